# Optimizing an MI355X kernel written in HIP

```python
import functools
import jax, jax.numpy as jnp
from jax import lax
import numpy as np

D_MODEL = 1024
BATCH = 2
SEQ = 8192
DEPTH = 1
DEC_BATCH = 128
DEC_SEQ = 8
PAST_LEN = 8192
PAGE_SIZE = 128

MIX_WIDTH = D_MODEL
LRU_WIDTH = MIX_WIDTH // 2
LRU_BLOCKS = 8
LRU_BLOCK = LRU_WIDTH // LRU_BLOCKS
CONV_WIDTH = 4
LRU_C = 8.0
ATTN_HEADS = 8
HEAD_DIM = (MIX_WIDTH - LRU_WIDTH) // ATTN_HEADS
KV_HEADS = 2
GROUP = ATTN_HEADS // KV_HEADS
WINDOW = 128
ROPE_THETA = 10000.0
N_MEM = 256
X_HEADS = 4
X_HEAD_DIM = D_MODEL // X_HEADS
D_FF = 2816
EPS = 1e-6
Q_WIDTH = ATTN_HEADS * HEAD_DIM
KV_WIDTH = KV_HEADS * HEAD_DIM
IN_COLS = 2 * LRU_WIDTH + Q_WIDTH + 2 * KV_WIDTH

kernel_name = 'hymba_rglru_swa_macaron_memxattn_step'


def rmsnorm(x, g):
    xf = x.astype(jnp.float32)
    y = xf * lax.rsqrt(jnp.mean(xf * xf, axis=-1, keepdims=True) + EPS)
    return (y * g.astype(jnp.float32)).astype(x.dtype)


def swiglu(x, w_gate, w_up, w_down):
    return (jax.nn.silu(x @ w_gate) * (x @ w_up)) @ w_down


def rope(z, pos):
    half = HEAD_DIM // 2
    inv = ROPE_THETA ** (-jnp.arange(half, dtype=jnp.float32) / half)
    ang = pos.astype(jnp.float32)[:, None] * inv[None, :]
    cos = jnp.cos(ang)[:, None, :]
    sin = jnp.sin(ang)[:, None, :]
    z1 = z[..., :half].astype(jnp.float32)
    z2 = z[..., half:].astype(jnp.float32)
    return jnp.concatenate([z1 * cos - z2 * sin, z2 * cos + z1 * sin], axis=-1).astype(z.dtype)


def sink_softmax(s, mask, sink):
    s = jnp.where(mask, s, -jnp.inf)
    sk = jnp.broadcast_to(sink.astype(jnp.float32), s.shape[:-1] + (1,))
    p = jax.nn.softmax(jnp.concatenate([s, sk], axis=-1), axis=-1)
    return p[..., :-1]


def lru_combine(left, right):
    a1, b1 = left
    a2, b2 = right
    return a1 * a2, a2 * b1 + b2


def rg_lru(u, conv_buf, h0, conv_w, conv_b, w_a, b_a, w_i, b_i, lam):
    n, t = u.shape[:2]
    xc = jnp.concatenate([conv_buf.astype(u.dtype), u], axis=1)
    conv = conv_b
    for j in range(CONV_WIDTH):
        conv = conv + xc[:, j:j + t] * conv_w[j]
    new_buf = xc[:, -(CONV_WIDTH - 1):]
    xb = conv.reshape(n, t, LRU_BLOCKS, LRU_BLOCK)
    r = jax.nn.sigmoid(jnp.einsum('ntgi,gij->ntgj', xb, w_a).reshape(n, t, LRU_WIDTH) + b_a)
    gi = jax.nn.sigmoid(jnp.einsum('ntgi,gij->ntgj', xb, w_i).reshape(n, t, LRU_WIDTH) + b_i)
    log_a = -LRU_C * r.astype(jnp.float32) * jax.nn.softplus(-lam.astype(jnp.float32))
    a = jnp.exp(log_a)
    b = jnp.sqrt(-jnp.expm1(2.0 * log_a)) * (gi * conv).astype(jnp.float32)
    b = b.at[:, 0].add(a[:, 0] * h0.astype(jnp.float32))
    _, h = lax.associative_scan(lru_combine, (a, b), axis=1)
    return h, h[:, -1], new_buf


def swa_prompt(q, k, v, sink):
    n, t = q.shape[:2]
    nb = t // WINDOW
    qb = q.reshape(n, nb, WINDOW, KV_HEADS, GROUP, HEAD_DIM)

    def band(z):
        zb = z.reshape(n, nb, WINDOW, KV_HEADS, HEAD_DIM)
        prev = jnp.concatenate([jnp.zeros_like(zb[:, :1]), zb[:, :-1]], axis=1)
        return jnp.concatenate([prev, zb], axis=2)

    kk, vv = band(k), band(v)
    s = jnp.einsum('nbqkgd,nbskd->nbkgqs', qb, kk, preferred_element_type=jnp.float32) * (HEAD_DIM ** -0.5)
    i = jnp.arange(WINDOW)[:, None]
    j = jnp.arange(2 * WINDOW)[None, :]
    dist = i + WINDOW - j
    within = (dist >= 0) & (dist < WINDOW)
    blk = jnp.arange(nb)[:, None, None]
    mask = within[None] & ((blk > 0) | (j[None] >= WINDOW))
    p = sink_softmax(s, mask[None, :, None, None], sink.reshape(KV_HEADS, GROUP)[None, None, :, :, None, None])
    o = jnp.einsum('nbkgqs,nbskd->nbqkgd', p.astype(vv.dtype), vv).reshape(n, t, Q_WIDTH)
    return o, k[:, -WINDOW:], v[:, -WINDOW:]


def swa_sample(q, k, v, sink, buf_k, buf_v):
    n, s_len = q.shape[:2]
    kk = jnp.concatenate([buf_k.astype(k.dtype), k], axis=1)
    vv = jnp.concatenate([buf_v.astype(v.dtype), v], axis=1)
    qp = PAST_LEN + jnp.arange(s_len, dtype=jnp.int32)
    kp = jnp.concatenate([PAST_LEN - WINDOW + jnp.arange(WINDOW, dtype=jnp.int32), qp])
    dist = qp[:, None] - kp[None, :]
    mask = (dist >= 0) & (dist < WINDOW) & (kp[None, :] >= 0)
    qg = q.reshape(n, s_len, KV_HEADS, GROUP, HEAD_DIM)
    s = jnp.einsum('nqkgd,nskd->nkgqs', qg, kk, preferred_element_type=jnp.float32) * (HEAD_DIM ** -0.5)
    p = sink_softmax(s, mask, sink.reshape(KV_HEADS, GROUP)[None, :, :, None, None])
    o = jnp.einsum('nkgqs,nskd->nqkgd', p.astype(vv.dtype), vv).reshape(n, s_len, Q_WIDTH)
    return o, kk[:, -WINDOW:], vv[:, -WINDOW:]


def memory_kv(mem, g_mem, w_ck, w_cv):
    n, m = mem.shape[:2]
    mm = rmsnorm(mem, g_mem)
    mk = (mm @ w_ck).reshape(n, m, X_HEADS, X_HEAD_DIM)
    mv = (mm @ w_cv).reshape(n, m, X_HEADS, X_HEAD_DIM)
    return mk, mv


def cross_attend(h, mk, mv, w_cq, w_co):
    n, t = h.shape[:2]
    q = (h @ w_cq).reshape(n, t, X_HEADS, X_HEAD_DIM)
    s = jnp.einsum('nthd,nmhd->nhtm', q, mk.astype(q.dtype), preferred_element_type=jnp.float32) * (X_HEAD_DIM ** -0.5)
    p = jax.nn.softmax(s, axis=-1).astype(mv.dtype)
    o = jnp.einsum('nhtm,nmhd->nthd', p, mv).reshape(n, t, D_MODEL).astype(h.dtype)
    return o @ w_co


def trunk_layer(x, pos, mk, mv, conv_buf, h0, attend, p):
    x = x + 0.5 * swiglu(rmsnorm(x, p['g_ffn1']), p['w1_gate'], p['w1_up'], p['w1_down'])
    h = rmsnorm(x, p['g_mix'])
    n, t = h.shape[:2]
    proj = h @ p['w_in']
    o1 = LRU_WIDTH
    o2 = 2 * LRU_WIDTH
    o3 = o2 + Q_WIDTH
    o4 = o3 + KV_WIDTH
    u, gate = proj[..., :o1], proj[..., o1:o2]
    q = rope(proj[..., o2:o3].reshape(n, t, ATTN_HEADS, HEAD_DIM), pos)
    k = rope(proj[..., o3:o4].reshape(n, t, KV_HEADS, HEAD_DIM), pos)
    v = proj[..., o4:].reshape(n, t, KV_HEADS, HEAD_DIM)
    hl, h_last, new_conv = rg_lru(u, conv_buf, h0, p['conv_w'], p['conv_b'], p['w_a'], p['b_a'], p['w_i'], p['b_i'], p['lam'])
    lru_out = rmsnorm(hl.astype(x.dtype) * jax.nn.gelu(gate), p['g_lru_out'])
    attn_o, new_k, new_v = attend(q, k, v, p['sink'])
    attn_out = rmsnorm(attn_o.astype(x.dtype), p['g_attn_out'])
    x = x + jnp.concatenate([lru_out, attn_out], axis=-1) @ p['w_out']
    x = x + cross_attend(rmsnorm(x, p['g_xattn']), mk, mv, p['w_cq'], p['w_co'])
    x = x + 0.5 * swiglu(rmsnorm(x, p['g_ffn2']), p['w2_gate'], p['w2_up'], p['w2_down'])
    return x, new_k, new_v, new_conv, h_last.astype(x.dtype)


def setup_inputs(seed: int = 0) -> dict:
    key = jax.random.key(seed)
    ks = iter(list(jax.random.split(key, 48)))

    def nrm(shape, scale):
        return jax.random.normal(next(ks), shape, jnp.float32) * scale

    def gain(shape):
        return 1.0 + nrm(shape, 0.05)

    L = DEPTH
    D = D_MODEL
    u = jax.random.uniform(next(ks), (L, LRU_WIDTH), jnp.float32, minval=0.9, maxval=0.999)
    a0 = u ** (1.0 / LRU_C)
    lam = jnp.log(a0) - jnp.log1p(-a0)
    return {
        'x_prompt': nrm((BATCH, SEQ, D), 1.0),
        'x_sample': nrm((DEC_BATCH, DEC_SEQ, D), 1.0),
        'mem_prompt': nrm((BATCH, N_MEM, D), 1.0),
        'cache_mem_k': nrm((L, DEC_BATCH, N_MEM, X_HEADS, X_HEAD_DIM), 1.0),
        'cache_mem_v': nrm((L, DEC_BATCH, N_MEM, X_HEADS, X_HEAD_DIM), 1.0),
        'cache_swa_k': nrm((L, DEC_BATCH, WINDOW, KV_HEADS, HEAD_DIM), 1.0),
        'cache_swa_v': nrm((L, DEC_BATCH, WINDOW, KV_HEADS, HEAD_DIM), 1.0),
        'state_conv': nrm((L, DEC_BATCH, CONV_WIDTH - 1, LRU_WIDTH), 1.0),
        'state_lru_h': nrm((L, DEC_BATCH, LRU_WIDTH), 0.5),
        'g_ffn1': gain((L, D)),
        'w1_gate': nrm((L, D, D_FF), D ** -0.5),
        'w1_up': nrm((L, D, D_FF), D ** -0.5),
        'w1_down': nrm((L, D_FF, D), D_FF ** -0.5),
        'g_mix': gain((L, D)),
        'w_in': nrm((L, D, IN_COLS), D ** -0.5),
        'conv_w': nrm((L, CONV_WIDTH, LRU_WIDTH), CONV_WIDTH ** -0.5),
        'conv_b': nrm((L, LRU_WIDTH), 0.02),
        'w_a': nrm((L, LRU_BLOCKS, LRU_BLOCK, LRU_BLOCK), LRU_BLOCK ** -0.5),
        'b_a': nrm((L, LRU_WIDTH), 0.02),
        'w_i': nrm((L, LRU_BLOCKS, LRU_BLOCK, LRU_BLOCK), LRU_BLOCK ** -0.5),
        'b_i': nrm((L, LRU_WIDTH), 0.02),
        'lam': lam,
        'sink': nrm((L, ATTN_HEADS), 0.5),
        'g_lru_out': gain((L, LRU_WIDTH)),
        'g_attn_out': gain((L, Q_WIDTH)),
        'w_out': nrm((L, MIX_WIDTH, D), MIX_WIDTH ** -0.5),
        'g_xattn': gain((L, D)),
        'g_mem': gain((L, D)),
        'w_cq': nrm((L, D, D), D ** -0.5),
        'w_ck': nrm((L, D, D), D ** -0.5),
        'w_cv': nrm((L, D, D), D ** -0.5),
        'w_co': nrm((L, D, D), D ** -0.5),
        'g_ffn2': gain((L, D)),
        'w2_gate': nrm((L, D, D_FF), D ** -0.5),
        'w2_up': nrm((L, D, D_FF), D ** -0.5),
        'w2_down': nrm((L, D_FF, D), D_FF ** -0.5),
        'g_final': gain((D,)),
    }


def reference(x_prompt, x_sample, mem_prompt, cache_mem_k, cache_mem_v, cache_swa_k, cache_swa_v, state_conv, state_lru_h,
              g_ffn1, w1_gate, w1_up, w1_down, g_mix, w_in, conv_w, conv_b, w_a, b_a, w_i, b_i, lam, sink,
              g_lru_out, g_attn_out, w_out, g_xattn, g_mem, w_cq, w_ck, w_cv, w_co, g_ffn2, w2_gate, w2_up, w2_down, g_final):
    pos_p = jnp.arange(x_prompt.shape[1], dtype=jnp.int32)
    pos_s = PAST_LEN + jnp.arange(x_sample.shape[1], dtype=jnp.int32)
    xp, xs = x_prompt, x_sample
    nbp = x_prompt.shape[0]
    mkp_l, mvp_l, kp_l, vp_l, cp_l, hp_l = [], [], [], [], [], []
    ks_l, vs_l, cs_l, hs_l = [], [], [], []
    for l in range(DEPTH):
        p = {
            'g_ffn1': g_ffn1[l], 'w1_gate': w1_gate[l], 'w1_up': w1_up[l], 'w1_down': w1_down[l],
            'g_mix': g_mix[l], 'w_in': w_in[l], 'conv_w': conv_w[l], 'conv_b': conv_b[l],
            'w_a': w_a[l], 'b_a': b_a[l], 'w_i': w_i[l], 'b_i': b_i[l], 'lam': lam[l], 'sink': sink[l],
            'g_lru_out': g_lru_out[l], 'g_attn_out': g_attn_out[l], 'w_out': w_out[l],
            'g_xattn': g_xattn[l], 'w_cq': w_cq[l], 'w_co': w_co[l],
            'g_ffn2': g_ffn2[l], 'w2_gate': w2_gate[l], 'w2_up': w2_up[l], 'w2_down': w2_down[l],
        }
        mk_p, mv_p = memory_kv(mem_prompt, g_mem[l], w_ck[l], w_cv[l])
        conv0 = jnp.zeros((nbp, CONV_WIDTH - 1, LRU_WIDTH), xp.dtype)
        h0 = jnp.zeros((nbp, LRU_WIDTH), jnp.float32)
        xp, kp_, vp_, cp_, hp_ = trunk_layer(xp, pos_p, mk_p, mv_p, conv0, h0, swa_prompt, p)
        attend_s = functools.partial(swa_sample, buf_k=cache_swa_k[l], buf_v=cache_swa_v[l])
        xs, ks_, vs_, cs_, hs_ = trunk_layer(xs, pos_s, cache_mem_k[l], cache_mem_v[l], state_conv[l], state_lru_h[l], attend_s, p)
        mkp_l.append(mk_p)
        mvp_l.append(mv_p)
        kp_l.append(kp_)
        vp_l.append(vp_)
        cp_l.append(cp_)
        hp_l.append(hp_)
        ks_l.append(ks_)
        vs_l.append(vs_)
        cs_l.append(cs_)
        hs_l.append(hs_)
    y_prompt = rmsnorm(xp, g_final)
    y_sample = rmsnorm(xs, g_final)
    return (y_prompt, y_sample,
            jnp.stack(mkp_l), jnp.stack(mvp_l),
            jnp.stack(kp_l), jnp.stack(vp_l), jnp.stack(cp_l), jnp.stack(hp_l),
            jnp.stack(ks_l), jnp.stack(vs_l), jnp.stack(cs_l), jnp.stack(hs_l))
```

```cpp
#include <hip/hip_runtime.h>
#include <hip/hip_cooperative_groups.h>
#include <cstdio>
#include <cstdint>
#include <cmath>
#include <cstring>
namespace cg = cooperative_groups;
namespace pg8 {
#define PG8_LAS __attribute__((address_space(3)))
typedef unsigned short bf16_t;
typedef short bf16x8 __attribute__((ext_vector_type(8)));
typedef float f32x4 __attribute__((ext_vector_type(4)));
typedef unsigned u32x4 __attribute__((ext_vector_type(4)));
constexpr int BM = 256, BK = 64, HALF = 128, HTB = HALF * BK * 2  , STAGE_BYTES = 8 * HTB, NXCD = 8, WGM = 8;

__host__ __device__ __forceinline__ int lds_byte(int r, int c) { const int st = (r >> 4) * 2 + (c >> 5), rr = r & 15, cc = c & 31, ob = rr * 64 + cc * 2; return st * 1024 + (ob ^ (((ob >> 9) & 1) << 5)); }
__host__ __device__ __forceinline__ void stage_rc(int b, int& R, int& C) { const int st = b / 1024, sb = b % 1024, swz = sb ^ (((sb >> 9) & 1) << 5); R = (st >> 1) * 16 + swz / 64; C = (st & 1) * 32 + (swz % 64) / 2; }
__host__ __device__ __forceinline__ int perm32(int rho) { const int n = rho >> 4, i = rho & 15; return 8 * (i >> 2) + 4 * n + (i & 3); }

struct Unit { int pm, pn, seg; };
struct Gemm { const bf16_t* A; const bf16_t* Bt; int M, N, K; const bf16_t* A2; const bf16_t* Bt2; };

struct StaticOrder {
    int nM, nN, nwg, G, c;
    __host__ __device__ void init(int M, int N, int G_, int c_) { nM = M / BM; nN = N / BM; nwg = nM * nN; G = G_; c = c_; }
    __host__ __device__ bool next(int i, Unit& u) const {
        const long L = (long)i * G + c; if (L >= nwg) return false;
        int wgid = (int)L; { const int q = nwg / NXCD, r = nwg % NXCD, xcd = wgid % NXCD, off = wgid / NXCD; wgid = (xcd < r ? xcd * (q + 1) : r * (q + 1) + (xcd - r) * q) + off; }
        const int nig = WGM * nN, gid = wgid / nig, fm = gid * WGM, gsz = (nM - fm) < WGM ? (nM - fm) : WGM;
        u.pm = fm + ((wgid % nig) % gsz); u.pn = (wgid % nig) / gsz; u.seg = 0; return true;
    }
    __device__ __forceinline__ void a_ready(const Unit&) const {}
    __device__ __forceinline__ void done(const Unit&) const {}
};

__device__ __forceinline__ unsigned cvt_pk_bf16(float lo, float hi) { unsigned r; asm volatile("v_cvt_pk_bf16_f32 %0, %1, %2" : "=v"(r) : "v"(lo), "v"(hi)); return r; }

template <class Epi, class Sched, bool ALIGN_EPI = false, bool SP2 = false>
__device__ __forceinline__ void gemm_phase(PG8_LAS unsigned char* lds, const Gemm g, const Sched& S, const Epi& E) {
    int tid_ = threadIdx.x; asm volatile("" : "+v"(tid_)); const int tid = tid_, wid = __builtin_amdgcn_readfirstlane(tid >> 6), lane = tid & 63, wr = wid >> 2, wc = wid & 3, fr = lane & 15, fq = lane >> 4;
    const int K = g.K, nt = K / BK;
    unsigned voffA[2], voffB[2];
#pragma unroll
    for (int i = 0; i < 2; ++i) { int R, C; stage_rc(tid * 16 + i * 8192, R, C); const int Rb = Epi::PERM ? ((R & ~31) + perm32(R & 31)) : R;
        voffA[i] = (unsigned)(R * K + C) * 2u; voffB[i] = (unsigned)(Rb * K + C) * 2u; }
    const size_t kstep = (size_t)(BK * 2);
    const size_t hstep = (size_t)HALF * K * 2;
    const size_t tstep = 2 * hstep;
    const unsigned ldsw = (unsigned)wid * 1024u;
    const int aoff = lds_byte(wr * 64 + fr, fq * 8), boff = lds_byte(wc * 32 + fr, fq * 8);
#define PG8_SA(b, h) (((b) * 2 + (h)) * HTB)
#define PG8_SB(b, h) ((4 + (b) * 2 + (h)) * HTB)
#define PG8_STAGE(bufoff, gbase, voff) do { _Pragma("unroll") for (int _i = 0; _i < 2; ++_i) \
        __builtin_amdgcn_global_load_lds((const unsigned*)((const char*)(gbase) + (voff)[_i]), (PG8_LAS unsigned*)(lds + (bufoff) + ldsw + _i * 8192), 16, 0, 0); } while (0)
#define PG8_LDA(dst, b, h) do { _Pragma("unroll") for (int m = 0; m < 4; ++m) _Pragma("unroll") for (int k = 0; k < 2; ++k) dst[m][k] = *(const PG8_LAS bf16x8*)(lds + PG8_SA(b, h) + aoff + m * 2048 + k * 1024); } while (0)
#define PG8_LDB(dst, b, h) do { _Pragma("unroll") for (int n = 0; n < 2; ++n) _Pragma("unroll") for (int k = 0; k < 2; ++k) dst[n][k] = *(const PG8_LAS bf16x8*)(lds + PG8_SB(b, h) + boff + n * 2048 + k * 1024); } while (0)
#define PG8_MMA(ai, bj, At, Bt) do { __builtin_amdgcn_s_setprio(1); _Pragma("unroll") for (int m = 0; m < 4; ++m) _Pragma("unroll") for (int n = 0; n < 2; ++n) _Pragma("unroll") for (int k = 0; k < 2; ++k) \
        acc[ai][bj][m][n] = __builtin_amdgcn_mfma_f32_16x16x32_bf16(Bt[n][k], At[m][k], acc[ai][bj][m][n], 0, 0, 0); __builtin_amdgcn_s_setprio(0); } while (0)
#define PG8_WAIT_V(n) asm volatile("s_waitcnt vmcnt(" #n ")" ::: "memory")
#define PG8_WAIT_L(n) asm volatile("s_waitcnt lgkmcnt(" #n ")" ::: "memory")
#define PG8_BAR __builtin_amdgcn_s_barrier()
#define PG8_SCHED __builtin_amdgcn_sched_barrier(0)
    Unit cur, nxt; int ui = 0;
    if (!S.next(0, cur)) return;
    f32x4 acc[2][2][4][2];
#pragma unroll
    for (int a = 0; a < 2; ++a)
#pragma unroll
        for (int b = 0; b < 2; ++b)
#pragma unroll
            for (int m = 0; m < 4; ++m)
#pragma unroll
                for (int n = 0; n < 2; ++n) acc[a][b][m][n] = (f32x4){0.f, 0.f, 0.f, 0.f};
    bf16x8 At[4][2], B0[2][2], B1[2][2];
    const char* cA = (const char*)((Epi::TWOSEG && cur.seg) ? g.A2 : g.A) + (size_t)cur.pm * tstep; const char* cB = (const char*)((Epi::TWOSEG && cur.seg) ? g.Bt2 : g.Bt) + (size_t)cur.pn * tstep;
    S.a_ready(cur);
    if constexpr (SP2) {
        PG8_STAGE(PG8_SB(0, 0), cB, voffB); PG8_STAGE(PG8_SB(0, 1), cB + hstep, voffB); PG8_STAGE(PG8_SA(0, 0), cA, voffA); PG8_STAGE(PG8_SA(0, 1), cA + hstep, voffA);
        if (wr == 1) PG8_BAR;
        PG8_WAIT_V(2); PG8_BAR;
        PG8_STAGE(PG8_SB(1, 0), cB + kstep, voffB); PG8_STAGE(PG8_SA(1, 0), cA + kstep, voffA); PG8_STAGE(PG8_SB(1, 1), cB + hstep + kstep, voffB);
        PG8_WAIT_V(6); PG8_BAR;
    } else {
        PG8_STAGE(PG8_SB(0, 0), cB, voffB); PG8_STAGE(PG8_SA(0, 0), cA, voffA); PG8_STAGE(PG8_SB(0, 1), cB + hstep, voffB); PG8_STAGE(PG8_SA(0, 1), cA + hstep, voffA);
        if (wr == 1) PG8_BAR;
        PG8_WAIT_V(4); PG8_BAR;
        PG8_STAGE(PG8_SB(1, 0), cB + kstep, voffB); PG8_STAGE(PG8_SA(1, 0), cA + kstep, voffA); PG8_STAGE(PG8_SB(1, 1), cB + hstep + kstep, voffB);
        PG8_WAIT_V(6); PG8_BAR;
    }
    for (;;) {
        const bool has_next = S.next(ui + 1, nxt);
        const char* nA = has_next ? (const char*)((Epi::TWOSEG && nxt.seg) ? g.A2 : g.A) + (size_t)nxt.pm * tstep : cA; const char* nB = has_next ? (const char*)((Epi::TWOSEG && nxt.seg) ? g.Bt2 : g.Bt) + (size_t)nxt.pn * tstep : cB;
        for (int t = 0; t < nt; t += 2) {
            const bool last = (t == nt - 2);
            if constexpr (Epi::MIDSCALE) { if (t == nt / 2) E.mid(acc, cur, wr, wc, fr, fq); }
            const char* a1 = cA + (size_t)(t + 1) * kstep;
            const char* a2 = last ? nA : cA + (size_t)(t + 2) * kstep; const char* b2 = last ? nB : cB + (size_t)(t + 2) * kstep;
            const char* a3 = a2 + kstep; const char* b3 = b2 + kstep;
            if (last && has_next) S.a_ready(nxt);
            if constexpr (SP2) {
            PG8_LDB(B0, 0, 0); PG8_LDB(B1, 0, 1); PG8_SCHED; PG8_LDA(At, 0, 0); PG8_STAGE(PG8_SA(1, 1), a1 + hstep, voffA);
            PG8_WAIT_V(8); PG8_WAIT_L(0); PG8_BAR; PG8_MMA(0, 0, At, B0); PG8_MMA(0, 1, At, B1); PG8_BAR; PG8_SCHED;
            PG8_LDA(At, 0, 1); PG8_STAGE(PG8_SB(0, 0), b2, voffB); PG8_STAGE(PG8_SB(0, 1), b2 + hstep, voffB); PG8_STAGE(PG8_SA(0, 0), a2, voffA);
            PG8_WAIT_V(8); PG8_WAIT_L(0); PG8_BAR; PG8_MMA(1, 0, At, B0); PG8_MMA(1, 1, At, B1); PG8_BAR; PG8_SCHED;
            PG8_LDB(B0, 1, 0); PG8_LDB(B1, 1, 1); PG8_SCHED; PG8_LDA(At, 1, 0); PG8_STAGE(PG8_SA(0, 1), a2 + hstep, voffA);
            PG8_WAIT_V(8); PG8_WAIT_L(0); PG8_BAR; PG8_MMA(0, 0, At, B0); PG8_MMA(0, 1, At, B1); PG8_BAR; PG8_SCHED;
            PG8_LDA(At, 1, 1); PG8_STAGE(PG8_SB(1, 0), b3, voffB); PG8_STAGE(PG8_SB(1, 1), b3 + hstep, voffB); PG8_STAGE(PG8_SA(1, 0), a3, voffA);
            PG8_WAIT_V(8); PG8_WAIT_L(0); PG8_BAR; PG8_MMA(1, 0, At, B0); PG8_MMA(1, 1, At, B1); PG8_BAR; PG8_SCHED;
            } else {
            PG8_LDB(B0, 0, 0); PG8_SCHED; PG8_LDA(At, 0, 0); PG8_STAGE(PG8_SA(1, 1), a1 + hstep, voffA);
            PG8_WAIT_L(8); PG8_BAR; PG8_WAIT_L(0); PG8_MMA(0, 0, At, B0); PG8_BAR; PG8_SCHED;
            PG8_LDB(B1, 0, 1); PG8_STAGE(PG8_SB(0, 0), b2, voffB);
            PG8_BAR; PG8_WAIT_L(0); PG8_MMA(0, 1, At, B1); PG8_BAR;
            PG8_LDA(At, 0, 1); PG8_STAGE(PG8_SA(0, 0), a2, voffA);
            PG8_BAR; PG8_WAIT_L(0); PG8_MMA(1, 0, At, B0); PG8_BAR; PG8_SCHED;
            PG8_STAGE(PG8_SB(0, 1), b2 + hstep, voffB);
            PG8_WAIT_V(6); PG8_BAR; PG8_MMA(1, 1, At, B1); PG8_BAR;
            PG8_LDB(B0, 1, 0); PG8_SCHED; PG8_LDA(At, 1, 0); PG8_STAGE(PG8_SA(0, 1), a2 + hstep, voffA);
            PG8_WAIT_L(8); PG8_BAR; PG8_WAIT_L(0); PG8_MMA(0, 0, At, B0); PG8_BAR; PG8_SCHED;
            PG8_LDB(B1, 1, 1); PG8_STAGE(PG8_SB(1, 0), b3, voffB);
            PG8_BAR; PG8_WAIT_L(0); PG8_MMA(0, 1, At, B1); PG8_BAR;
            PG8_LDA(At, 1, 1); PG8_STAGE(PG8_SA(1, 0), a3, voffA);
            PG8_BAR; PG8_WAIT_L(0); PG8_MMA(1, 0, At, B0); PG8_BAR; PG8_SCHED;
            PG8_STAGE(PG8_SB(1, 1), b3 + hstep, voffB);
            PG8_WAIT_V(6); PG8_BAR; PG8_MMA(1, 1, At, B1); PG8_BAR;
            }
        }
        if constexpr (ALIGN_EPI) { if (wr == 0) PG8_BAR; }
        bool keep_acc = false;
        if constexpr (Epi::TWOSEG) { if (cur.seg == 0) { E.mid(acc, cur, wr, wc, fr, fq); keep_acc = true; } else { E(acc, cur, wr, wc, fr, fq); } }
        else if constexpr (!Epi::AFTER_DRAIN) { E(acc, cur, wr, wc, fr, fq); S.done(cur); }
        if (!has_next) break;
        if (!keep_acc) {
#pragma unroll
        for (int a = 0; a < 2; ++a)
#pragma unroll
            for (int b = 0; b < 2; ++b)
#pragma unroll
                for (int m = 0; m < 4; ++m)
#pragma unroll
                    for (int n = 0; n < 2; ++n) acc[a][b][m][n] = (f32x4){0.f, 0.f, 0.f, 0.f};
        }
        cur = nxt; cA = nA; cB = nB; ++ui;
        if constexpr (ALIGN_EPI) { if (wr == 1) PG8_BAR; }
    }
    PG8_WAIT_V(0);
    if constexpr (!ALIGN_EPI) { if (wr == 0) PG8_BAR; }
    PG8_BAR;
    if constexpr (Epi::AFTER_DRAIN) { E.fused(acc, cur, wr, wc, fr, fq, lds, wid, lane); S.done(cur); }
#undef PG8_SA
#undef PG8_SB
#undef PG8_STAGE
#undef PG8_LDA
#undef PG8_LDB
#undef PG8_MMA
#undef PG8_WAIT_V
#undef PG8_WAIT_L
#undef PG8_BAR
#undef PG8_SCHED
}
}
using namespace pg8;
#define LAS __attribute__((address_space(3)))
typedef float f32x16 __attribute__((ext_vector_type(16)));
typedef unsigned u32x2 __attribute__((ext_vector_type(2)));

constexpr int D = 1024, MP = 16384, MS = 1024, M = MP + MS, FF = 2816, NIN = 1792, SEQ = 8192, MEMR = 512;
constexpr float EPS = 1e-6f, LOG2E = 1.4426950408889634f;
constexpr float C2S = 0.125f * LOG2E;
constexpr float C2X = 0.0625f * LOG2E;
constexpr size_t O_Y = 0, O_MK = (size_t)M * D, O_MV = O_MK + 524288, O_SKP = O_MV + 524288, O_SVP = O_SKP + 32768, O_CP = O_SVP + 32768,
                 O_HP = O_CP + 3072, O_SKS = O_HP + 1024, O_SVS = O_SKS + 2097152, O_CS = O_SVS + 2097152, O_HS = O_CS + 196608, O_END = O_HS + 65536;
constexpr size_t MiB = 1u << 20;
constexpr size_t WS_SS = 0, WS_ROPE = MiB / 2, WS_SUM = 3 * MiB, WS_WAB = 4 * MiB, WS_W1GU = 8 * MiB, WS_WCKV = 19 * MiB, WS_W1D = 23 * MiB, WS_WIN = 29 * MiB,
                 WS_WOUT = 33 * MiB, WS_WCQ = 35 * MiB, WS_WCO = 37 * MiB, WS_W2GU = 39 * MiB, WS_W2D = 50 * MiB, WS_XB = 56 * MiB, WS_H = 91 * MiB, WS_X = 185 * MiB,
                 WS_PROJ = 253 * MiB, WS_MIX = 313 * MiB, WS_QX = 347 * MiB, WS_XO = 381 * MiB, WS_END = 415 * MiB;
constexpr int ROPE_POS = 8200;
constexpr int RING_BYTES = 131072, MISC_OFF = RING_BYTES, LDS_BYTES = 147456;

__device__ __forceinline__ float bf2f(unsigned short b) { return __uint_as_float((unsigned)b << 16); }
__device__ __forceinline__ unsigned short f2bf(float f) { unsigned u = __float_as_uint(f); return (unsigned short)((u + 0x7fffu + ((u >> 16) & 1u)) >> 16); }
__device__ __forceinline__ unsigned pk2(float lo, float hi) { return (unsigned)f2bf(lo) | ((unsigned)f2bf(hi) << 16); }
__device__ __forceinline__ float rstd_of(float ss) { return rsqrtf(ss * (1.0f / 1024.0f) + EPS); }
__device__ __forceinline__ float fexp2(float x) { return __builtin_amdgcn_exp2f(x); }
__device__ __forceinline__ float sigmoidf_(float x) { return __builtin_amdgcn_rcpf(1.0f + fexp2(-x * LOG2E)); }
__device__ __forceinline__ float silu_mul(float g, float u) { return g * u * sigmoidf_(g); }
__device__ __forceinline__ float gelu_tanh(float x) { const float z = 0.7978845608028654f * (x + 0.044715f * x * x * x); return x * sigmoidf_(2.0f * z); }

__device__ __forceinline__ void st16(void* p, u32x4 v) { *(u32x4*)p = v; }
__device__ __forceinline__ void st8(void* p, u32x2 v) { *(u32x2*)p = v; }
struct EpiGU {
    static constexpr bool PERM = true, AFTER_DRAIN = false, MIDSCALE = false, TWOSEG = false;
    bf16_t* H; const float* ss;
    __device__ __forceinline__ void operator()(const f32x4 (&acc)[2][2][4][2], const Unit& u, int wr, int wc, int fr, int fq) const {
        const int row0 = u.pm * 256 + wr * 64 + fr, col0 = u.pn * 128 + wc * 32 + 8 * fq;
        float rsv[2][4];
#pragma unroll
        for (int ai = 0; ai < 2; ++ai)
#pragma unroll
            for (int m = 0; m < 4; ++m) rsv[ai][m] = ss[row0 + ai * 128 + m * 16];
#pragma unroll
        for (int ai = 0; ai < 2; ++ai)
#pragma unroll
            for (int m = 0; m < 4; ++m) {
                const int row = row0 + ai * 128 + m * 16; const float rs = rstd_of(rsv[ai][m]);
                const f32x4 g0 = acc[ai][0][m][0] * rs, g1 = acc[ai][0][m][1] * rs, u0 = acc[ai][1][m][0] * rs, u1 = acc[ai][1][m][1] * rs;
                u32x4 w;
                w.x = cvt_pk_bf16(silu_mul(g0[0], u0[0]), silu_mul(g0[1], u0[1])); w.y = cvt_pk_bf16(silu_mul(g0[2], u0[2]), silu_mul(g0[3], u0[3]));
                w.z = cvt_pk_bf16(silu_mul(g1[0], u1[0]), silu_mul(g1[1], u1[1])); w.w = cvt_pk_bf16(silu_mul(g1[2], u1[2]), silu_mul(g1[3], u1[3]));
                st16(H + (size_t)row * FF + col0, w);
            }
    }
};
template <bool ROWSCALE, bool F32BASE>
struct EpiRes {
    static constexpr bool PERM = true, AFTER_DRAIN = false, MIDSCALE = false, TWOSEG = false;
    const float* base_p; const float* base_s; bf16_t* XB; float* ss_out; float scale; const float* rowss;
    __device__ __forceinline__ void operator()(const f32x4 (&acc)[2][2][4][2], const Unit& u, int wr, int wc, int fr, int fq) const {
        const int row0 = u.pm * 256 + wr * 64 + fr, col0 = u.pn * 256 + wc * 32 + 8 * fq;
#pragma unroll
        for (int ai = 0; ai < 2; ++ai) {
            f32x4 bv[4][2][2]; float scv[4];
#pragma unroll
            for (int m = 0; m < 4; ++m) {
                const int row = row0 + ai * 128 + m * 16;
                scv[m] = ROWSCALE ? rowss[row] : 0.f;
                if (F32BASE) {
                    const float* b = row < MP ? base_p + (size_t)row * D : base_s + (size_t)(row - MP) * D;
#pragma unroll
                    for (int bj = 0; bj < 2; ++bj) { bv[m][bj][0] = *(const f32x4*)(b + col0 + bj * 128); bv[m][bj][1] = *(const f32x4*)(b + col0 + bj * 128 + 4); }
                } else {
#pragma unroll
                    for (int bj = 0; bj < 2; ++bj) {
                        const u32x4 w = *(const u32x4*)(XB + (size_t)row * D + col0 + bj * 128);
                        bv[m][bj][0] = (f32x4){__uint_as_float(w.x << 16), __uint_as_float(w.x & 0xffff0000u), __uint_as_float(w.y << 16), __uint_as_float(w.y & 0xffff0000u)};
                        bv[m][bj][1] = (f32x4){__uint_as_float(w.z << 16), __uint_as_float(w.z & 0xffff0000u), __uint_as_float(w.w << 16), __uint_as_float(w.w & 0xffff0000u)};
                    }
                }
            }
#pragma unroll
            for (int m = 0; m < 4; ++m) {
                const int row = row0 + ai * 128 + m * 16;
                const float sc = ROWSCALE ? rsqrtf(scv[m] * (1.0f / 512.0f) + EPS) : scale; float sq = 0.f;
#pragma unroll
                for (int bj = 0; bj < 2; ++bj) {
                    const int c = col0 + bj * 128;
                    const f32x4 v0 = bv[m][bj][0] + acc[ai][bj][m][0] * sc, v1 = bv[m][bj][1] + acc[ai][bj][m][1] * sc;
                    u32x4 w; w.x = cvt_pk_bf16(v0[0], v0[1]); w.y = cvt_pk_bf16(v0[2], v0[3]); w.z = cvt_pk_bf16(v1[0], v1[1]); w.w = cvt_pk_bf16(v1[2], v1[3]);
                    *(u32x4*)(XB + (size_t)row * D + c) = w;
                    sq += (v0[0] * v0[0] + v0[1] * v0[1]) + (v0[2] * v0[2] + v0[3] * v0[3]) + (v1[0] * v1[0] + v1[1] * v1[1]) + (v1[2] * v1[2] + v1[3] * v1[3]);
                }
                if (ss_out) { sq += __shfl_xor(sq, 16); sq += __shfl_xor(sq, 32); if (fq == 0) unsafeAtomicAdd(ss_out + row, sq); }
            }
        }
    }
};
struct EpiMix {
    static constexpr bool PERM = true, AFTER_DRAIN = false, MIDSCALE = false, TWOSEG = true;
    bf16_t* XB; float* ss_out; const float* ssl; const float* ssa;
    __device__ __forceinline__ void mid(f32x4 (&acc)[2][2][4][2], const Unit& u, int wr, int wc, int fr, int fq) const {
        const int row0 = u.pm * 256 + wr * 64 + fr;
        float sl[2][4], sa[2][4];
#pragma unroll
        for (int ai = 0; ai < 2; ++ai)
#pragma unroll
            for (int m = 0; m < 4; ++m) { sl[ai][m] = ssl[row0 + ai * 128 + m * 16]; sa[ai][m] = ssa[row0 + ai * 128 + m * 16]; }
#pragma unroll
        for (int ai = 0; ai < 2; ++ai)
#pragma unroll
            for (int m = 0; m < 4; ++m) {
                const float ratio = rsqrtf(sl[ai][m] * (1.0f / 512.0f) + EPS) * sqrtf(sa[ai][m] * (1.0f / 512.0f) + EPS);
#pragma unroll
                for (int bj = 0; bj < 2; ++bj)
#pragma unroll
                    for (int n = 0; n < 2; ++n) acc[ai][bj][m][n] = acc[ai][bj][m][n] * ratio;
            }
    }
    __device__ __forceinline__ void operator()(const f32x4 (&acc)[2][2][4][2], const Unit& u, int wr, int wc, int fr, int fq) const {
        const EpiRes<true, false> E{nullptr, nullptr, XB, ss_out, 1.0f, ssa};
        E(acc, u, wr, wc, fr, fq);
    }
};
struct StaticOrder2 {
    StaticOrder S;
    __host__ __device__ void init(int M, int N, int G_, int c_) { S.init(M, N, G_, c_); }
    __host__ __device__ bool next(int i, Unit& u) const { const bool ok = S.next(i >> 1, u); u.seg = i & 1; return ok; }
    __device__ __forceinline__ void a_ready(const Unit&) const {}
    __device__ __forceinline__ void done(const Unit&) const {}
};
struct EpiFinal {
    static constexpr bool PERM = true, AFTER_DRAIN = true, MIDSCALE = false, TWOSEG = false;
    const bf16_t* XB; float* ss; unsigned* cnt; const float* gfin; float* Y; float scale;
    __device__ __forceinline__ void fused(f32x4 (&acc)[2][2][4][2], const Unit& u, int wr, int wc, int fr, int fq, PG8_LAS unsigned char* lds, int wid, int lane) const {
        const int row0 = u.pm * 256 + wr * 64 + fr, col0 = u.pn * 256 + wc * 32 + 8 * fq;
#pragma unroll
        for (int ai = 0; ai < 2; ++ai) {
            u32x4 bw[4][2];
#pragma unroll
            for (int m = 0; m < 4; ++m)
#pragma unroll
                for (int bj = 0; bj < 2; ++bj) bw[m][bj] = *(const u32x4*)(XB + (size_t)(row0 + ai * 128 + m * 16) * D + col0 + bj * 128);
#pragma unroll
            for (int m = 0; m < 4; ++m) {
                float sq = 0.f;
#pragma unroll
                for (int bj = 0; bj < 2; ++bj) {
                    const u32x4 w = bw[m][bj];
                    const f32x4 b0 = (f32x4){__uint_as_float(w.x << 16), __uint_as_float(w.x & 0xffff0000u), __uint_as_float(w.y << 16), __uint_as_float(w.y & 0xffff0000u)};
                    const f32x4 b1 = (f32x4){__uint_as_float(w.z << 16), __uint_as_float(w.z & 0xffff0000u), __uint_as_float(w.w << 16), __uint_as_float(w.w & 0xffff0000u)};
                    const f32x4 v0 = b0 + acc[ai][bj][m][0] * scale, v1 = b1 + acc[ai][bj][m][1] * scale;
                    acc[ai][bj][m][0] = v0; acc[ai][bj][m][1] = v1;
                    sq += (v0[0] * v0[0] + v0[1] * v0[1]) + (v0[2] * v0[2] + v0[3] * v0[3]) + (v1[0] * v1[0] + v1[1] * v1[1]) + (v1[2] * v1[2] + v1[3] * v1[3]);
                }
                sq += __shfl_xor(sq, 16); sq += __shfl_xor(sq, 32);
                if (fq == 0) unsafeAtomicAdd(ss + row0 + ai * 128 + m * 16, sq);
            }
        }
        asm volatile("s_waitcnt vmcnt(0)" ::: "memory");
        __syncthreads();
        if (threadIdx.x == 0) {
            unsigned* c = cnt + 64 * u.pm;
            __hip_atomic_fetch_add(c, 1u, __ATOMIC_RELAXED, __HIP_MEMORY_SCOPE_AGENT);
            unsigned sp = 0u;
            while (__hip_atomic_load(c, __ATOMIC_RELAXED, __HIP_MEMORY_SCOPE_AGENT) < 4u) { __builtin_amdgcn_s_sleep(2); if (++sp > (1u << 20)) break; }
        }
        __syncthreads();
        PG8_LAS float* S = (PG8_LAS float*)lds;
        if (threadIdx.x < 256) S[threadIdx.x] = rstd_of(unsafeAtomicAdd(ss + u.pm * 256 + (int)threadIdx.x, 0.0f));
        __syncthreads();
#pragma unroll
        for (int ai = 0; ai < 2; ++ai)
#pragma unroll
            for (int m = 0; m < 4; ++m) {
                const int rl = ai * 128 + wr * 64 + m * 16 + fr; const float rs = S[rl];
                float* yrow = Y + (size_t)(u.pm * 256 + rl) * D;
#pragma unroll
                for (int bj = 0; bj < 2; ++bj) {
                    const int c = col0 + bj * 128;
                    const f32x4 g0 = *(const f32x4*)(gfin + c), g1 = *(const f32x4*)(gfin + c + 4);
                    *(f32x4*)(yrow + c) = acc[ai][bj][m][0] * rs * g0; *(f32x4*)(yrow + c + 4) = acc[ai][bj][m][1] * rs * g1;
                }
            }
        __syncthreads();
    }
};
struct EpiRowBf16 {
    static constexpr bool PERM = true, AFTER_DRAIN = false, MIDSCALE = false, TWOSEG = false;
    bf16_t* O; int ldc; const float* ss; float cst;
    __device__ __forceinline__ void operator()(const f32x4 (&acc)[2][2][4][2], const Unit& u, int wr, int wc, int fr, int fq) const {
        const int row0 = u.pm * 256 + wr * 64 + fr, col0 = u.pn * 256 + wc * 32 + 8 * fq;
        float rsv[2][4];
#pragma unroll
        for (int ai = 0; ai < 2; ++ai)
#pragma unroll
            for (int m = 0; m < 4; ++m) rsv[ai][m] = ss[row0 + ai * 128 + m * 16];
#pragma unroll
        for (int ai = 0; ai < 2; ++ai)
#pragma unroll
            for (int m = 0; m < 4; ++m) {
                const int row = row0 + ai * 128 + m * 16; const float rs = rstd_of(rsv[ai][m]) * cst;
#pragma unroll
                for (int bj = 0; bj < 2; ++bj) {
                    const f32x4 v0 = acc[ai][bj][m][0] * rs, v1 = acc[ai][bj][m][1] * rs;
                    u32x4 w; w.x = cvt_pk_bf16(v0[0], v0[1]); w.y = cvt_pk_bf16(v0[2], v0[3]); w.z = cvt_pk_bf16(v1[0], v1[1]); w.w = cvt_pk_bf16(v1[2], v1[3]);
                    st16(O + (size_t)row * ldc + col0 + bj * 128, w);
                }
            }
    }
};
struct EpiMemKV {
    static constexpr bool PERM = true, AFTER_DRAIN = false, MIDSCALE = false, TWOSEG = false;
    float* out;
    __device__ __forceinline__ void operator()(const f32x4 (&acc)[2][2][4][2], const Unit& u, int wr, int wc, int fr, int fq) const {
        const int row0 = u.pm * 256 + wr * 64 + fr, col0 = u.pn * 256 + wc * 32 + 8 * fq;
#pragma unroll
        for (int ai = 0; ai < 2; ++ai)
#pragma unroll
            for (int m = 0; m < 4; ++m) {
                const int row = row0 + ai * 128 + m * 16;
#pragma unroll
                for (int bj = 0; bj < 2; ++bj) {
                    const int c = col0 + bj * 128;
                    float* dst = out + (c < 1024 ? O_MK : O_MV) + (size_t)row * 1024 + (c & 1023);
                    *(f32x4*)dst = acc[ai][bj][m][0]; *(f32x4*)(dst + 4) = acc[ai][bj][m][1];
                }
            }
    }
};
struct EpiIn {
    static constexpr bool PERM = true, AFTER_DRAIN = false, MIDSCALE = false, TWOSEG = false;
    bf16_t* P; const float* ss; const float* rope; float* out;
    __device__ __forceinline__ void operator()(const f32x4 (&acc)[2][2][4][2], const Unit& u, int wr, int wc, int fr, int fq) const {
        const int row0 = u.pm * 256 + wr * 64 + fr; const int pn = u.pn;
        const int ip = (wc & 1) * 4 + fq, hl = wc >> 1;
        float rsv[2][4];
#pragma unroll
        for (int ai = 0; ai < 2; ++ai)
#pragma unroll
            for (int m = 0; m < 4; ++m) rsv[ai][m] = ss[row0 + ai * 128 + m * 16];
#pragma unroll
        for (int ai = 0; ai < 2; ++ai) {
            f32x4 csv[4][2];
            if (pn >= 4) {
#pragma unroll
                for (int m = 0; m < 4; ++m) {
                    const int row = row0 + ai * 128 + m * 16;
                    const bool smp = row >= MP; const int pos = smp ? SEQ + ((row - MP) & 7) : (row & (SEQ - 1));
                    const float* rp = rope + ((size_t)pos * 32 + 4 * ip) * 2; csv[m][0] = *(const f32x4*)rp; csv[m][1] = *(const f32x4*)(rp + 4);
                }
            }
#pragma unroll
            for (int m = 0; m < 4; ++m) {
                const int row = row0 + ai * 128 + m * 16; const float rs = rstd_of(rsv[ai][m]);
                const bool smp = row >= MP; const int t = smp ? ((row - MP) & 7) : (row & (SEQ - 1)); const int sq = smp ? ((row - MP) >> 3) : (row >> 13);
                bf16_t* prow = P + (size_t)row * NIN;
                if (pn < 4) {
#pragma unroll
                    for (int bj = 0; bj < 2; ++bj) {
                        const int c = pn * 256 + bj * 128 + wc * 32 + 8 * fq;
                        const f32x4 v0 = acc[ai][bj][m][0] * rs, v1 = acc[ai][bj][m][1] * rs;
                        u32x4 w; w.x = cvt_pk_bf16(v0[0], v0[1]); w.y = cvt_pk_bf16(v0[2], v0[3]); w.z = cvt_pk_bf16(v1[0], v1[1]); w.w = cvt_pk_bf16(v1[2], v1[3]);
                        st16(prow + c, w);
                        if (pn < 2) {
                            float* dst = nullptr;
                            if (!smp && t >= SEQ - 3) dst = out + O_CP + ((size_t)sq * 3 + (t - (SEQ - 3))) * 512 + c;
                            else if (smp && t >= 5) dst = out + O_CS + ((size_t)sq * 3 + (t - 5)) * 512 + c;
                            if (dst) { *(f32x4*)dst = v0; *(f32x4*)(dst + 4) = v1; }
                        }
                    }
                } else {
                    const f32x4 cs0 = csv[m][0], cs1 = csv[m][1];
#pragma unroll
                    for (int bj = 0; bj < 2; ++bj) {
                        const bool isv = (pn == 6 && bj == 1);
                        if (!isv) {
                            const f32x4 z1 = acc[ai][bj][m][0] * rs, z2 = acc[ai][bj][m][1] * rs;
                            f32x4 o1, o2;
                            o1[0] = z1[0] * cs0[0] - z2[0] * cs0[1]; o2[0] = z2[0] * cs0[0] + z1[0] * cs0[1];
                            o1[1] = z1[1] * cs0[2] - z2[1] * cs0[3]; o2[1] = z2[1] * cs0[2] + z1[1] * cs0[3];
                            o1[2] = z1[2] * cs1[0] - z2[2] * cs1[1]; o2[2] = z2[2] * cs1[0] + z1[2] * cs1[1];
                            o1[3] = z1[3] * cs1[2] - z2[3] * cs1[3]; o2[3] = z2[3] * cs1[2] + z1[3] * cs1[3];
                            if (pn < 6) {
                                const int head = (pn - 4) * 4 + bj * 2 + hl; o1 = o1 * C2S; o2 = o2 * C2S;
                                bf16_t* d = prow + 1024 + head * 64 + 4 * ip;
                                u32x2 a; a.x = cvt_pk_bf16(o1[0], o1[1]); a.y = cvt_pk_bf16(o1[2], o1[3]); st8(d, a);
                                u32x2 b; b.x = cvt_pk_bf16(o2[0], o2[1]); b.y = cvt_pk_bf16(o2[2], o2[3]); st8(d + 32, b);
                            } else {
                                const int head = hl;
                                bf16_t* d = prow + 1536 + head * 64 + 4 * ip;
                                u32x2 a; a.x = cvt_pk_bf16(o1[0], o1[1]); a.y = cvt_pk_bf16(o1[2], o1[3]); st8(d, a);
                                u32x2 b; b.x = cvt_pk_bf16(o2[0], o2[1]); b.y = cvt_pk_bf16(o2[2], o2[3]); st8(d + 32, b);
                                float* dst = nullptr;
                                if (!smp && t >= SEQ - 128) dst = out + O_SKP + ((size_t)sq * 128 + (t - (SEQ - 128))) * 128 + head * 64 + 4 * ip;
                                else if (smp) dst = out + O_SKS + ((size_t)sq * 128 + 120 + t) * 128 + head * 64 + 4 * ip;
                                if (dst) { *(f32x4*)dst = o1; *(f32x4*)(dst + 32) = o2; }
                            }
                        } else {
                            const int cv = wc * 32 + 8 * fq;
                            const f32x4 v0 = acc[ai][bj][m][0] * rs, v1 = acc[ai][bj][m][1] * rs;
                            u32x4 w; w.x = cvt_pk_bf16(v0[0], v0[1]); w.y = cvt_pk_bf16(v0[2], v0[3]); w.z = cvt_pk_bf16(v1[0], v1[1]); w.w = cvt_pk_bf16(v1[2], v1[3]);
                            st16(prow + 1664 + cv, w);
                            float* dst = nullptr;
                            if (!smp && t >= SEQ - 128) dst = out + O_SVP + ((size_t)sq * 128 + (t - (SEQ - 128))) * 128 + cv;
                            else if (smp) dst = out + O_SVS + ((size_t)sq * 128 + 120 + t) * 128 + cv;
                            if (dst) { *(f32x4*)dst = v0; *(f32x4*)(dst + 4) = v1; }
                        }
                    }
                }
            }
        }
    }
};

struct Args { const float* in[37]; float* out; unsigned char* ws; double inv_rev[32]; int use_cg; int pad; };
struct Ctx {
    LAS unsigned char* lds; int tid, lane, wave, G, bid;
    const float* const* in; float* out; unsigned char* ws;
    float* SS; float* ROPE; float* SUMA; float* SUMB; bf16_t* WAB; bf16_t* XB; bf16_t* H; float* X; bf16_t* PROJ; bf16_t* MIX; bf16_t* QX; bf16_t* XO;
};
__device__ __forceinline__ float wave_sum(float v) {
#pragma unroll
    for (int o = 1; o < 64; o <<= 1) v += __shfl_xor(v, o);
    return v;
}
__device__ __forceinline__ int dst_row_of(int mode, int row_off, int n) {
    if (mode == 0) return row_off + n;
    if (mode == 1) return (n >> 7) * 256 + row_off + (n & 127);
    if (n < 1024 || n >= 1664) return n;
    const int hb = (n - 1024) >> 6, dd = (n - 1024) & 63, nn = dd >> 5, rem = dd & 31, i = rem >> 2, e = rem & 3;
    return 1024 + hb * 64 + 8 * i + 4 * nn + e;
}
struct P0Item { const float* W; bf16_t* WT; const float* g0; int K, N, mode, row_off, r; };
__device__ __forceinline__ P0Item p0_item(Ctx& F, int it) {
    unsigned char* ws = F.ws;
    constexpr int I_GU = 16 * 88, I_DN = 44 * 32, I_IN = 16 * 56, I_SQ = 16 * 32;
    static_assert(I_GU == I_DN, "");
    int r = it; P0Item d;
    if (r < I_GU) { d = P0Item{F.in[10], (bf16_t*)(ws + WS_W1GU), F.in[9], D, FF, 1, 0, r}; return d; } r -= I_GU;
    if (r < I_GU) { d = P0Item{F.in[11], (bf16_t*)(ws + WS_W1GU), F.in[9], D, FF, 1, 128, r}; return d; } r -= I_GU;
    if (r < I_DN) { d = P0Item{F.in[12], (bf16_t*)(ws + WS_W1D), nullptr, FF, D, 0, 0, r}; return d; } r -= I_DN;
    if (r < I_GU) { d = P0Item{F.in[33], (bf16_t*)(ws + WS_W2GU), F.in[32], D, FF, 1, 0, r}; return d; } r -= I_GU;
    if (r < I_GU) { d = P0Item{F.in[34], (bf16_t*)(ws + WS_W2GU), F.in[32], D, FF, 1, 128, r}; return d; } r -= I_GU;
    if (r < I_DN) { d = P0Item{F.in[35], (bf16_t*)(ws + WS_W2D), nullptr, FF, D, 0, 0, r}; return d; } r -= I_DN;
    if (r < I_IN) { d = P0Item{F.in[14], (bf16_t*)(ws + WS_WIN), F.in[13], D, NIN, 2, 0, r}; return d; } r -= I_IN;
    if (r < I_SQ / 2) { d = P0Item{F.in[25], (bf16_t*)(ws + WS_WOUT), F.in[23], 512, D, 0, 0, r}; return d; } r -= I_SQ / 2;
    if (r < I_SQ / 2) { d = P0Item{F.in[25] + 512 * 1024, (bf16_t*)(ws + WS_WOUT + MiB), F.in[24], 512, D, 0, 0, r}; return d; } r -= I_SQ / 2;
    if (r < I_SQ) { d = P0Item{F.in[28], (bf16_t*)(ws + WS_WCQ), F.in[26], D, D, 0, 0, r}; return d; } r -= I_SQ;
    if (r < I_SQ) { d = P0Item{F.in[29], (bf16_t*)(ws + WS_WCKV), nullptr, D, D, 0, 0, r}; return d; } r -= I_SQ;
    if (r < I_SQ) { d = P0Item{F.in[30], (bf16_t*)(ws + WS_WCKV), nullptr, D, D, 0, 1024, r}; return d; } r -= I_SQ;
    d = P0Item{F.in[31], (bf16_t*)(ws + WS_WCO), nullptr, D, D, 0, 0, r}; return d;
}
__device__ __forceinline__ void p0_load_item(const P0Item& d, float (&v)[32], int lane) {
    const int nblk = d.N / 32, kb = d.r / nblk, nb = d.r % nblk, k0 = 64 * kb, n0 = 32 * nb;
#pragma unroll
    for (int i = 0; i < 32; ++i) { const int k = k0 + 2 * i + (lane >> 5); v[i] = d.W[(size_t)k * d.N + n0 + (lane & 31)] * (d.g0 ? d.g0[k] : 1.0f); }
}
__device__ __forceinline__ void p0_store_item(const P0Item& d, const float (&v)[32], LAS float* scr, int lane) {
    const int nblk = d.N / 32, kb = d.r / nblk, nb = d.r % nblk, k0 = 64 * kb, n0 = 32 * nb;
#pragma unroll
    for (int i = 0; i < 32; ++i) scr[(2 * i + (lane >> 5)) * 33 + (lane & 31)] = v[i];
    asm volatile("s_waitcnt lgkmcnt(0)" ::: "memory");
    const int c = lane & 7;
#pragma unroll
    for (int j = 0; j < 4; ++j) {
        const int n = (lane >> 3) + 8 * j; const LAS float* s = scr + (8 * c) * 33 + n;
        u32x4 o; o.x = cvt_pk_bf16(s[0 * 33], s[1 * 33]); o.y = cvt_pk_bf16(s[2 * 33], s[3 * 33]); o.z = cvt_pk_bf16(s[4 * 33], s[5 * 33]); o.w = cvt_pk_bf16(s[6 * 33], s[7 * 33]);
        *(u32x4*)(d.WT + (size_t)dst_row_of(d.mode, d.row_off, n0 + n) * d.K + k0 + 8 * c) = o;
    }
    asm volatile("s_waitcnt lgkmcnt(0)" ::: "memory");
}
__device__ __forceinline__ void p0_prologue(Ctx& F, const double* inv_rev) {
    LAS float* scr = (LAS float*)(F.lds + F.wave * 16384);
    const int gw = F.bid * 8 + F.wave, NGW = F.G * 8;
    constexpr int NITEMS = 6 * 1408 + 896 + 5 * 512;
#ifndef DUP_P0A
#define DUP_P0A 0
#endif
#ifndef DUP_P0B
#define DUP_P0B 0
#endif
#ifndef DUP_P0C
#define DUP_P0C 0
#endif
    for (int rp_ = 0; rp_ <= DUP_P0A; ++rp_) {
        float cur[32]; int it = gw;
        if (it < NITEMS) { const P0Item d = p0_item(F, it); p0_load_item(d, cur, F.lane); }
        for (; it < NITEMS; it += NGW) {
            float nxt[32]; const bool more = it + NGW < NITEMS;
            if (more) { const P0Item dn = p0_item(F, it + NGW); p0_load_item(dn, nxt, F.lane); }
            const P0Item d = p0_item(F, it);
            p0_store_item(d, cur, scr, F.lane);
            if (more) {
#pragma unroll
                for (int i = 0; i < 32; ++i) cur[i] = nxt[i];
            }
        }
    }
    for (int rp_ = 0; rp_ <= DUP_P0B; ++rp_)
    for (int mb = gw; mb < M + MEMR; mb += 4 * NGW) {
        f32x4 v[4][4]; float s[4];
#pragma unroll
        for (int r = 0; r < 4; ++r) {
            const int m = mb + r * NGW; s[r] = 0.f;
            if (m < M + MEMR) {
                const float* src = m < MP ? F.in[0] + (size_t)m * D : (m < M ? F.in[1] + (size_t)(m - MP) * D : F.in[2] + (size_t)(m - M) * D);
                const f32x4* xr = (const f32x4*)src + F.lane;
#pragma unroll
                for (int j = 0; j < 4; ++j) v[r][j] = xr[64 * j];
            }
        }
#pragma unroll
        for (int r = 0; r < 4; ++r) {
            const int m = mb + r * NGW;
            if (m < M + MEMR) {
#pragma unroll
                for (int j = 0; j < 4; ++j) s[r] += (v[r][j][0] * v[r][j][0] + v[r][j][1] * v[r][j][1]) + (v[r][j][2] * v[r][j][2] + v[r][j][3] * v[r][j][3]);
                s[r] = wave_sum(s[r]);
                if (m < M) { if (F.lane == 0) F.SS[m] = s[r]; }
                else { const float rs = rstd_of(s[r]); const f32x4* gr = (const f32x4*)F.in[27] + F.lane;
#pragma unroll
                    for (int j = 0; j < 4; ++j) v[r][j] = v[r][j] * rs * gr[64 * j]; }
                u32x2* o8 = (u32x2*)(F.XB + (size_t)m * D) + F.lane;
#pragma unroll
                for (int j = 0; j < 4; ++j) { u32x2 w; w.x = pk2(v[r][j][0], v[r][j][1]); w.y = pk2(v[r][j][2], v[r][j][3]); o8[64 * j] = w; }
            }
        }
    }
    const int gt = F.bid * 512 + F.tid, NGT = F.G * 512;
    for (int rp_ = 0; rp_ <= DUP_P0C; ++rp_) {
    for (int i = gt; i < 6 * M; i += NGT) F.SS[M + i] = 0.f;
    for (int i = gt; i < ROPE_POS * 32; i += NGT) {
        const int pos = i >> 5, fi = i & 31; const double rev = (double)pos * inv_rev[fi]; const float fr = (float)(rev - floor(rev));
        F.ROPE[2 * i] = __builtin_amdgcn_cosf(fr); F.ROPE[2 * i + 1] = __builtin_amdgcn_sinf(fr);
    }
    {
        f32x4 ck[4], cv[4];
#pragma unroll
        for (int u = 0; u < 4; ++u) { const int i = gt + u * NGT; if (i < 128 * 3840) { const int n = i / 3840, r = i % 3840;
            ck[u] = ((const f32x4*)(F.in[5] + (size_t)n * 16384 + 1024))[r]; cv[u] = ((const f32x4*)(F.in[6] + (size_t)n * 16384 + 1024))[r]; } }
#pragma unroll
        for (int u = 0; u < 4; ++u) { const int i = gt + u * NGT; if (i < 128 * 3840) { const int n = i / 3840, r = i % 3840;
            ((f32x4*)(F.out + O_SKS + (size_t)n * 16384))[r] = ck[u]; ((f32x4*)(F.out + O_SVS + (size_t)n * 16384))[r] = cv[u]; } }
    }
    for (int i = gt; i < 2 * 8 * 64 * 64; i += NGT) {
        const int k = i & 63, n = (i >> 6) & 63, g = (i >> 12) & 7, mat = i >> 15;
        F.WAB[i] = f2bf((mat ? F.in[19] : F.in[17])[((size_t)g * 64 + k) * 64 + n]);
    }
    }
}
#define XB_TMO      128
#define XB_XCNT(j)  (256  + 64 * (j))
#define XB_XSUB(j)  (1280 + 64 * (j))
#define XB_XGEN(j)  (2304 + 64 * (j))
#define XB_TOP      3328
#define XB_TOPGEN   3392
#define XCD_BAR_WORDS 3456
#define XB_SPIN_CAP (1u << 18)

__device__ __forceinline__ unsigned xb_ld(unsigned* p)              { return __hip_atomic_load(p, __ATOMIC_RELAXED, __HIP_MEMORY_SCOPE_AGENT); }
__device__ __forceinline__ unsigned xb_add(unsigned* p, unsigned v) { return __hip_atomic_fetch_add(p, v, __ATOMIC_RELAXED, __HIP_MEMORY_SCOPE_AGENT); }
__device__ __forceinline__ unsigned xb_xcc_id() { return (unsigned)__builtin_amdgcn_s_getreg((3 << 11) | 20) & 0xFu; }
#define XB_SPIN(cond, bar) do { unsigned _sp = 0; while (cond) { __builtin_amdgcn_s_sleep(1); \
    if ((++_sp & 255u) == 0u) { if (xb_ld(&(bar)[XB_TMO])) break; if (_sp > XB_SPIN_CAP) { atomicAdd(&(bar)[XB_TMO], 1u); break; } } } } while (0)

struct XcdBarrier {
    unsigned* bar; unsigned x;
    volatile LAS unsigned* st;
};

__device__ __forceinline__ XcdBarrier xcd_barrier_post(unsigned* bar, volatile LAS unsigned* st) {
    XcdBarrier b; b.bar = bar; b.x = xb_xcc_id(); b.st = st;
    if (threadIdx.x == 0) (void)xb_add(&bar[XB_XCNT(b.x)], 1u);
    return b;
}
__device__ __forceinline__ void xcd_barrier_complete(unsigned* bar, unsigned x, unsigned& nloc, unsigned& nx) {
    const unsigned G = gridDim.x * gridDim.y * gridDim.z;
    unsigned sum, cnt, mine, sp = 0u;
    for (;;) {
        sum = 0u; cnt = 0u; mine = 0u;
#pragma unroll
        for (unsigned j = 0; j < 16; ++j) { const unsigned c = xb_ld(&bar[XB_XCNT(j)]); sum += c; cnt += (c > 0u) ? 1u : 0u; mine = (j == x) ? c : mine; }
        if (sum == G) break;
        __builtin_amdgcn_s_sleep(1);
        if ((++sp & 255u) == 0u) { if (xb_ld(&bar[XB_TMO])) break; if (sp > XB_SPIN_CAP) { atomicAdd(&bar[XB_TMO], 1u); break; } }
    }
    nloc = mine > 0u ? mine : 1u; nx = cnt > 0u ? cnt : 1u;
}

__device__ __forceinline__ void xcd_barrier(const XcdBarrier& b) {
    asm volatile("s_waitcnt vmcnt(0)" ::: "memory");
    __syncthreads();
    if (threadIdx.x == 0) {
        unsigned* bar = b.bar;
        __builtin_amdgcn_s_waitcnt(0);
        unsigned nloc = b.st[0], nx = b.st[1];
        if (nloc == 0u) { xcd_barrier_complete(bar, b.x, nloc, nx); b.st[0] = nloc; b.st[1] = nx; }
        const unsigned old = xb_add(&bar[XB_XSUB(b.x)], 1u);
        const unsigned gen = old / nloc;
        if (old + 1u == (gen + 1u) * nloc) {
            __builtin_amdgcn_fence(__ATOMIC_RELEASE, "agent");
            asm volatile("s_waitcnt vmcnt(0)" ::: "memory");
            const unsigned og = xb_add(&bar[XB_TOP], 1u);
            const unsigned tg = og / nx;
            if (og + 1u == (tg + 1u) * nx) xb_add(&bar[XB_TOPGEN], 1u);
            else XB_SPIN(xb_ld(&bar[XB_TOPGEN]) == tg, bar);
            __builtin_amdgcn_fence(__ATOMIC_ACQUIRE, "agent");
            xb_add(&bar[XB_XGEN(b.x)], 1u);
            asm volatile("s_waitcnt vmcnt(0)" ::: "memory");
        } else {
            XB_SPIN(xb_ld(&bar[XB_XGEN(b.x)]) == gen, bar);
            __builtin_amdgcn_fence(__ATOMIC_ACQUIRE, "agent");
            asm volatile("s_waitcnt vmcnt(0)" ::: "memory");
        }
    }
    __syncthreads();
}

template <bool SAMPLE, int PASS, int NH>
__device__ __forceinline__ void lru_tile(Ctx& F, int m0, int bn  , int k  , float* ssl) {
    const int g = F.wave, lane = F.lane, c = g * 64 + lane;
    LAS unsigned char* ldsw = F.lds + g * 16384;
    const float* conv_w = F.in[15]; const float cw0 = conv_w[c], cw1 = conv_w[512 + c], cw2 = conv_w[1024 + c], cw3 = conv_w[1536 + c], cb = F.in[16][c];
    const float ba = F.in[18][c], bi = F.in[20][c], lamv = F.in[21][c];
    const float sp8 = 8.0f * (fmaxf(-lamv, 0.f) + log1pf(__expf(-fabsf(lamv))));
    const bf16_t* Pu = F.PROJ + (size_t)m0 * NIN + c;
    const float* scv = F.in[7] + (size_t)bn * 1536 + c;
    float x0 = 0.f, x1 = 0.f, x2 = 0.f;
    if (!SAMPLE && k > 0) { x0 = bf2f(Pu[-3 * NIN]); x1 = bf2f(Pu[-2 * NIN]); x2 = bf2f(Pu[-NIN]); }
    float h = 0.f, Ap = 1.f;
    if (!SAMPLE && PASS == 2 && k > 0) {
        const float* sa = F.SUMA + (size_t)bn * 128 * 512 + c; const float* sb = F.SUMB + (size_t)bn * 128 * 512 + c;
        const int kq = (k + 3) >> 2;
        float qa[4] = {1.f, 1.f, 1.f, 1.f}, qb[4] = {0.f, 0.f, 0.f, 0.f};
#pragma unroll 4
        for (int j = 0; j < kq; ++j) {
#pragma unroll
            for (int q = 0; q < 4; ++q) { const int jj = q * kq + j; if (jj < k) { const float a = sa[(size_t)jj * 512], b = sb[(size_t)jj * 512]; qa[q] *= a; qb[q] = a * qb[q] + b; } }
        }
#pragma unroll
        for (int q = 0; q < 4; ++q) h = qa[q] * h + qb[q];
    }
    LAS float* pre_r = (LAS float*)ldsw; LAS float* pre_i = pre_r + 2048;
#pragma unroll 1
    for (int half = 0; half < NH; ++half) {
        unsigned short uu[32], gg[32]; float st[4][3], hs[4];
        {
            const bf16_t* rp = F.PROJ + ((size_t)(m0 + 32 * half) * NIN + g * 64) + (size_t)(lane >> 3) * NIN + (lane & 7) * 8;
            u32x4 wu[4], wg[4];
#pragma unroll
            for (int i = 0; i < 4; ++i) { wu[i] = *(const u32x4*)(rp + (size_t)(8 * i) * NIN); if (PASS == 2) wg[i] = *(const u32x4*)(rp + (size_t)(8 * i) * NIN + 512); }
            LAS bf16_t* ut = (LAS bf16_t*)ldsw; LAS bf16_t* gt = ut + 2048;
#pragma unroll
            for (int i = 0; i < 4; ++i) { *(LAS u32x4*)(ut + ((lane >> 3) + 8 * i) * 64 + (lane & 7) * 8) = wu[i]; if (PASS == 2) *(LAS u32x4*)(gt + ((lane >> 3) + 8 * i) * 64 + (lane & 7) * 8) = wg[i]; }
            asm volatile("s_waitcnt lgkmcnt(0)" ::: "memory");
#pragma unroll
            for (int j = 0; j < 32; ++j) { uu[j] = ut[j * 64 + lane]; gg[j] = (PASS == 2) ? gt[j * 64 + lane] : (unsigned short)0; }
            asm volatile("s_waitcnt lgkmcnt(0)" ::: "memory");
        }
        if (SAMPLE) {
#pragma unroll
            for (int sq = 0; sq < 4; ++sq) { const float* sc = scv + (size_t)(4 * half + sq) * 1536; st[sq][0] = sc[0]; st[sq][1] = sc[512]; st[sq][2] = sc[1024]; hs[sq] = F.in[8][(size_t)(bn + 4 * half + sq) * 512 + c]; }
        }
        {
            LAS bf16_t* convb = (LAS bf16_t*)(ldsw + 8192); float xa = x0, xb = x1, xc = x2;
#pragma unroll
            for (int j = 0; j < 32; ++j) {
                if (SAMPLE && (j & 7) == 0) { xa = st[j >> 3][0]; xb = st[j >> 3][1]; xc = st[j >> 3][2]; }
                const float xi = bf2f(uu[j]);
                const float cv = (((cb + cw0 * xa) + cw1 * xb) + cw2 * xc) + cw3 * xi; xa = xb; xb = xc; xc = xi;
                convb[j * 72 + lane] = (unsigned short)cvt_pk_bf16(cv, cv);
            }
        }
        asm volatile("s_waitcnt lgkmcnt(0)" ::: "memory");
        bf16x8 Af[2][2];
        {
            const LAS bf16_t* convb = (const LAS bf16_t*)(ldsw + 8192);
#pragma unroll
            for (int tt = 0; tt < 2; ++tt)
#pragma unroll
                for (int ks = 0; ks < 2; ++ks) Af[tt][ks] = *(const LAS bf16x8*)(convb + (16 * tt + (lane & 15)) * 72 + 32 * ks + 8 * (lane >> 4));
        }
        asm volatile("s_waitcnt lgkmcnt(0)" ::: "memory");
#pragma unroll
        for (int nt = 0; nt < 4; ++nt) {
            const bf16_t* wa = F.WAB + ((size_t)g * 64 + 16 * nt + (lane & 15)) * 64 + 8 * (lane >> 4); const bf16_t* wi = wa + 8 * 64 * 64;
            const bf16x8 Ba0 = *(const bf16x8*)wa, Ba1 = *(const bf16x8*)(wa + 32), Bi0 = *(const bf16x8*)wi, Bi1 = *(const bf16x8*)(wi + 32);
#pragma unroll
            for (int tt2 = 0; tt2 < 2; ++tt2) {
                f32x4 ar = (f32x4){0.f, 0.f, 0.f, 0.f}, ai = ar;
                ar = __builtin_amdgcn_mfma_f32_16x16x32_bf16(Af[tt2][0], Ba0, ar, 0, 0, 0); ar = __builtin_amdgcn_mfma_f32_16x16x32_bf16(Af[tt2][1], Ba1, ar, 0, 0, 0);
                ai = __builtin_amdgcn_mfma_f32_16x16x32_bf16(Af[tt2][0], Bi0, ai, 0, 0, 0); ai = __builtin_amdgcn_mfma_f32_16x16x32_bf16(Af[tt2][1], Bi1, ai, 0, 0, 0);
                const int nn = (16 * nt + (lane & 15)) ^ (((lane >> 4) & 1) << 4);
#pragma unroll
                for (int j = 0; j < 4; ++j) { const int il = 16 * tt2 + 4 * (lane >> 4) + j; pre_r[il * 64 + nn] = ar[j]; pre_i[il * 64 + nn] = ai[j]; }
            }
        }
        asm volatile("s_waitcnt lgkmcnt(0)" ::: "memory");
#pragma unroll
        for (int il = 0; il < 32; il += 2) {
            typedef float v2f __attribute__((ext_vector_type(2)));
            const int i = 32 * half + il; const int nn = lane ^ (((il >> 2) & 1) << 4);
            if (SAMPLE && (il & 7) == 0) { x0 = st[il >> 3][0]; x1 = st[il >> 3][1]; x2 = st[il >> 3][2]; h = hs[il >> 3]; }
            const float xa = bf2f(uu[il]), xb = bf2f(uu[il + 1]);
            v2f cv = (v2f){cb, cb} + (v2f){x0, x1} * cw0; cv = cv + (v2f){x1, x2} * cw1; cv = cv + (v2f){x2, xa} * cw2; cv = cv + (v2f){xa, xb} * cw3;
            x0 = x2; x1 = xa; x2 = xb;
            const v2f tr = ((v2f){pre_r[il * 64 + nn], pre_r[(il + 1) * 64 + nn]} + ba) * (-LOG2E), ti = ((v2f){pre_i[il * 64 + nn], pre_i[(il + 1) * 64 + nn]} + bi) * (-LOG2E);
            const v2f r = (v2f){__builtin_amdgcn_rcpf(1.0f + fexp2(tr.x)), __builtin_amdgcn_rcpf(1.0f + fexp2(tr.y))};
            const v2f gi = (v2f){__builtin_amdgcn_rcpf(1.0f + fexp2(ti.x)), __builtin_amdgcn_rcpf(1.0f + fexp2(ti.y))};
            const v2f la = r * (-sp8), al = la * LOG2E, xx = la * 2.0f;
            const v2f a = (v2f){fexp2(al.x), fexp2(al.y)};
            const v2f ser = -xx * (1.0f + xx * 0.5f * (1.0f + xx * (1.0f / 3.0f) * (1.0f + xx * 0.25f * (1.0f + xx * 0.2f * (1.0f + xx * (1.0f / 6.0f))))));
            const v2f alt = 1.0f - a * a;
            const float om0 = xx.x > -0.25f ? ser.x : alt.x, om1 = xx.y > -0.25f ? ser.y : alt.y;
            const v2f sq = (v2f){__builtin_amdgcn_sqrtf(fmaxf(om0, 0.f)), __builtin_amdgcn_sqrtf(fmaxf(om1, 0.f))};
            const v2f bb = sq * (gi * cv);
            const float h0 = a.x * h + bb.x, h1 = a.y * h0 + bb.y; h = h1;
            if (PASS == 1) Ap *= a.x * a.y;
            if (PASS == 2) {
                const v2f g2 = (v2f){bf2f(gg[il]), bf2f(gg[il + 1])};
                const v2f z = (g2 + g2 * g2 * g2 * 0.044715f) * (-2.0f * 0.7978845608028654f * LOG2E);
                const v2f sg = (v2f){__builtin_amdgcn_rcpf(1.0f + fexp2(z.x)), __builtin_amdgcn_rcpf(1.0f + fexp2(z.y))};
                const v2f yv = (v2f){h0, h1} * g2 * sg;
                const unsigned yp = cvt_pk_bf16(yv.x, yv.y);
                ((LAS unsigned*)pre_i)[il * 64 + nn] = yp & 0xffffu; ((LAS unsigned*)pre_i)[(il + 1) * 64 + nn] = yp >> 16;
                const float y0 = __uint_as_float(yp << 16), y1 = __uint_as_float(yp & 0xffff0000u);
                pre_r[il * 64 + nn] = y0 * y0; pre_r[(il + 1) * 64 + nn] = y1 * y1;
                if (SAMPLE && (il & 7) == 6) F.out[O_HS + (size_t)(bn + (i >> 3)) * 512 + c] = h1;
            }
            if ((il & 7) == 6) __builtin_amdgcn_sched_barrier(0);
        }
        asm volatile("s_waitcnt lgkmcnt(0)" ::: "memory");
        if (PASS == 2) {
            if (lane < 32) {
                float s = 0.f;
#pragma unroll 8
                for (int j = 0; j < 64; ++j) s += pre_r[lane * 64 + ((j + lane) & 63)];
                unsafeAtomicAdd(ssl + m0 + 32 * half + lane, s);
            }
            {
                const LAS unsigned* yw = (const LAS unsigned*)pre_i;
#pragma unroll
                for (int i = 0; i < 4; ++i) {
                    const int row = (lane >> 3) + 8 * i, ch8 = ((lane & 7) * 8) ^ (((row >> 2) & 1) << 4);
                    const u32x4 lo = *(const LAS u32x4*)(yw + row * 64 + ch8), hi4 = *(const LAS u32x4*)(yw + row * 64 + ch8 + 4);
                    u32x4 w; w.x = (lo.x & 0xffffu) | (lo.y << 16); w.y = (lo.z & 0xffffu) | (lo.w << 16); w.z = (hi4.x & 0xffffu) | (hi4.y << 16); w.w = (hi4.z & 0xffffu) | (hi4.w << 16);
                    st16(F.MIX + (size_t)(m0 + 32 * half + row) * 512 + g * 64 + (lane & 7) * 8, w);
                }
            }
            asm volatile("s_waitcnt lgkmcnt(0)" ::: "memory");
        }
    }
    if (PASS == 1) {
        __hip_atomic_store((unsigned*)(F.SUMA + ((size_t)bn * 128 + k) * 512 + c), __float_as_uint(Ap), __ATOMIC_RELAXED, __HIP_MEMORY_SCOPE_AGENT);
        __hip_atomic_store((unsigned*)(F.SUMB + ((size_t)bn * 128 + k) * 512 + c), __float_as_uint(h), __ATOMIC_RELAXED, __HIP_MEMORY_SCOPE_AGENT);
    }
    if (PASS == 2) { if (!SAMPLE && k == 127) F.out[O_HP + (size_t)bn * 512 + c] = h; }
}

constexpr int SWA_KS = 136, SWA_VS = 204, SWA_VOFF = 192 * SWA_KS * 2;
__device__ __forceinline__ int crow(int r, int hi) { return (r & 3) + 8 * (r >> 2) + 4 * hi; }
__device__ __forceinline__ unsigned short bf_at(const u32x4& v, int e) { return (unsigned short)(v[e >> 1] >> ((e & 1) * 16)); }
template <bool SAMPLE>
__device__ __forceinline__ void swa_qtile(Ctx& F, const bf16_t* qrow  , int kb, int tb  , int h, float sk, bf16_t* orow, float* ssrow) {
    const int lane = F.lane, q = lane & 31, hi = lane >> 5, kvh = h >> 2;
    const LAS bf16_t* Kl = (const LAS bf16_t*)F.lds; const LAS bf16_t* Vt = (const LAS bf16_t*)(F.lds + SWA_VOFF);
    bf16x8 qf[4];
#pragma unroll
    for (int ks = 0; ks < 4; ++ks) qf[ks] = *(const bf16x8*)(qrow + 16 * ks + 8 * hi);
    f32x16 s[5];
#pragma unroll
    for (int kt = 0; kt < 5; ++kt) {
        s[kt] = (f32x16){0.f, 0.f, 0.f, 0.f, 0.f, 0.f, 0.f, 0.f, 0.f, 0.f, 0.f, 0.f, 0.f, 0.f, 0.f, 0.f};
#pragma unroll
        for (int ks = 0; ks < 4; ++ks) {
            const bf16x8 a = *(const LAS bf16x8*)(Kl + (kb + 32 * kt + q) * SWA_KS + kvh * 64 + 16 * ks + 8 * hi);
            s[kt] = __builtin_amdgcn_mfma_f32_32x32x16_bf16(a, qf[ks], s[kt], 0, 0, 0);
        }
    }
    float mx = sk;
#pragma unroll
    for (int kt = 0; kt < 5; ++kt)
#pragma unroll
        for (int r = 0; r < 16; ++r) {
            const int kk = 32 * kt + crow(r, hi); bool valid;
            if (SAMPLE) valid = (kk < 128) ? (kk >= q + 1) : (kk - 128 <= q && kk < 136);
            else valid = (kk >= q + 1) && (kk <= q + 128) && (tb + kk >= 0);
            const float sv = valid ? s[kt][r] : -INFINITY; s[kt][r] = sv; mx = fmaxf(mx, sv);
        }
    mx = fmaxf(mx, __shfl_xor(mx, 32));
    float l = 0.f; bf16x8 pb[10];
#pragma unroll
    for (int kt = 0; kt < 5; ++kt) {
        float p[16];
#pragma unroll
        for (int r = 0; r < 16; ++r) { p[r] = fexp2(s[kt][r] - mx); l += p[r]; }
#pragma unroll
        for (int hf = 0; hf < 2; ++hf) {
            u32x4 w; w.x = cvt_pk_bf16(p[8 * hf + 0], p[8 * hf + 1]); w.y = cvt_pk_bf16(p[8 * hf + 2], p[8 * hf + 3]); w.z = cvt_pk_bf16(p[8 * hf + 4], p[8 * hf + 5]); w.w = cvt_pk_bf16(p[8 * hf + 6], p[8 * hf + 7]);
            pb[2 * kt + hf] = __builtin_bit_cast(bf16x8, w);
        }
    }
    l += __shfl_xor(l, 32); l += fexp2(sk - mx);
    const float inv = 1.0f / l; float sq = 0.f;
    const bool wr_ok = !SAMPLE || q < 8;
#pragma unroll
    for (int dt = 0; dt < 2; ++dt) {
        f32x16 o = (f32x16){0.f, 0.f, 0.f, 0.f, 0.f, 0.f, 0.f, 0.f, 0.f, 0.f, 0.f, 0.f, 0.f, 0.f, 0.f, 0.f};
#pragma unroll
        for (int u = 0; u < 10; ++u) {
            const LAS bf16_t* vp = Vt + (kvh * 64 + 32 * dt + q) * SWA_VS + kb + 16 * u + 4 * hi;
            const u32x2 lo = *(const LAS u32x2*)vp, hi4 = *(const LAS u32x2*)(vp + 8);
            u32x4 w; w.x = lo.x; w.y = lo.y; w.z = hi4.x; w.w = hi4.y;
            o = __builtin_amdgcn_mfma_f32_32x32x16_bf16(__builtin_bit_cast(bf16x8, w), pb[u], o, 0, 0, 0);
        }
#pragma unroll
        for (int r = 0; r < 16; ++r) { o[r] *= inv; sq += o[r] * o[r]; }
        if (wr_ok) {
#pragma unroll
            for (int rg = 0; rg < 4; ++rg) {
                u32x2 w; w.x = cvt_pk_bf16(o[4 * rg], o[4 * rg + 1]); w.y = cvt_pk_bf16(o[4 * rg + 2], o[4 * rg + 3]);
                st8(orow + 32 * dt + 8 * rg + 4 * hi, w);
            }
        }
    }
    sq += __shfl_xor(sq, 32);
    if (wr_ok && hi == 0) unsafeAtomicAdd(ssrow, sq);
}
__device__ __forceinline__ void swa_prompt_item(Ctx& F, int b, int qb, float* ssa) {
    const int tid = F.tid, lane = F.lane, h = F.wave, q = lane & 31;
    LAS bf16_t* Kl = (LAS bf16_t*)F.lds; LAS bf16_t* Vt = (LAS bf16_t*)(F.lds + SWA_VOFF);
    const int tb = 64 * qb - 128; const size_t rowbase = (size_t)b * SEQ;
    const u32x4 z4 = (u32x4){0u, 0u, 0u, 0u};
#pragma unroll
    for (int i = 0; i < 6; ++i) { const int p = tid + 512 * i, key = p >> 4, ch = p & 15, tok = tb + key;
        const u32x4 v = tok >= 0 ? *(const u32x4*)(F.PROJ + (rowbase + tok) * NIN + 1536 + ch * 8) : z4;
        *(LAS u32x4*)(Kl + key * SWA_KS + ch * 8) = v; }
#pragma unroll
    for (int i = 0; i < 3; ++i) { const int p = tid + 512 * i, ch = (p & 3) + 4 * (p / 384), kp = (p % 384) >> 2, tok = tb + 2 * kp;
        const u32x4 v0 = tok >= 0 ? *(const u32x4*)(F.PROJ + (rowbase + tok) * NIN + 1664 + ch * 8) : z4;
        const u32x4 v1 = tok + 1 >= 0 ? *(const u32x4*)(F.PROJ + (rowbase + tok + 1) * NIN + 1664 + ch * 8) : z4;
#pragma unroll
        for (int e = 0; e < 8; ++e) *(LAS unsigned*)(Vt + (ch * 8 + e) * SWA_VS + 2 * kp) = (unsigned)bf_at(v0, e) | ((unsigned)bf_at(v1, e) << 16); }
    __syncthreads();
    const float sk = F.in[22][h] * LOG2E;
    const size_t m0 = rowbase + 64 * qb;
    swa_qtile<false>(F, F.PROJ + (m0 + q) * NIN + 1024 + h * 64, 0, tb, h, sk, (F.MIX + (size_t)M * 512) + (m0 + q) * 512 + h * 64, ssa + m0 + q);
    swa_qtile<false>(F, F.PROJ + (m0 + 32 + q) * NIN + 1024 + h * 64, 32, tb + 32, h, sk, (F.MIX + (size_t)M * 512) + (m0 + 32 + q) * 512 + h * 64, ssa + m0 + 32 + q);
    __syncthreads();
}
__device__ __forceinline__ void swa_sample_item(Ctx& F, int n, float* ssa) {
    const int tid = F.tid, lane = F.lane, h = F.wave, q = lane & 31;
    LAS bf16_t* Kl = (LAS bf16_t*)F.lds; LAS bf16_t* Vt = (LAS bf16_t*)(F.lds + SWA_VOFF);
    const size_t m0 = (size_t)MP + 8 * n;
    const float* ck = F.in[5] + (size_t)n * 16384; const float* cv = F.in[6] + (size_t)n * 16384;
    const u32x4 z4 = (u32x4){0u, 0u, 0u, 0u};
#pragma unroll
    for (int i = 0; i < 5; ++i) { const int p = tid + 512 * i, key = p >> 4, ch = p & 15;
        u32x4 v = z4;
        if (key < 128) { const f32x4 a = *(const f32x4*)(ck + key * 128 + ch * 8), bq = *(const f32x4*)(ck + key * 128 + ch * 8 + 4);
            v.x = cvt_pk_bf16(a[0], a[1]); v.y = cvt_pk_bf16(a[2], a[3]); v.z = cvt_pk_bf16(bq[0], bq[1]); v.w = cvt_pk_bf16(bq[2], bq[3]); }
        else if (key < 136) v = *(const u32x4*)(F.PROJ + (m0 + key - 128) * NIN + 1536 + ch * 8);
        *(LAS u32x4*)(Kl + key * SWA_KS + ch * 8) = v; }
#pragma unroll
    for (int i = 0; i < 3; ++i) { const int p = tid + 512 * i;
        if (p < 1280) { const int ch = (p & 3) + 4 * (p / 320), kp = (p % 320) >> 2, key = 2 * kp;
            u32x4 v0 = z4, v1 = z4;
            if (key < 128) {
                const f32x4 a0 = *(const f32x4*)(cv + key * 128 + ch * 8), b0 = *(const f32x4*)(cv + key * 128 + ch * 8 + 4), a1 = *(const f32x4*)(cv + (key + 1) * 128 + ch * 8), b1 = *(const f32x4*)(cv + (key + 1) * 128 + ch * 8 + 4);
                v0.x = cvt_pk_bf16(a0[0], a0[1]); v0.y = cvt_pk_bf16(a0[2], a0[3]); v0.z = cvt_pk_bf16(b0[0], b0[1]); v0.w = cvt_pk_bf16(b0[2], b0[3]);
                v1.x = cvt_pk_bf16(a1[0], a1[1]); v1.y = cvt_pk_bf16(a1[2], a1[3]); v1.z = cvt_pk_bf16(b1[0], b1[1]); v1.w = cvt_pk_bf16(b1[2], b1[3]);
            } else if (key < 136) { v0 = *(const u32x4*)(F.PROJ + (m0 + key - 128) * NIN + 1664 + ch * 8); v1 = *(const u32x4*)(F.PROJ + (m0 + key + 1 - 128) * NIN + 1664 + ch * 8); }
#pragma unroll
            for (int e = 0; e < 8; ++e) *(LAS unsigned*)(Vt + (ch * 8 + e) * SWA_VS + 2 * kp) = (unsigned)bf_at(v0, e) | ((unsigned)bf_at(v1, e) << 16); } }
    __syncthreads();
    const float sk = F.in[22][h] * LOG2E;
    const int qc = q < 8 ? q : 7;
    swa_qtile<true>(F, F.PROJ + (m0 + qc) * NIN + 1024 + h * 64, 0, 0, h, sk, (F.MIX + (size_t)M * 512) + (m0 + qc) * 512 + h * 64, ssa + m0 + qc);
    __syncthreads();
}

constexpr int XK_S = 72, XV_S = 260, XV_OFF = 256 * XK_S * 2;
template <bool SAMPLE>
__device__ __forceinline__ void xattn_item(Ctx& F, const float* Ksrc, const float* Vsrc, int h, size_t m0) {
    const int tid = F.tid, lane = F.lane, q = lane & 31, hi = lane >> 5;
    LAS bf16_t* Kc = (LAS bf16_t*)F.lds; LAS bf16_t* Vtc = (LAS bf16_t*)(F.lds + XV_OFF);
    const bool active = SAMPLE ? (F.wave == 0) : true;
    const size_t qr = SAMPLE ? m0 + (q < 8 ? q : 7) : m0 + 32 * F.wave + q;
    const bf16_t* qrow = F.QX + qr * D + h * 256;
    f32x16 S[8];
#pragma unroll
    for (int kt = 0; kt < 8; ++kt) S[kt] = (f32x16){0.f, 0.f, 0.f, 0.f, 0.f, 0.f, 0.f, 0.f, 0.f, 0.f, 0.f, 0.f, 0.f, 0.f, 0.f, 0.f};
    f32x4 pre[8];
    const float* kbase = Ksrc + (size_t)(tid >> 4) * 1024 + h * 256 + 4 * (tid & 15);
    const float* vbase = Vsrc + (size_t)(2 * (tid >> 2)) * 1024 + h * 256 + 4 * (tid & 3);
#pragma unroll
    for (int i = 0; i < 8; ++i) pre[i] = *(const f32x4*)(kbase + (size_t)i * 32 * 1024);
    for (int ch = 0; ch < 4; ++ch) {
        __syncthreads();
#pragma unroll
        for (int i = 0; i < 8; ++i) { u32x2 w; w.x = cvt_pk_bf16(pre[i][0], pre[i][1]); w.y = cvt_pk_bf16(pre[i][2], pre[i][3]); *(LAS u32x2*)(Kc + ((tid >> 4) + 32 * i) * XK_S + 4 * (tid & 15)) = w; }
        __syncthreads();
        if (ch < 3) {
#pragma unroll
            for (int i = 0; i < 8; ++i) pre[i] = *(const f32x4*)(kbase + (size_t)i * 32 * 1024 + 64 * (ch + 1));
        } else {
#pragma unroll
            for (int i = 0; i < 4; ++i) { pre[2 * i] = *(const f32x4*)(vbase + 16 * i); pre[2 * i + 1] = *(const f32x4*)(vbase + 1024 + 16 * i); }
        }
        if (active) {
#pragma unroll 1
            for (int ks = 0; ks < 4; ++ks) {
                const bf16x8 qf = *(const bf16x8*)(qrow + 64 * ch + 16 * ks + 8 * hi);
#pragma unroll
                for (int kt = 0; kt < 8; ++kt) {
                    const bf16x8 a = *(const LAS bf16x8*)(Kc + (32 * kt + q) * XK_S + 16 * ks + 8 * hi);
                    S[kt] = __builtin_amdgcn_mfma_f32_32x32x16_bf16(a, qf, S[kt], 0, 0, 0);
                }
            }
        }
    }
    float mx = -INFINITY;
#pragma unroll
    for (int kt = 0; kt < 8; ++kt)
#pragma unroll
        for (int r = 0; r < 16; ++r) mx = fmaxf(mx, S[kt][r]);
    mx = fmaxf(mx, __shfl_xor(mx, 32));
    float l = 0.f; bf16x8 pb[16];
#pragma unroll
    for (int kt = 0; kt < 8; ++kt) {
        float p[16];
#pragma unroll
        for (int r = 0; r < 16; ++r) { p[r] = fexp2(S[kt][r] - mx); l += p[r]; }
#pragma unroll
        for (int hf = 0; hf < 2; ++hf) {
            u32x4 w; w.x = cvt_pk_bf16(p[8 * hf + 0], p[8 * hf + 1]); w.y = cvt_pk_bf16(p[8 * hf + 2], p[8 * hf + 3]); w.z = cvt_pk_bf16(p[8 * hf + 4], p[8 * hf + 5]); w.w = cvt_pk_bf16(p[8 * hf + 6], p[8 * hf + 7]);
            pb[2 * kt + hf] = __builtin_bit_cast(bf16x8, w);
        }
    }
    l += __shfl_xor(l, 32);
    const float inv = 1.0f / l;
    bf16_t* orow = F.XO + qr * D + h * 256;
    for (int ch = 0; ch < 4; ++ch) {
        __syncthreads();
#pragma unroll
        for (int i = 0; i < 4; ++i) {
#pragma unroll
            for (int e = 0; e < 4; ++e) *(LAS unsigned*)(Vtc + (4 * ((tid & 3) + 4 * i) + e) * XV_S + 2 * (tid >> 2)) = cvt_pk_bf16(pre[2 * i][e], pre[2 * i + 1][e]); }
        __syncthreads();
        if (ch < 3) {
#pragma unroll
            for (int i = 0; i < 4; ++i) { pre[2 * i] = *(const f32x4*)(vbase + 64 * (ch + 1) + 16 * i); pre[2 * i + 1] = *(const f32x4*)(vbase + 1024 + 64 * (ch + 1) + 16 * i); }
        }
        if (active) {
#pragma unroll
            for (int dt = 0; dt < 2; ++dt) {
                f32x16 o = (f32x16){0.f, 0.f, 0.f, 0.f, 0.f, 0.f, 0.f, 0.f, 0.f, 0.f, 0.f, 0.f, 0.f, 0.f, 0.f, 0.f};
#pragma unroll
                for (int u = 0; u < 16; ++u) {
                    const LAS bf16_t* vp = Vtc + (32 * dt + q) * XV_S + 16 * u + 4 * hi;
                    const u32x2 lo = *(const LAS u32x2*)vp, hi4 = *(const LAS u32x2*)(vp + 8);
                    u32x4 w; w.x = lo.x; w.y = lo.y; w.z = hi4.x; w.w = hi4.y;
                    o = __builtin_amdgcn_mfma_f32_32x32x16_bf16(__builtin_bit_cast(bf16x8, w), pb[u], o, 0, 0, 0);
                }
                if (!SAMPLE || q < 8) {
#pragma unroll
                    for (int rg = 0; rg < 4; ++rg) {
                        u32x2 w; w.x = cvt_pk_bf16(o[4 * rg] * inv, o[4 * rg + 1] * inv); w.y = cvt_pk_bf16(o[4 * rg + 2] * inv, o[4 * rg + 3] * inv);
                        st8(orow + 64 * ch + 32 * dt + 8 * rg + 4 * hi, w);
                    }
                }
            }
        }
    }
    __syncthreads();
}

struct MiniSeg { const bf16_t* A; const bf16_t* Bt; int K; const float* rowss; };
template <int MODE  , int NSEG>
__device__ __forceinline__ void mini_gemm(Ctx& F, const MiniSeg& sg0, const MiniSeg& sg1, float cscale, const float* base_s  , bf16_t* XB, float* ss_out, bf16_t* O, const float* ssin, float cst,
                                          unsigned* cnt_s = nullptr, const float* gfin = nullptr, float* Y = nullptr  ) {
    const int t = F.bid; if (t >= 256) return;
    const int lane = F.lane, w = F.wave, fr = lane & 15, fq = lane >> 4;
    const int R0 = (t >> 4) * 64, C0 = (t & 15) * 64;
    f32x4 acc[4][4];
#pragma unroll
    for (int mt = 0; mt < 4; ++mt)
#pragma unroll
        for (int nt = 0; nt < 4; ++nt) acc[mt][nt] = (f32x4){0.f, 0.f, 0.f, 0.f};
#pragma unroll
    for (int s_ = 0; s_ < NSEG; ++s_) {
        const MiniSeg& sg = s_ ? sg1 : sg0;
        const int K = sg.K, nsteps = K >> 8;
        const bf16_t* pa = sg.A + (size_t)(R0 + fr) * K + (size_t)w * (K >> 3) + 8 * fq; const bf16_t* pb = sg.Bt + (size_t)(C0 + fr) * K + (size_t)w * (K >> 3) + 8 * fq;
        f32x4 sacc[4][4];
        if (NSEG > 1) {
#pragma unroll
            for (int mt = 0; mt < 4; ++mt)
#pragma unroll
                for (int nt = 0; nt < 4; ++nt) sacc[mt][nt] = (f32x4){0.f, 0.f, 0.f, 0.f};
        }
        constexpr int NB = (NSEG > 1) ? 2 : 4;
#pragma unroll 1
        for (int s0 = 0; s0 < nsteps; s0 += NB) {
            bf16x8 a[NB][4], b[NB][4];
#pragma unroll
            for (int s = 0; s < NB; ++s)
                if (s0 + s < nsteps) {
#pragma unroll
                    for (int i = 0; i < 4; ++i) { a[s][i] = *(const bf16x8*)(pa + (size_t)(16 * i) * K + 32 * (s0 + s)); b[s][i] = *(const bf16x8*)(pb + (size_t)(16 * i) * K + 32 * (s0 + s)); }
                }
#pragma unroll
            for (int s = 0; s < NB; ++s)
                if (s0 + s < nsteps) {
#pragma unroll
                    for (int mt = 0; mt < 4; ++mt)
#pragma unroll
                        for (int nt = 0; nt < 4; ++nt) {
                            if (NSEG > 1) sacc[mt][nt] = __builtin_amdgcn_mfma_f32_16x16x32_bf16(b[s][nt], a[s][mt], sacc[mt][nt], 0, 0, 0);
                            else acc[mt][nt] = __builtin_amdgcn_mfma_f32_16x16x32_bf16(b[s][nt], a[s][mt], acc[mt][nt], 0, 0, 0);
                        }
                }
        }
        if (NSEG > 1) {
#pragma unroll
            for (int mt = 0; mt < 4; ++mt) {
                const float sc = rsqrtf(sg.rowss[MP + R0 + 16 * mt + fr] * (1.0f / 512.0f) + EPS);
#pragma unroll
                for (int nt = 0; nt < 4; ++nt) acc[mt][nt] = acc[mt][nt] + sacc[mt][nt] * sc;
            }
        }
    }
    LAS float* part = (LAS float*)(F.lds + w * 16384);
#pragma unroll
    for (int mt = 0; mt < 4; ++mt)
#pragma unroll
        for (int nt = 0; nt < 4; ++nt) { const int row = 16 * mt + fr, chn = (4 * nt + fq) ^ fr; *(LAS f32x4*)(part + row * 64 + 4 * chn) = acc[mt][nt]; }
    __syncthreads();
    const int r = 8 * w + (lane >> 3), j = lane & 7;
    f32x4 t0 = (f32x4){0.f, 0.f, 0.f, 0.f}, t1 = t0;
#pragma unroll
    for (int pw = 0; pw < 8; ++pw) {
        const LAS float* pp = (const LAS float*)(F.lds + pw * 16384) + r * 64;
        t0 = t0 + *(const LAS f32x4*)(pp + 4 * ((2 * j) ^ (r & 15))); t1 = t1 + *(const LAS f32x4*)(pp + 4 * ((2 * j + 1) ^ (r & 15)));
    }
    const int R = MP + R0 + r, C = C0 + 8 * j;
    if (MODE == 0 || MODE == 2) {
        if (NSEG == 1) { t0 = t0 * cscale; t1 = t1 * cscale; }
        f32x4 b0, b1;
        if (base_s) { b0 = *(const f32x4*)(base_s + (size_t)(R - MP) * D + C); b1 = *(const f32x4*)(base_s + (size_t)(R - MP) * D + C + 4); }
        else { const u32x4 wv = *(const u32x4*)(XB + (size_t)R * D + C);
            b0 = (f32x4){__uint_as_float(wv.x << 16), __uint_as_float(wv.x & 0xffff0000u), __uint_as_float(wv.y << 16), __uint_as_float(wv.y & 0xffff0000u)};
            b1 = (f32x4){__uint_as_float(wv.z << 16), __uint_as_float(wv.z & 0xffff0000u), __uint_as_float(wv.w << 16), __uint_as_float(wv.w & 0xffff0000u)}; }
        const f32x4 v0 = b0 + t0, v1 = b1 + t1;
        if (MODE == 0) { u32x4 wo; wo.x = cvt_pk_bf16(v0[0], v0[1]); wo.y = cvt_pk_bf16(v0[2], v0[3]); wo.z = cvt_pk_bf16(v1[0], v1[1]); wo.w = cvt_pk_bf16(v1[2], v1[3]);
            *(u32x4*)(XB + (size_t)R * D + C) = wo; }
        float sq = (v0[0] * v0[0] + v0[1] * v0[1]) + (v0[2] * v0[2] + v0[3] * v0[3]) + (v1[0] * v1[0] + v1[1] * v1[1]) + (v1[2] * v1[2] + v1[3] * v1[3]);
        sq += __shfl_xor(sq, 1); sq += __shfl_xor(sq, 2); sq += __shfl_xor(sq, 4);
        if (j == 0) unsafeAtomicAdd(ss_out + R, sq);
        if (MODE == 2) {
            asm volatile("s_waitcnt vmcnt(0)" ::: "memory");
            __syncthreads();
            if (threadIdx.x == 0) {
                unsigned* c = cnt_s + 64 * (t >> 4);
                __hip_atomic_fetch_add(c, 1u, __ATOMIC_RELAXED, __HIP_MEMORY_SCOPE_AGENT);
                unsigned sp = 0u;
                while (__hip_atomic_load(c, __ATOMIC_RELAXED, __HIP_MEMORY_SCOPE_AGENT) < 16u) { __builtin_amdgcn_s_sleep(2); if (++sp > (1u << 20)) break; }
            }
            __syncthreads();
            float s = 0.f; if (j == 0) s = unsafeAtomicAdd(ss_out + R, 0.0f);
            s = __shfl(s, lane & ~7);
            const float rs = rstd_of(s);
            const f32x4 g0 = *(const f32x4*)(gfin + C), g1 = *(const f32x4*)(gfin + C + 4);
            *(f32x4*)(Y + (size_t)R * D + C) = v0 * rs * g0; *(f32x4*)(Y + (size_t)R * D + C + 4) = v1 * rs * g1;
        }
    } else {
        const float rs = rstd_of(ssin[R]) * cst;
        const f32x4 v0 = t0 * rs, v1 = t1 * rs;
        u32x4 wo; wo.x = cvt_pk_bf16(v0[0], v0[1]); wo.y = cvt_pk_bf16(v0[2], v0[3]); wo.z = cvt_pk_bf16(v1[0], v1[1]); wo.w = cvt_pk_bf16(v1[2], v1[3]);
        st16(O + (size_t)R * D + C, wo);
    }
    __syncthreads();
}

__global__ void __launch_bounds__(512, 2) hymba_fwd(Args args) {
    extern __shared__ __attribute__((aligned(16))) unsigned char lds_raw[];
    cg::grid_group grid = cg::this_grid();
    Ctx F;
    F.lds = (LAS unsigned char*)lds_raw; F.tid = threadIdx.x; F.lane = F.tid & 63; F.wave = __builtin_amdgcn_readfirstlane(F.tid >> 6); F.G = gridDim.x; F.bid = blockIdx.x;
    F.in = args.in; F.out = args.out; F.ws = args.ws;
    unsigned char* ws = args.ws;
    F.SS = (float*)(ws + WS_SS); F.ROPE = (float*)(ws + WS_ROPE); F.SUMA = (float*)(ws + WS_SUM); F.SUMB = F.SUMA + 256 * 512; F.WAB = (bf16_t*)(ws + WS_WAB);
    F.XB = (bf16_t*)(ws + WS_XB); F.H = (bf16_t*)(ws + WS_H); F.X = (float*)(ws + WS_X); F.PROJ = (bf16_t*)(ws + WS_PROJ); F.MIX = (bf16_t*)(ws + WS_MIX);
    F.QX = (bf16_t*)(ws + WS_QX); F.XO = (bf16_t*)(ws + WS_XO);
    float* ss0 = F.SS; float* ss1 = F.SS + M; float* ss2 = F.SS + 2 * M; float* ss3 = F.SS + 3 * M; float* ss4 = F.SS + 4 * M;
    constexpr size_t WS_BAR = WS_WAB + 2 * MiB;
    unsigned* const barw = (unsigned*)(ws + WS_BAR);
    volatile LAS unsigned* const barst = (volatile LAS unsigned*)(F.lds + MISC_OFF + 8192);
    if (threadIdx.x < 2) barst[threadIdx.x] = 0u;
    __syncthreads();
    XcdBarrier xbar = xcd_barrier_post(barw, barst);
#define GRID_SYNC() xcd_barrier(xbar)
#define RETID() do { int t_ = threadIdx.x; asm volatile("" : "+v"(t_)); F.tid = t_; F.lane = t_ & 63; F.wave = __builtin_amdgcn_readfirstlane(t_ >> 6); } while (0)
#ifndef PHASE_MASK
#define PHASE_MASK 0xFFFF
#endif
#define PH(k) if constexpr (((PHASE_MASK) >> (k)) & 1)
#ifndef DUP_MASK
#define DUP_MASK 0
#endif
#ifndef EXTRA_SYNCS
#define EXTRA_SYNCS 0
#endif
#define REP(k) for (int rep = 0; rep < 1 + (((DUP_MASK) >> (k)) & 1); ++rep)
    float* const ssdummy = (float*)(ws + WS_WAB + MiB);

    PH(0) REP(0) { RETID(); p0_prologue(F, args.inv_rev); }
    if (args.use_cg) grid.sync();
    GRID_SYNC();
    for (int e = 0; e < EXTRA_SYNCS; ++e) GRID_SYNC();
    PH(1) REP(1) {
        Gemm g{F.XB, (const bf16_t*)(ws + WS_W1GU), M, 2 * FF, D}; StaticOrder S; S.init(M, 2 * FF, F.G, F.bid);
        EpiGU E{F.H, ss0};
        gemm_phase<EpiGU, StaticOrder, true, true>(F.lds, g, S, E);
        Gemm g2{F.XB + (size_t)M * D, (const bf16_t*)(ws + WS_WCKV), MEMR, 2 * D, D}; StaticOrder S2; S2.init(MEMR, 2 * D, F.G, F.G - 1 - F.bid);
        EpiMemKV E2{F.out};
        gemm_phase<EpiMemKV, StaticOrder, true, true>(F.lds, g2, S2, E2);
    }
    GRID_SYNC();
    PH(2) {
        Gemm g{F.H, (const bf16_t*)(ws + WS_W1D), MP, D, FF}; StaticOrder S; S.init(MP, D, F.G, F.bid);
        EpiRes<false, false> E{nullptr, nullptr, F.XB, ss1, 0.5f, nullptr};
        gemm_phase<EpiRes<false, false>, StaticOrder, true, true>(F.lds, g, S, E);
        RETID(); const MiniSeg s0{F.H + (size_t)MP * FF, (const bf16_t*)(ws + WS_W1D), FF, nullptr};
        mini_gemm<0, 1>(F, s0, s0, 0.5f, nullptr, F.XB, ss1, nullptr, nullptr, 0.f);
    }
    GRID_SYNC();
    PH(3) REP(3) {
        Gemm g{F.XB, (const bf16_t*)(ws + WS_WIN), M, NIN, D}; StaticOrder S; S.init(M, NIN, F.G, F.bid);
        EpiIn E{F.PROJ, ss1, F.ROPE, F.out};
        gemm_phase<EpiIn, StaticOrder, true, true>(F.lds, g, S, E);
    }
    GRID_SYNC();
    unsigned* const cntl = barw + 9216;
    PH(4) { RETID(); for (int it = F.bid; it < 256; it += F.G) lru_tile<false, 1, 2>(F, (it >> 7) * SEQ + (it & 127) * 64, it >> 7, it & 127, nullptr); }
    asm volatile("s_waitcnt vmcnt(0)" ::: "memory");
    __syncthreads();
    if (threadIdx.x == 0 && F.bid < 256) __hip_atomic_fetch_add(cntl + 64 * (F.bid >> 7), 1u, __ATOMIC_RELAXED, __HIP_MEMORY_SCOPE_AGENT);
    PH(13) REP(13) { RETID(); float* ssa = rep ? ssdummy : F.SS + 6 * M; for (int it = F.bid; it < 256 + 128; it += F.G) { if (it < 256) swa_prompt_item(F, it >> 7, it & 127, ssa); else swa_sample_item(F, it - 256, ssa); }
        if (rep == 0 && F.bid >= 128 && F.bid < 160) { const int st = F.bid - 128; lru_tile<true, 2, 1>(F, MP + st * 32, st * 4, 0, F.SS + 5 * M); } }
    if (threadIdx.x == 0 && F.bid < 256) {
        unsigned sp = 0u;
        while (__hip_atomic_load(cntl + 64 * (F.bid >> 7), __ATOMIC_RELAXED, __HIP_MEMORY_SCOPE_AGENT) < 128u) { __builtin_amdgcn_s_sleep(2); if (++sp > (1u << 20)) break; }
        __builtin_amdgcn_fence(__ATOMIC_ACQUIRE, "agent");
        asm volatile("s_waitcnt vmcnt(0)" ::: "memory");
    }
    __syncthreads();
    PH(5) REP(5) { RETID(); float* ssl = rep ? ssdummy : F.SS + 5 * M;
        for (int it = F.bid; it < 256; it += F.G) lru_tile<false, 2, 2>(F, (it >> 7) * SEQ + (it & 127) * 64, it >> 7, it & 127, ssl);
    }
    GRID_SYNC();
    PH(6) {
        StaticOrder2 S; S.init(MP, D, F.G, F.bid);
        Gemm g{F.MIX, (const bf16_t*)(ws + WS_WOUT), MP, D, 512, F.MIX + (size_t)M * 512, (const bf16_t*)(ws + WS_WOUT + MiB)};
        EpiMix E{F.XB, ss2, F.SS + 5 * M, F.SS + 6 * M};
        gemm_phase<EpiMix, StaticOrder2, true, true>(F.lds, g, S, E);
        RETID(); const MiniSeg s0{F.MIX + (size_t)MP * 512, (const bf16_t*)(ws + WS_WOUT), 512, F.SS + 5 * M}, s1{F.MIX + (size_t)(M + MP) * 512, (const bf16_t*)(ws + WS_WOUT + MiB), 512, F.SS + 6 * M};
        mini_gemm<0, 2>(F, s0, s1, 1.0f, nullptr, F.XB, ss2, nullptr, nullptr, 0.f);
    }
    GRID_SYNC();
    PH(7) REP(7) {
        Gemm g{F.XB, (const bf16_t*)(ws + WS_WCQ), MP, D, D}; StaticOrder S; S.init(MP, D, F.G, F.bid);
        EpiRowBf16 E{F.QX, D, ss2, C2X};
        gemm_phase<EpiRowBf16, StaticOrder, true, true>(F.lds, g, S, E);
        RETID(); const MiniSeg s0{F.XB + (size_t)MP * D, (const bf16_t*)(ws + WS_WCQ), D, nullptr};
        mini_gemm<1, 1>(F, s0, s0, 1.0f, nullptr, nullptr, nullptr, F.QX, ss2, C2X);
    }
    GRID_SYNC();
    PH(8) REP(8) { RETID();
        if (F.bid < 256) {
            const int itp = F.bid, b = itp >> 7, hp = (itp >> 5) & 3, qb = itp & 31;
            if (!(F.bid & 1)) xattn_item<false>(F, F.out + O_MK + (size_t)b * 262144, F.out + O_MV + (size_t)b * 262144, hp, (size_t)b * SEQ + 256 * qb);
#pragma unroll 1
            for (int sl = 0; sl < 2; ++sl) { const int j = F.bid + 256 * sl, n = j >> 2, h = j & 3;
                xattn_item<true>(F, F.in[3] + (size_t)n * 262144, F.in[4] + (size_t)n * 262144, h, (size_t)MP + 8 * n); }
            if (F.bid & 1) xattn_item<false>(F, F.out + O_MK + (size_t)b * 262144, F.out + O_MV + (size_t)b * 262144, hp, (size_t)b * SEQ + 256 * qb);
        }
    }
    GRID_SYNC();
    PH(9) {
        Gemm g{F.XO, (const bf16_t*)(ws + WS_WCO), MP, D, D}; StaticOrder S; S.init(MP, D, F.G, F.bid);
        EpiRes<false, false> E{nullptr, nullptr, F.XB, ss3, 1.0f, nullptr};
        gemm_phase<EpiRes<false, false>, StaticOrder, true, true>(F.lds, g, S, E);
        RETID(); const MiniSeg s0{F.XO + (size_t)MP * D, (const bf16_t*)(ws + WS_WCO), D, nullptr};
        mini_gemm<0, 1>(F, s0, s0, 1.0f, nullptr, F.XB, ss3, nullptr, nullptr, 0.f);
    }
    GRID_SYNC();
    PH(10) REP(10) {
        Gemm g{F.XB, (const bf16_t*)(ws + WS_W2GU), M, 2 * FF, D}; StaticOrder S; S.init(M, 2 * FF, F.G, F.bid);
        EpiGU E{F.H, ss3};
        gemm_phase<EpiGU, StaticOrder, true, true>(F.lds, g, S, E);
    }
    GRID_SYNC();
    PH(11) {
        unsigned* cntp = barw + 4096; unsigned* cnts = barw + 8192;
        Gemm g{F.H, (const bf16_t*)(ws + WS_W2D), MP, D, FF}; StaticOrder S; S.init(MP, D, F.G, F.bid);
        EpiFinal E{F.XB, ss4, cntp, F.in[36], F.out + O_Y, 0.5f};
        gemm_phase<EpiFinal, StaticOrder, false, true>(F.lds, g, S, E);
        RETID(); const MiniSeg s0{F.H + (size_t)MP * FF, (const bf16_t*)(ws + WS_W2D), FF, nullptr};
        mini_gemm<2, 1>(F, s0, s0, 0.5f, nullptr, F.XB, ss4, nullptr, nullptr, 0.f, cnts, F.in[36], F.out + O_Y);
    }
}

extern "C" void kernel_launch(void* const* d_in, const int* in_sizes, int n_in, void* d_out, int out_size, void* d_ws, size_t ws_size, hipStream_t stream) {
    static int grid = 0;
    if (grid == 0) {
        if (n_in != 37 || (size_t)out_size != O_END || ws_size < WS_END) { fprintf(stderr, "kernel_launch: unexpected shapes: n_in %d out %d (want %zu) ws %zu (want >= %zu)\n", n_in, out_size, (size_t)O_END, ws_size, (size_t)WS_END); grid = -1; return; }
        int dev = 0, cus = 0, per_cu = 0;
        hipGetDevice(&dev); hipDeviceGetAttribute(&cus, hipDeviceAttributeMultiprocessorCount, dev);
        if (hipFuncSetAttribute((const void*)hymba_fwd, hipFuncAttributeMaxDynamicSharedMemorySize, LDS_BYTES) != hipSuccess) { fprintf(stderr, "kernel_launch: hipFuncSetAttribute failed\n"); grid = -1; return; }
        if (hipOccupancyMaxActiveBlocksPerMultiprocessor(&per_cu, (const void*)hymba_fwd, 512, LDS_BYTES) != hipSuccess || per_cu < 1) { fprintf(stderr, "kernel_launch: occupancy query says %d blocks/CU\n", per_cu); (void)hipGetLastError(); per_cu = 1; }
        grid = cus;
        if (grid != 256) fprintf(stderr, "kernel_launch: note: %d CUs\n", grid);
    }
    if (grid < 0) return;
    Args a; memset(&a, 0, sizeof(a));
    for (int i = 0; i < 37; ++i) a.in[i] = (const float*)d_in[i];
    a.out = (float*)d_out; a.ws = (unsigned char*)d_ws;
    for (int i = 0; i < 32; ++i) a.inv_rev[i] = std::pow(10000.0, -(double)i / 32.0) / 6.283185307179586476925;
    a.use_cg = 0;
    if (hipMemsetAsync((char*)d_ws + WS_WAB + 2 * MiB, 0, 40960, stream) != hipSuccess) { fprintf(stderr, "kernel_launch: memset of barrier words failed\n"); return; }
    void* kargs[] = {&a};
    hipError_t e = hipLaunchCooperativeKernel((const void*)hymba_fwd, dim3(grid), dim3(512), kargs, LDS_BYTES, stream);
    if (e != hipSuccess) fprintf(stderr, "kernel_launch: cooperative launch failed: %s (grid %d)\n", hipGetErrorString(e), grid);
}
```

```cpp
#include <hip/hip_runtime.h>
#include <hip/hip_cooperative_groups.h>
#include <cstdio>
#include <cstdint>
#include <cmath>
#include <cstring>
namespace cg = cooperative_groups;
namespace pg8 {
#define PG8_LAS __attribute__((address_space(3)))
typedef unsigned short bf16_t;
typedef short bf16x8 __attribute__((ext_vector_type(8)));
typedef float f32x4 __attribute__((ext_vector_type(4)));
typedef unsigned u32x4 __attribute__((ext_vector_type(4)));
constexpr int BM = 256, BK = 64, HALF = 128, HTB = HALF * BK * 2  , STAGE_BYTES = 8 * HTB, NXCD = 8, WGM = 8;

__host__ __device__ __forceinline__ int lds_byte(int r, int c) { const int st = (r >> 4) * 2 + (c >> 5), rr = r & 15, cc = c & 31, ob = rr * 64 + cc * 2; return st * 1024 + (ob ^ (((ob >> 9) & 1) << 5)); }
__host__ __device__ __forceinline__ void stage_rc(int b, int& R, int& C) { const int st = b / 1024, sb = b % 1024, swz = sb ^ (((sb >> 9) & 1) << 5); R = (st >> 1) * 16 + swz / 64; C = (st & 1) * 32 + (swz % 64) / 2; }
__host__ __device__ __forceinline__ int perm32(int rho) { const int n = rho >> 4, i = rho & 15; return 8 * (i >> 2) + 4 * n + (i & 3); }

struct Unit { int pm, pn, seg; };
struct Gemm { const bf16_t* A; const bf16_t* Bt; int M, N, K; const bf16_t* A2; const bf16_t* Bt2; };

struct StaticOrder {
    int nM, nN, nwg, G, c;
    __host__ __device__ void init(int M, int N, int G_, int c_) { nM = M / BM; nN = N / BM; nwg = nM * nN; G = G_; c = c_; }
    __host__ __device__ bool next(int i, Unit& u) const {
        const long L = (long)i * G + c; if (L >= nwg) return false;
        int wgid = (int)L; { const int q = nwg / NXCD, r = nwg % NXCD, xcd = wgid % NXCD, off = wgid / NXCD; wgid = (xcd < r ? xcd * (q + 1) : r * (q + 1) + (xcd - r) * q) + off; }
        const int nig = WGM * nN, gid = wgid / nig, fm = gid * WGM, gsz = (nM - fm) < WGM ? (nM - fm) : WGM;
        u.pm = fm + ((wgid % nig) % gsz); u.pn = (wgid % nig) / gsz; u.seg = 0; return true;
    }
    __device__ __forceinline__ void a_ready(const Unit&) const {}
    __device__ __forceinline__ void done(const Unit&) const {}
};

__device__ __forceinline__ unsigned cvt_pk_bf16(float lo, float hi) { unsigned r; asm volatile("v_cvt_pk_bf16_f32 %0, %1, %2" : "=v"(r) : "v"(lo), "v"(hi)); return r; }

template <class Epi, class Sched, bool ALIGN_EPI = false, bool SP2 = false>
__device__ __forceinline__ void gemm_phase(PG8_LAS unsigned char* lds, const Gemm g, const Sched& S, const Epi& E) {
    int tid_ = threadIdx.x; asm volatile("" : "+v"(tid_)); const int tid = tid_, wid = __builtin_amdgcn_readfirstlane(tid >> 6), lane = tid & 63, wr = wid >> 2, wc = wid & 3, fr = lane & 15, fq = lane >> 4;
    const int K = g.K, nt = K / BK;
    unsigned voffA[2], voffB[2];
#pragma unroll
    for (int i = 0; i < 2; ++i) { int R, C; stage_rc(tid * 16 + i * 8192, R, C); const int Rb = Epi::PERM ? ((R & ~31) + perm32(R & 31)) : R;
        voffA[i] = (unsigned)(R * K + C) * 2u; voffB[i] = (unsigned)(Rb * K + C) * 2u; }
    const size_t kstep = (size_t)(BK * 2);
    const size_t hstep = (size_t)HALF * K * 2;
    const size_t tstep = 2 * hstep;
    const unsigned ldsw = (unsigned)wid * 1024u;
    const int aoff = lds_byte(wr * 64 + fr, fq * 8), boff = lds_byte(wc * 32 + fr, fq * 8);
#define PG8_SA(b, h) (((b) * 2 + (h)) * HTB)
#define PG8_SB(b, h) ((4 + (b) * 2 + (h)) * HTB)
#define PG8_STAGE(bufoff, gbase, voff) do { _Pragma("unroll") for (int _i = 0; _i < 2; ++_i) \
        __builtin_amdgcn_global_load_lds((const unsigned*)((const char*)(gbase) + (voff)[_i]), (PG8_LAS unsigned*)(lds + (bufoff) + ldsw + _i * 8192), 16, 0, 0); } while (0)
#define PG8_LDA(dst, b, h) do { _Pragma("unroll") for (int m = 0; m < 4; ++m) _Pragma("unroll") for (int k = 0; k < 2; ++k) dst[m][k] = *(const PG8_LAS bf16x8*)(lds + PG8_SA(b, h) + aoff + m * 2048 + k * 1024); } while (0)
#define PG8_LDB(dst, b, h) do { _Pragma("unroll") for (int n = 0; n < 2; ++n) _Pragma("unroll") for (int k = 0; k < 2; ++k) dst[n][k] = *(const PG8_LAS bf16x8*)(lds + PG8_SB(b, h) + boff + n * 2048 + k * 1024); } while (0)
#define PG8_MMA(ai, bj, At, Bt) do { __builtin_amdgcn_s_setprio(1); _Pragma("unroll") for (int m = 0; m < 4; ++m) _Pragma("unroll") for (int n = 0; n < 2; ++n) _Pragma("unroll") for (int k = 0; k < 2; ++k) \
        acc[ai][bj][m][n] = __builtin_amdgcn_mfma_f32_16x16x32_bf16(Bt[n][k], At[m][k], acc[ai][bj][m][n], 0, 0, 0); __builtin_amdgcn_s_setprio(0); } while (0)
#define PG8_WAIT_V(n) asm volatile("s_waitcnt vmcnt(" #n ")" ::: "memory")
#define PG8_WAIT_L(n) asm volatile("s_waitcnt lgkmcnt(" #n ")" ::: "memory")
#define PG8_BAR __builtin_amdgcn_s_barrier()
#define PG8_SCHED __builtin_amdgcn_sched_barrier(0)
    Unit cur, nxt; int ui = 0;
    if (!S.next(0, cur)) return;
    f32x4 acc[2][2][4][2];
#pragma unroll
    for (int a = 0; a < 2; ++a)
#pragma unroll
        for (int b = 0; b < 2; ++b)
#pragma unroll
            for (int m = 0; m < 4; ++m)
#pragma unroll
                for (int n = 0; n < 2; ++n) acc[a][b][m][n] = (f32x4){0.f, 0.f, 0.f, 0.f};
    bf16x8 At[4][2], B0[2][2], B1[2][2];
    const char* cA = (const char*)((Epi::TWOSEG && cur.seg) ? g.A2 : g.A) + (size_t)cur.pm * tstep; const char* cB = (const char*)((Epi::TWOSEG && cur.seg) ? g.Bt2 : g.Bt) + (size_t)cur.pn * tstep;
    S.a_ready(cur);
    if constexpr (SP2) {
        PG8_STAGE(PG8_SB(0, 0), cB, voffB); PG8_STAGE(PG8_SB(0, 1), cB + hstep, voffB); PG8_STAGE(PG8_SA(0, 0), cA, voffA); PG8_STAGE(PG8_SA(0, 1), cA + hstep, voffA);
        if (wr == 1) PG8_BAR;
        PG8_WAIT_V(2); PG8_BAR;
        PG8_STAGE(PG8_SB(1, 0), cB + kstep, voffB); PG8_STAGE(PG8_SA(1, 0), cA + kstep, voffA); PG8_STAGE(PG8_SB(1, 1), cB + hstep + kstep, voffB);
        PG8_WAIT_V(6); PG8_BAR;
    } else {
        PG8_STAGE(PG8_SB(0, 0), cB, voffB); PG8_STAGE(PG8_SA(0, 0), cA, voffA); PG8_STAGE(PG8_SB(0, 1), cB + hstep, voffB); PG8_STAGE(PG8_SA(0, 1), cA + hstep, voffA);
        if (wr == 1) PG8_BAR;
        PG8_WAIT_V(4); PG8_BAR;
        PG8_STAGE(PG8_SB(1, 0), cB + kstep, voffB); PG8_STAGE(PG8_SA(1, 0), cA + kstep, voffA); PG8_STAGE(PG8_SB(1, 1), cB + hstep + kstep, voffB);
        PG8_WAIT_V(6); PG8_BAR;
    }
    for (;;) {
        const bool has_next = S.next(ui + 1, nxt);
        const char* nA = has_next ? (const char*)((Epi::TWOSEG && nxt.seg) ? g.A2 : g.A) + (size_t)nxt.pm * tstep : cA; const char* nB = has_next ? (const char*)((Epi::TWOSEG && nxt.seg) ? g.Bt2 : g.Bt) + (size_t)nxt.pn * tstep : cB;
        for (int t = 0; t < nt; t += 2) {
            const bool last = (t == nt - 2);
            if constexpr (Epi::MIDSCALE) { if (t == nt / 2) E.mid(acc, cur, wr, wc, fr, fq); }
            const char* a1 = cA + (size_t)(t + 1) * kstep;
            const char* a2 = last ? nA : cA + (size_t)(t + 2) * kstep; const char* b2 = last ? nB : cB + (size_t)(t + 2) * kstep;
            const char* a3 = a2 + kstep; const char* b3 = b2 + kstep;
            if (last && has_next) S.a_ready(nxt);
            if constexpr (SP2) {
            PG8_LDB(B0, 0, 0); PG8_LDB(B1, 0, 1); PG8_SCHED; PG8_LDA(At, 0, 0); PG8_STAGE(PG8_SA(1, 1), a1 + hstep, voffA);
            PG8_WAIT_V(8); PG8_WAIT_L(0); PG8_BAR; PG8_MMA(0, 0, At, B0); PG8_MMA(0, 1, At, B1); PG8_BAR; PG8_SCHED;
            PG8_LDA(At, 0, 1); PG8_STAGE(PG8_SB(0, 0), b2, voffB); PG8_STAGE(PG8_SB(0, 1), b2 + hstep, voffB); PG8_STAGE(PG8_SA(0, 0), a2, voffA);
            PG8_WAIT_V(8); PG8_WAIT_L(0); PG8_BAR; PG8_MMA(1, 0, At, B0); PG8_MMA(1, 1, At, B1); PG8_BAR; PG8_SCHED;
            PG8_LDB(B0, 1, 0); PG8_LDB(B1, 1, 1); PG8_SCHED; PG8_LDA(At, 1, 0); PG8_STAGE(PG8_SA(0, 1), a2 + hstep, voffA);
            PG8_WAIT_V(8); PG8_WAIT_L(0); PG8_BAR; PG8_MMA(0, 0, At, B0); PG8_MMA(0, 1, At, B1); PG8_BAR; PG8_SCHED;
            PG8_LDA(At, 1, 1); PG8_STAGE(PG8_SB(1, 0), b3, voffB); PG8_STAGE(PG8_SB(1, 1), b3 + hstep, voffB); PG8_STAGE(PG8_SA(1, 0), a3, voffA);
            PG8_WAIT_V(8); PG8_WAIT_L(0); PG8_BAR; PG8_MMA(1, 0, At, B0); PG8_MMA(1, 1, At, B1); PG8_BAR; PG8_SCHED;
            } else {
            PG8_LDB(B0, 0, 0); PG8_SCHED; PG8_LDA(At, 0, 0); PG8_STAGE(PG8_SA(1, 1), a1 + hstep, voffA);
            PG8_WAIT_L(8); PG8_BAR; PG8_WAIT_L(0); PG8_MMA(0, 0, At, B0); PG8_BAR; PG8_SCHED;
            PG8_LDB(B1, 0, 1); PG8_STAGE(PG8_SB(0, 0), b2, voffB);
            PG8_BAR; PG8_WAIT_L(0); PG8_MMA(0, 1, At, B1); PG8_BAR;
            PG8_LDA(At, 0, 1); PG8_STAGE(PG8_SA(0, 0), a2, voffA);
            PG8_BAR; PG8_WAIT_L(0); PG8_MMA(1, 0, At, B0); PG8_BAR; PG8_SCHED;
            PG8_STAGE(PG8_SB(0, 1), b2 + hstep, voffB);
            PG8_WAIT_V(6); PG8_BAR; PG8_MMA(1, 1, At, B1); PG8_BAR;
            PG8_LDB(B0, 1, 0); PG8_SCHED; PG8_LDA(At, 1, 0); PG8_STAGE(PG8_SA(0, 1), a2 + hstep, voffA);
            PG8_WAIT_L(8); PG8_BAR; PG8_WAIT_L(0); PG8_MMA(0, 0, At, B0); PG8_BAR; PG8_SCHED;
            PG8_LDB(B1, 1, 1); PG8_STAGE(PG8_SB(1, 0), b3, voffB);
            PG8_BAR; PG8_WAIT_L(0); PG8_MMA(0, 1, At, B1); PG8_BAR;
            PG8_LDA(At, 1, 1); PG8_STAGE(PG8_SA(1, 0), a3, voffA);
            PG8_BAR; PG8_WAIT_L(0); PG8_MMA(1, 0, At, B0); PG8_BAR; PG8_SCHED;
            PG8_STAGE(PG8_SB(1, 1), b3 + hstep, voffB);
            PG8_WAIT_V(6); PG8_BAR; PG8_MMA(1, 1, At, B1); PG8_BAR;
            }
        }
        if constexpr (ALIGN_EPI) { if (wr == 0) PG8_BAR; }
        bool keep_acc = false;
        if constexpr (Epi::TWOSEG) { if (cur.seg == 0) { E.mid(acc, cur, wr, wc, fr, fq); keep_acc = true; } else { E(acc, cur, wr, wc, fr, fq); } }
        else if constexpr (!Epi::AFTER_DRAIN) { E(acc, cur, wr, wc, fr, fq); S.done(cur); }
        if (!has_next) break;
        if (!keep_acc) {
#pragma unroll
        for (int a = 0; a < 2; ++a)
#pragma unroll
            for (int b = 0; b < 2; ++b)
#pragma unroll
                for (int m = 0; m < 4; ++m)
#pragma unroll
                    for (int n = 0; n < 2; ++n) acc[a][b][m][n] = (f32x4){0.f, 0.f, 0.f, 0.f};
        }
        cur = nxt; cA = nA; cB = nB; ++ui;
        if constexpr (ALIGN_EPI) { if (wr == 1) PG8_BAR; }
    }
    PG8_WAIT_V(0);
    if constexpr (!ALIGN_EPI) { if (wr == 0) PG8_BAR; }
    PG8_BAR;
    if constexpr (Epi::AFTER_DRAIN) { E.fused(acc, cur, wr, wc, fr, fq, lds, wid, lane); S.done(cur); }
#undef PG8_SA
#undef PG8_SB
#undef PG8_STAGE
#undef PG8_LDA
#undef PG8_LDB
#undef PG8_MMA
#undef PG8_WAIT_V
#undef PG8_WAIT_L
#undef PG8_BAR
#undef PG8_SCHED
}
}
using namespace pg8;
#define LAS __attribute__((address_space(3)))
typedef float f32x16 __attribute__((ext_vector_type(16)));
typedef unsigned u32x2 __attribute__((ext_vector_type(2)));

constexpr int D = 1024, MP = 16384, MS = 1024, M = MP + MS, FF = 2816, NIN = 1792, SEQ = 8192, MEMR = 512;
constexpr float EPS = 1e-6f, LOG2E = 1.4426950408889634f;
constexpr float C2S = 0.125f * LOG2E;
constexpr float C2X = 0.0625f * LOG2E;
constexpr size_t O_Y = 0, O_MK = (size_t)M * D, O_MV = O_MK + 524288, O_SKP = O_MV + 524288, O_SVP = O_SKP + 32768, O_CP = O_SVP + 32768,
                 O_HP = O_CP + 3072, O_SKS = O_HP + 1024, O_SVS = O_SKS + 2097152, O_CS = O_SVS + 2097152, O_HS = O_CS + 196608, O_END = O_HS + 65536;
constexpr size_t MiB = 1u << 20;
constexpr size_t WS_SS = 0, WS_ROPE = MiB / 2, WS_SUM = 3 * MiB, WS_WAB = 4 * MiB, WS_W1GU = 8 * MiB, WS_WCKV = 19 * MiB, WS_W1D = 23 * MiB, WS_WIN = 29 * MiB,
                 WS_WOUT = 33 * MiB, WS_WCQ = 35 * MiB, WS_WCO = 37 * MiB, WS_W2GU = 39 * MiB, WS_W2D = 50 * MiB, WS_XB = 56 * MiB, WS_H = 91 * MiB, WS_X = 185 * MiB,
                 WS_PROJ = 253 * MiB, WS_MIX = 313 * MiB, WS_QX = 347 * MiB, WS_XO = 381 * MiB, WS_END = 415 * MiB;
constexpr int ROPE_POS = 8200;
constexpr int RING_BYTES = 131072, MISC_OFF = RING_BYTES, LDS_BYTES = 147456;

__device__ __forceinline__ float bf2f(unsigned short b) { return __uint_as_float((unsigned)b << 16); }
__device__ __forceinline__ unsigned short f2bf(float f) { unsigned u = __float_as_uint(f); return (unsigned short)((u + 0x7fffu + ((u >> 16) & 1u)) >> 16); }
__device__ __forceinline__ unsigned pk2(float lo, float hi) { return (unsigned)f2bf(lo) | ((unsigned)f2bf(hi) << 16); }
__device__ __forceinline__ float rstd_of(float ss) { return rsqrtf(ss * (1.0f / 1024.0f) + EPS); }
__device__ __forceinline__ float fexp2(float x) { return __builtin_amdgcn_exp2f(x); }
__device__ __forceinline__ float sigmoidf_(float x) { return __builtin_amdgcn_rcpf(1.0f + fexp2(-x * LOG2E)); }
__device__ __forceinline__ float silu_mul(float g, float u) { return g * u * sigmoidf_(g); }
__device__ __forceinline__ float gelu_tanh(float x) { const float z = 0.7978845608028654f * (x + 0.044715f * x * x * x); return x * sigmoidf_(2.0f * z); }

__device__ __forceinline__ void st16(void* p, u32x4 v) { *(u32x4*)p = v; }
__device__ __forceinline__ void st8(void* p, u32x2 v) { *(u32x2*)p = v; }
struct EpiGU {
    static constexpr bool PERM = true, AFTER_DRAIN = false, MIDSCALE = false, TWOSEG = false;
    bf16_t* H; const float* ss;
    __device__ __forceinline__ void operator()(const f32x4 (&acc)[2][2][4][2], const Unit& u, int wr, int wc, int fr, int fq) const {
        const int row0 = u.pm * 256 + wr * 64 + fr, col0 = u.pn * 128 + wc * 32 + 8 * fq;
        float rsv[2][4];
#pragma unroll
        for (int ai = 0; ai < 2; ++ai)
#pragma unroll
            for (int m = 0; m < 4; ++m) rsv[ai][m] = ss[row0 + ai * 128 + m * 16];
#pragma unroll
        for (int ai = 0; ai < 2; ++ai)
#pragma unroll
            for (int m = 0; m < 4; ++m) {
                const int row = row0 + ai * 128 + m * 16; const float rs = rstd_of(rsv[ai][m]);
                const f32x4 g0 = acc[ai][0][m][0] * rs, g1 = acc[ai][0][m][1] * rs, u0 = acc[ai][1][m][0] * rs, u1 = acc[ai][1][m][1] * rs;
                u32x4 w;
                w.x = cvt_pk_bf16(silu_mul(g0[0], u0[0]), silu_mul(g0[1], u0[1])); w.y = cvt_pk_bf16(silu_mul(g0[2], u0[2]), silu_mul(g0[3], u0[3]));
                w.z = cvt_pk_bf16(silu_mul(g1[0], u1[0]), silu_mul(g1[1], u1[1])); w.w = cvt_pk_bf16(silu_mul(g1[2], u1[2]), silu_mul(g1[3], u1[3]));
                st16(H + (size_t)row * FF + col0, w);
            }
    }
};
template <bool ROWSCALE, bool F32BASE>
struct EpiRes {
    static constexpr bool PERM = true, AFTER_DRAIN = false, MIDSCALE = false, TWOSEG = false;
    const float* base_p; const float* base_s; bf16_t* XB; float* ss_out; float scale; const float* rowss;
    __device__ __forceinline__ void operator()(const f32x4 (&acc)[2][2][4][2], const Unit& u, int wr, int wc, int fr, int fq) const {
        const int row0 = u.pm * 256 + wr * 64 + fr, col0 = u.pn * 256 + wc * 32 + 8 * fq;
#pragma unroll
        for (int ai = 0; ai < 2; ++ai) {
            f32x4 bv[4][2][2]; float scv[4];
#pragma unroll
            for (int m = 0; m < 4; ++m) {
                const int row = row0 + ai * 128 + m * 16;
                scv[m] = ROWSCALE ? rowss[row] : 0.f;
                if (F32BASE) {
                    const float* b = row < MP ? base_p + (size_t)row * D : base_s + (size_t)(row - MP) * D;
#pragma unroll
                    for (int bj = 0; bj < 2; ++bj) { bv[m][bj][0] = *(const f32x4*)(b + col0 + bj * 128); bv[m][bj][1] = *(const f32x4*)(b + col0 + bj * 128 + 4); }
                } else {
#pragma unroll
                    for (int bj = 0; bj < 2; ++bj) {
                        const u32x4 w = *(const u32x4*)(XB + (size_t)row * D + col0 + bj * 128);
                        bv[m][bj][0] = (f32x4){__uint_as_float(w.x << 16), __uint_as_float(w.x & 0xffff0000u), __uint_as_float(w.y << 16), __uint_as_float(w.y & 0xffff0000u)};
                        bv[m][bj][1] = (f32x4){__uint_as_float(w.z << 16), __uint_as_float(w.z & 0xffff0000u), __uint_as_float(w.w << 16), __uint_as_float(w.w & 0xffff0000u)};
                    }
                }
            }
#pragma unroll
            for (int m = 0; m < 4; ++m) {
                const int row = row0 + ai * 128 + m * 16;
                const float sc = ROWSCALE ? rsqrtf(scv[m] * (1.0f / 512.0f) + EPS) : scale; float sq = 0.f;
#pragma unroll
                for (int bj = 0; bj < 2; ++bj) {
                    const int c = col0 + bj * 128;
                    const f32x4 v0 = bv[m][bj][0] + acc[ai][bj][m][0] * sc, v1 = bv[m][bj][1] + acc[ai][bj][m][1] * sc;
                    u32x4 w; w.x = cvt_pk_bf16(v0[0], v0[1]); w.y = cvt_pk_bf16(v0[2], v0[3]); w.z = cvt_pk_bf16(v1[0], v1[1]); w.w = cvt_pk_bf16(v1[2], v1[3]);
                    *(u32x4*)(XB + (size_t)row * D + c) = w;
                    sq += (v0[0] * v0[0] + v0[1] * v0[1]) + (v0[2] * v0[2] + v0[3] * v0[3]) + (v1[0] * v1[0] + v1[1] * v1[1]) + (v1[2] * v1[2] + v1[3] * v1[3]);
                }
                if (ss_out) { sq += __shfl_xor(sq, 16); sq += __shfl_xor(sq, 32); if (fq == 0) unsafeAtomicAdd(ss_out + row, sq); }
            }
        }
    }
};
struct EpiMix {
    static constexpr bool PERM = true, AFTER_DRAIN = false, MIDSCALE = false, TWOSEG = true;
    bf16_t* XB; float* ss_out; const float* ssl; const float* ssa;
    __device__ __forceinline__ void mid(f32x4 (&acc)[2][2][4][2], const Unit& u, int wr, int wc, int fr, int fq) const {
        const int row0 = u.pm * 256 + wr * 64 + fr;
        float sl[2][4], sa[2][4];
#pragma unroll
        for (int ai = 0; ai < 2; ++ai)
#pragma unroll
            for (int m = 0; m < 4; ++m) { sl[ai][m] = ssl[row0 + ai * 128 + m * 16]; sa[ai][m] = ssa[row0 + ai * 128 + m * 16]; }
#pragma unroll
        for (int ai = 0; ai < 2; ++ai)
#pragma unroll
            for (int m = 0; m < 4; ++m) {
                const float ratio = rsqrtf(sl[ai][m] * (1.0f / 512.0f) + EPS) * sqrtf(sa[ai][m] * (1.0f / 512.0f) + EPS);
#pragma unroll
                for (int bj = 0; bj < 2; ++bj)
#pragma unroll
                    for (int n = 0; n < 2; ++n) acc[ai][bj][m][n] = acc[ai][bj][m][n] * ratio;
            }
    }
    __device__ __forceinline__ void operator()(const f32x4 (&acc)[2][2][4][2], const Unit& u, int wr, int wc, int fr, int fq) const {
        const EpiRes<true, false> E{nullptr, nullptr, XB, ss_out, 1.0f, ssa};
        E(acc, u, wr, wc, fr, fq);
    }
};
struct StaticOrder2 {
    StaticOrder S;
    __host__ __device__ void init(int M, int N, int G_, int c_) { S.init(M, N, G_, c_); }
    __host__ __device__ bool next(int i, Unit& u) const { const bool ok = S.next(i >> 1, u); u.seg = i & 1; return ok; }
    __device__ __forceinline__ void a_ready(const Unit&) const {}
    __device__ __forceinline__ void done(const Unit&) const {}
};
struct EpiFinal {
    static constexpr bool PERM = true, AFTER_DRAIN = true, MIDSCALE = false, TWOSEG = false;
    const bf16_t* XB; float* ss; unsigned* cnt; const float* gfin; float* Y; float scale;
    __device__ __forceinline__ void fused(f32x4 (&acc)[2][2][4][2], const Unit& u, int wr, int wc, int fr, int fq, PG8_LAS unsigned char* lds, int wid, int lane) const {
        const int row0 = u.pm * 256 + wr * 64 + fr, col0 = u.pn * 256 + wc * 32 + 8 * fq;
#pragma unroll
        for (int ai = 0; ai < 2; ++ai) {
            u32x4 bw[4][2];
#pragma unroll
            for (int m = 0; m < 4; ++m)
#pragma unroll
                for (int bj = 0; bj < 2; ++bj) bw[m][bj] = *(const u32x4*)(XB + (size_t)(row0 + ai * 128 + m * 16) * D + col0 + bj * 128);
#pragma unroll
            for (int m = 0; m < 4; ++m) {
                float sq = 0.f;
#pragma unroll
                for (int bj = 0; bj < 2; ++bj) {
                    const u32x4 w = bw[m][bj];
                    const f32x4 b0 = (f32x4){__uint_as_float(w.x << 16), __uint_as_float(w.x & 0xffff0000u), __uint_as_float(w.y << 16), __uint_as_float(w.y & 0xffff0000u)};
                    const f32x4 b1 = (f32x4){__uint_as_float(w.z << 16), __uint_as_float(w.z & 0xffff0000u), __uint_as_float(w.w << 16), __uint_as_float(w.w & 0xffff0000u)};
                    const f32x4 v0 = b0 + acc[ai][bj][m][0] * scale, v1 = b1 + acc[ai][bj][m][1] * scale;
                    acc[ai][bj][m][0] = v0; acc[ai][bj][m][1] = v1;
                    sq += (v0[0] * v0[0] + v0[1] * v0[1]) + (v0[2] * v0[2] + v0[3] * v0[3]) + (v1[0] * v1[0] + v1[1] * v1[1]) + (v1[2] * v1[2] + v1[3] * v1[3]);
                }
                sq += __shfl_xor(sq, 16); sq += __shfl_xor(sq, 32);
                if (fq == 0) unsafeAtomicAdd(ss + row0 + ai * 128 + m * 16, sq);
            }
        }
        asm volatile("s_waitcnt vmcnt(0)" ::: "memory");
        __syncthreads();
        if (threadIdx.x == 0) {
            unsigned* c = cnt + 64 * u.pm;
            __hip_atomic_fetch_add(c, 1u, __ATOMIC_RELAXED, __HIP_MEMORY_SCOPE_AGENT);
            unsigned sp = 0u;
            while (__hip_atomic_load(c, __ATOMIC_RELAXED, __HIP_MEMORY_SCOPE_AGENT) < 4u) { __builtin_amdgcn_s_sleep(2); if (++sp > (1u << 20)) break; }
        }
        __syncthreads();
        PG8_LAS float* S = (PG8_LAS float*)lds;
        if (threadIdx.x < 256) S[threadIdx.x] = rstd_of(unsafeAtomicAdd(ss + u.pm * 256 + (int)threadIdx.x, 0.0f));
        __syncthreads();
#pragma unroll
        for (int ai = 0; ai < 2; ++ai)
#pragma unroll
            for (int m = 0; m < 4; ++m) {
                const int rl = ai * 128 + wr * 64 + m * 16 + fr; const float rs = S[rl];
                float* yrow = Y + (size_t)(u.pm * 256 + rl) * D;
#pragma unroll
                for (int bj = 0; bj < 2; ++bj) {
                    const int c = col0 + bj * 128;
                    const f32x4 g0 = *(const f32x4*)(gfin + c), g1 = *(const f32x4*)(gfin + c + 4);
                    __builtin_nontemporal_store(acc[ai][bj][m][0] * rs * g0, (f32x4*)(yrow + c)); __builtin_nontemporal_store(acc[ai][bj][m][1] * rs * g1, (f32x4*)(yrow + c + 4));
                }
            }
        __syncthreads();
    }
};
struct EpiRowBf16 {
    static constexpr bool PERM = true, AFTER_DRAIN = false, MIDSCALE = false, TWOSEG = false;
    bf16_t* O; int ldc; const float* ss; float cst;
    __device__ __forceinline__ void operator()(const f32x4 (&acc)[2][2][4][2], const Unit& u, int wr, int wc, int fr, int fq) const {
        const int row0 = u.pm * 256 + wr * 64 + fr, col0 = u.pn * 256 + wc * 32 + 8 * fq;
        float rsv[2][4];
#pragma unroll
        for (int ai = 0; ai < 2; ++ai)
#pragma unroll
            for (int m = 0; m < 4; ++m) rsv[ai][m] = ss[row0 + ai * 128 + m * 16];
#pragma unroll
        for (int ai = 0; ai < 2; ++ai)
#pragma unroll
            for (int m = 0; m < 4; ++m) {
                const int row = row0 + ai * 128 + m * 16; const float rs = rstd_of(rsv[ai][m]) * cst;
#pragma unroll
                for (int bj = 0; bj < 2; ++bj) {
                    const f32x4 v0 = acc[ai][bj][m][0] * rs, v1 = acc[ai][bj][m][1] * rs;
                    u32x4 w; w.x = cvt_pk_bf16(v0[0], v0[1]); w.y = cvt_pk_bf16(v0[2], v0[3]); w.z = cvt_pk_bf16(v1[0], v1[1]); w.w = cvt_pk_bf16(v1[2], v1[3]);
                    st16(O + (size_t)row * ldc + col0 + bj * 128, w);
                }
            }
    }
};
struct EpiMemKV {
    static constexpr bool PERM = true, AFTER_DRAIN = false, MIDSCALE = false, TWOSEG = false;
    float* out;
    __device__ __forceinline__ void operator()(const f32x4 (&acc)[2][2][4][2], const Unit& u, int wr, int wc, int fr, int fq) const {
        const int row0 = u.pm * 256 + wr * 64 + fr, col0 = u.pn * 256 + wc * 32 + 8 * fq;
#pragma unroll
        for (int ai = 0; ai < 2; ++ai)
#pragma unroll
            for (int m = 0; m < 4; ++m) {
                const int row = row0 + ai * 128 + m * 16;
#pragma unroll
                for (int bj = 0; bj < 2; ++bj) {
                    const int c = col0 + bj * 128;
                    float* dst = out + (c < 1024 ? O_MK : O_MV) + (size_t)row * 1024 + (c & 1023);
                    *(f32x4*)dst = acc[ai][bj][m][0]; *(f32x4*)(dst + 4) = acc[ai][bj][m][1];
                }
            }
    }
};
struct EpiIn {
    static constexpr bool PERM = true, AFTER_DRAIN = false, MIDSCALE = false, TWOSEG = false;
    bf16_t* P; const float* ss; const float* rope; float* out;
    __device__ __forceinline__ void operator()(const f32x4 (&acc)[2][2][4][2], const Unit& u, int wr, int wc, int fr, int fq) const {
        const int row0 = u.pm * 256 + wr * 64 + fr; const int pn = u.pn;
        const int ip = (wc & 1) * 4 + fq, hl = wc >> 1;
        float rsv[2][4];
#pragma unroll
        for (int ai = 0; ai < 2; ++ai)
#pragma unroll
            for (int m = 0; m < 4; ++m) rsv[ai][m] = ss[row0 + ai * 128 + m * 16];
#pragma unroll
        for (int ai = 0; ai < 2; ++ai) {
            f32x4 csv[4][2];
            if (pn >= 4) {
#pragma unroll
                for (int m = 0; m < 4; ++m) {
                    const int row = row0 + ai * 128 + m * 16;
                    const bool smp = row >= MP; const int pos = smp ? SEQ + ((row - MP) & 7) : (row & (SEQ - 1));
                    const float* rp = rope + ((size_t)pos * 32 + 4 * ip) * 2; csv[m][0] = *(const f32x4*)rp; csv[m][1] = *(const f32x4*)(rp + 4);
                }
            }
#pragma unroll
            for (int m = 0; m < 4; ++m) {
                const int row = row0 + ai * 128 + m * 16; const float rs = rstd_of(rsv[ai][m]);
                const bool smp = row >= MP; const int t = smp ? ((row - MP) & 7) : (row & (SEQ - 1)); const int sq = smp ? ((row - MP) >> 3) : (row >> 13);
                bf16_t* prow = P + (size_t)row * NIN;
                if (pn < 4) {
#pragma unroll
                    for (int bj = 0; bj < 2; ++bj) {
                        const int c = pn * 256 + bj * 128 + wc * 32 + 8 * fq;
                        const f32x4 v0 = acc[ai][bj][m][0] * rs, v1 = acc[ai][bj][m][1] * rs;
                        u32x4 w; w.x = cvt_pk_bf16(v0[0], v0[1]); w.y = cvt_pk_bf16(v0[2], v0[3]); w.z = cvt_pk_bf16(v1[0], v1[1]); w.w = cvt_pk_bf16(v1[2], v1[3]);
                        st16(prow + c, w);
                        if (pn < 2) {
                            float* dst = nullptr;
                            if (!smp && t >= SEQ - 3) dst = out + O_CP + ((size_t)sq * 3 + (t - (SEQ - 3))) * 512 + c;
                            else if (smp && t >= 5) dst = out + O_CS + ((size_t)sq * 3 + (t - 5)) * 512 + c;
                            if (dst) { *(f32x4*)dst = v0; *(f32x4*)(dst + 4) = v1; }
                        }
                    }
                } else {
                    const f32x4 cs0 = csv[m][0], cs1 = csv[m][1];
#pragma unroll
                    for (int bj = 0; bj < 2; ++bj) {
                        const bool isv = (pn == 6 && bj == 1);
                        if (!isv) {
                            const f32x4 z1 = acc[ai][bj][m][0] * rs, z2 = acc[ai][bj][m][1] * rs;
                            f32x4 o1, o2;
                            o1[0] = z1[0] * cs0[0] - z2[0] * cs0[1]; o2[0] = z2[0] * cs0[0] + z1[0] * cs0[1];
                            o1[1] = z1[1] * cs0[2] - z2[1] * cs0[3]; o2[1] = z2[1] * cs0[2] + z1[1] * cs0[3];
                            o1[2] = z1[2] * cs1[0] - z2[2] * cs1[1]; o2[2] = z2[2] * cs1[0] + z1[2] * cs1[1];
                            o1[3] = z1[3] * cs1[2] - z2[3] * cs1[3]; o2[3] = z2[3] * cs1[2] + z1[3] * cs1[3];
                            if (pn < 6) {
                                const int head = (pn - 4) * 4 + bj * 2 + hl; o1 = o1 * C2S; o2 = o2 * C2S;
                                bf16_t* d = prow + 1024 + head * 64 + 4 * ip;
                                u32x2 a; a.x = cvt_pk_bf16(o1[0], o1[1]); a.y = cvt_pk_bf16(o1[2], o1[3]); st8(d, a);
                                u32x2 b; b.x = cvt_pk_bf16(o2[0], o2[1]); b.y = cvt_pk_bf16(o2[2], o2[3]); st8(d + 32, b);
                            } else {
                                const int head = hl;
                                bf16_t* d = prow + 1536 + head * 64 + 4 * ip;
                                u32x2 a; a.x = cvt_pk_bf16(o1[0], o1[1]); a.y = cvt_pk_bf16(o1[2], o1[3]); st8(d, a);
                                u32x2 b; b.x = cvt_pk_bf16(o2[0], o2[1]); b.y = cvt_pk_bf16(o2[2], o2[3]); st8(d + 32, b);
                                float* dst = nullptr;
                                if (!smp && t >= SEQ - 128) dst = out + O_SKP + ((size_t)sq * 128 + (t - (SEQ - 128))) * 128 + head * 64 + 4 * ip;
                                else if (smp) dst = out + O_SKS + ((size_t)sq * 128 + 120 + t) * 128 + head * 64 + 4 * ip;
                                if (dst) { *(f32x4*)dst = o1; *(f32x4*)(dst + 32) = o2; }
                            }
                        } else {
                            const int cv = wc * 32 + 8 * fq;
                            const f32x4 v0 = acc[ai][bj][m][0] * rs, v1 = acc[ai][bj][m][1] * rs;
                            u32x4 w; w.x = cvt_pk_bf16(v0[0], v0[1]); w.y = cvt_pk_bf16(v0[2], v0[3]); w.z = cvt_pk_bf16(v1[0], v1[1]); w.w = cvt_pk_bf16(v1[2], v1[3]);
                            st16(prow + 1664 + cv, w);
                            float* dst = nullptr;
                            if (!smp && t >= SEQ - 128) dst = out + O_SVP + ((size_t)sq * 128 + (t - (SEQ - 128))) * 128 + cv;
                            else if (smp) dst = out + O_SVS + ((size_t)sq * 128 + 120 + t) * 128 + cv;
                            if (dst) { *(f32x4*)dst = v0; *(f32x4*)(dst + 4) = v1; }
                        }
                    }
                }
            }
        }
    }
};

struct Args { const float* in[37]; float* out; unsigned char* ws; double inv_rev[32]; int use_cg; int pad; };
struct Ctx {
    LAS unsigned char* lds; int tid, lane, wave, G, bid;
    const float* const* in; float* out; unsigned char* ws;
    float* SS; float* ROPE; float* SUMA; float* SUMB; bf16_t* WAB; bf16_t* XB; bf16_t* H; float* X; bf16_t* PROJ; bf16_t* MIX; bf16_t* QX; bf16_t* XO;
};
__device__ __forceinline__ float wave_sum(float v) {
#pragma unroll
    for (int o = 1; o < 64; o <<= 1) v += __shfl_xor(v, o);
    return v;
}
__device__ __forceinline__ int dst_row_of(int mode, int row_off, int n) {
    if (mode == 0) return row_off + n;
    if (mode == 1) return (n >> 7) * 256 + row_off + (n & 127);
    if (n < 1024 || n >= 1664) return n;
    const int hb = (n - 1024) >> 6, dd = (n - 1024) & 63, nn = dd >> 5, rem = dd & 31, i = rem >> 2, e = rem & 3;
    return 1024 + hb * 64 + 8 * i + 4 * nn + e;
}
struct P0Item { const float* W; bf16_t* WT; const float* g0; int K, N, mode, row_off, r; };
__device__ __forceinline__ P0Item p0_item(Ctx& F, int it) {
    unsigned char* ws = F.ws;
    constexpr int I_GU = 16 * 88, I_DN = 44 * 32, I_IN = 16 * 56, I_SQ = 16 * 32;
    static_assert(I_GU == I_DN, "");
    int r = it; P0Item d;
    if (r < I_GU) { d = P0Item{F.in[10], (bf16_t*)(ws + WS_W1GU), F.in[9], D, FF, 1, 0, r}; return d; } r -= I_GU;
    if (r < I_GU) { d = P0Item{F.in[11], (bf16_t*)(ws + WS_W1GU), F.in[9], D, FF, 1, 128, r}; return d; } r -= I_GU;
    if (r < I_DN) { d = P0Item{F.in[12], (bf16_t*)(ws + WS_W1D), nullptr, FF, D, 0, 0, r}; return d; } r -= I_DN;
    if (r < I_GU) { d = P0Item{F.in[33], (bf16_t*)(ws + WS_W2GU), F.in[32], D, FF, 1, 0, r}; return d; } r -= I_GU;
    if (r < I_GU) { d = P0Item{F.in[34], (bf16_t*)(ws + WS_W2GU), F.in[32], D, FF, 1, 128, r}; return d; } r -= I_GU;
    if (r < I_DN) { d = P0Item{F.in[35], (bf16_t*)(ws + WS_W2D), nullptr, FF, D, 0, 0, r}; return d; } r -= I_DN;
    if (r < I_IN) { d = P0Item{F.in[14], (bf16_t*)(ws + WS_WIN), F.in[13], D, NIN, 2, 0, r}; return d; } r -= I_IN;
    if (r < I_SQ / 2) { d = P0Item{F.in[25], (bf16_t*)(ws + WS_WOUT), F.in[23], 512, D, 0, 0, r}; return d; } r -= I_SQ / 2;
    if (r < I_SQ / 2) { d = P0Item{F.in[25] + 512 * 1024, (bf16_t*)(ws + WS_WOUT + MiB), F.in[24], 512, D, 0, 0, r}; return d; } r -= I_SQ / 2;
    if (r < I_SQ) { d = P0Item{F.in[28], (bf16_t*)(ws + WS_WCQ), F.in[26], D, D, 0, 0, r}; return d; } r -= I_SQ;
    if (r < I_SQ) { d = P0Item{F.in[29], (bf16_t*)(ws + WS_WCKV), nullptr, D, D, 0, 0, r}; return d; } r -= I_SQ;
    if (r < I_SQ) { d = P0Item{F.in[30], (bf16_t*)(ws + WS_WCKV), nullptr, D, D, 0, 1024, r}; return d; } r -= I_SQ;
    d = P0Item{F.in[31], (bf16_t*)(ws + WS_WCO), nullptr, D, D, 0, 0, r}; return d;
}
__device__ __forceinline__ void p0_load_item(const P0Item& d, float (&v)[32], int lane) {
    const int nblk = d.N / 32, kb = d.r / nblk, nb = d.r % nblk, k0 = 64 * kb, n0 = 32 * nb;
#pragma unroll
    for (int i = 0; i < 32; ++i) { const int k = k0 + 2 * i + (lane >> 5); v[i] = __builtin_nontemporal_load(d.W + (size_t)k * d.N + n0 + (lane & 31)) * (d.g0 ? d.g0[k] : 1.0f); }
}
__device__ __forceinline__ void p0_store_item(const P0Item& d, const float (&v)[32], LAS float* scr, int lane) {
    const int nblk = d.N / 32, kb = d.r / nblk, nb = d.r % nblk, k0 = 64 * kb, n0 = 32 * nb;
#pragma unroll
    for (int i = 0; i < 32; ++i) scr[(2 * i + (lane >> 5)) * 33 + (lane & 31)] = v[i];
    asm volatile("s_waitcnt lgkmcnt(0)" ::: "memory");
    const int c = lane & 7;
#pragma unroll
    for (int j = 0; j < 4; ++j) {
        const int n = (lane >> 3) + 8 * j; const LAS float* s = scr + (8 * c) * 33 + n;
        u32x4 o; o.x = cvt_pk_bf16(s[0 * 33], s[1 * 33]); o.y = cvt_pk_bf16(s[2 * 33], s[3 * 33]); o.z = cvt_pk_bf16(s[4 * 33], s[5 * 33]); o.w = cvt_pk_bf16(s[6 * 33], s[7 * 33]);
        *(u32x4*)(d.WT + (size_t)dst_row_of(d.mode, d.row_off, n0 + n) * d.K + k0 + 8 * c) = o;
    }
    asm volatile("s_waitcnt lgkmcnt(0)" ::: "memory");
}
__device__ __forceinline__ void p0_prologue(Ctx& F, const double* inv_rev) {
    LAS float* scr = (LAS float*)(F.lds + F.wave * 16384);
    const int gw = F.bid * 8 + F.wave, NGW = F.G * 8;
    constexpr int NITEMS = 6 * 1408 + 896 + 5 * 512;
#ifndef DUP_P0A
#define DUP_P0A 0
#endif
#ifndef DUP_P0B
#define DUP_P0B 0
#endif
#ifndef DUP_P0C
#define DUP_P0C 0
#endif
    for (int rp_ = 0; rp_ <= DUP_P0A; ++rp_) {
        float cur[32]; int it = gw;
        if (it < NITEMS) { const P0Item d = p0_item(F, it); p0_load_item(d, cur, F.lane); }
        for (; it < NITEMS; it += NGW) {
            float nxt[32]; const bool more = it + NGW < NITEMS;
            if (more) { const P0Item dn = p0_item(F, it + NGW); p0_load_item(dn, nxt, F.lane); }
            const P0Item d = p0_item(F, it);
            p0_store_item(d, cur, scr, F.lane);
            if (more) {
#pragma unroll
                for (int i = 0; i < 32; ++i) cur[i] = nxt[i];
            }
        }
    }
    for (int rp_ = 0; rp_ <= DUP_P0B; ++rp_)
    for (int mb = gw; mb < M + MEMR; mb += 4 * NGW) {
        f32x4 v[4][4]; float s[4];
#pragma unroll
        for (int r = 0; r < 4; ++r) {
            const int m = mb + r * NGW; s[r] = 0.f;
            if (m < M + MEMR) {
                const float* src = m < MP ? F.in[0] + (size_t)m * D : (m < M ? F.in[1] + (size_t)(m - MP) * D : F.in[2] + (size_t)(m - M) * D);
                const f32x4* xr = (const f32x4*)src + F.lane;
#pragma unroll
                for (int j = 0; j < 4; ++j) v[r][j] = __builtin_nontemporal_load(xr + 64 * j);
            }
        }
#pragma unroll
        for (int r = 0; r < 4; ++r) {
            const int m = mb + r * NGW;
            if (m < M + MEMR) {
#pragma unroll
                for (int j = 0; j < 4; ++j) s[r] += (v[r][j][0] * v[r][j][0] + v[r][j][1] * v[r][j][1]) + (v[r][j][2] * v[r][j][2] + v[r][j][3] * v[r][j][3]);
                s[r] = wave_sum(s[r]);
                if (m < M) { if (F.lane == 0) F.SS[m] = s[r]; }
                else { const float rs = rstd_of(s[r]); const f32x4* gr = (const f32x4*)F.in[27] + F.lane;
#pragma unroll
                    for (int j = 0; j < 4; ++j) v[r][j] = v[r][j] * rs * gr[64 * j]; }
                u32x2* o8 = (u32x2*)(F.XB + (size_t)m * D) + F.lane;
#pragma unroll
                for (int j = 0; j < 4; ++j) { u32x2 w; w.x = pk2(v[r][j][0], v[r][j][1]); w.y = pk2(v[r][j][2], v[r][j][3]); o8[64 * j] = w; }
            }
        }
    }
    const int gt = F.bid * 512 + F.tid, NGT = F.G * 512;
    for (int rp_ = 0; rp_ <= DUP_P0C; ++rp_) {
    for (int i = gt; i < 6 * M; i += NGT) F.SS[M + i] = 0.f;
    for (int i = gt; i < ROPE_POS * 32; i += NGT) {
        const int pos = i >> 5, fi = i & 31; const double rev = (double)pos * inv_rev[fi]; const float fr = (float)(rev - floor(rev));
        F.ROPE[2 * i] = __builtin_amdgcn_cosf(fr); F.ROPE[2 * i + 1] = __builtin_amdgcn_sinf(fr);
    }
    {
        f32x4 ck[4], cv[4];
#pragma unroll
        for (int u = 0; u < 4; ++u) { const int i = gt + u * NGT; if (i < 128 * 3840) { const int n = i / 3840, r = i % 3840;
            ck[u] = __builtin_nontemporal_load((const f32x4*)(F.in[5] + (size_t)n * 16384 + 1024) + r); cv[u] = __builtin_nontemporal_load((const f32x4*)(F.in[6] + (size_t)n * 16384 + 1024) + r); } }
#pragma unroll
        for (int u = 0; u < 4; ++u) { const int i = gt + u * NGT; if (i < 128 * 3840) { const int n = i / 3840, r = i % 3840;
            ((f32x4*)(F.out + O_SKS + (size_t)n * 16384))[r] = ck[u]; ((f32x4*)(F.out + O_SVS + (size_t)n * 16384))[r] = cv[u]; } }
    }
    for (int i = gt; i < 2 * 8 * 64 * 64; i += NGT) {
        const int k = i & 63, n = (i >> 6) & 63, g = (i >> 12) & 7, mat = i >> 15;
        F.WAB[i] = f2bf((mat ? F.in[19] : F.in[17])[((size_t)g * 64 + k) * 64 + n]);
    }
    }
}
#define XB_TMO      128
#define XB_XCNT(j)  (256  + 64 * (j))
#define XB_XSUB(j)  (1280 + 64 * (j))
#define XB_XGEN(j)  (2304 + 64 * (j))
#define XB_TOP      3328
#define XB_TOPGEN   3392
#define XCD_BAR_WORDS 3456
#define XB_SPIN_CAP (1u << 18)

__device__ __forceinline__ unsigned xb_ld(unsigned* p)              { return __hip_atomic_load(p, __ATOMIC_RELAXED, __HIP_MEMORY_SCOPE_AGENT); }
__device__ __forceinline__ unsigned xb_add(unsigned* p, unsigned v) { return __hip_atomic_fetch_add(p, v, __ATOMIC_RELAXED, __HIP_MEMORY_SCOPE_AGENT); }
__device__ __forceinline__ unsigned xb_xcc_id() { return (unsigned)__builtin_amdgcn_s_getreg((3 << 11) | 20) & 0xFu; }
#define XB_SPIN(cond, bar) do { unsigned _sp = 0; while (cond) { __builtin_amdgcn_s_sleep(1); \
    if ((++_sp & 255u) == 0u) { if (xb_ld(&(bar)[XB_TMO])) break; if (_sp > XB_SPIN_CAP) { atomicAdd(&(bar)[XB_TMO], 1u); break; } } } } while (0)

struct XcdBarrier {
    unsigned* bar; unsigned x;
    volatile LAS unsigned* st;
};

__device__ __forceinline__ XcdBarrier xcd_barrier_post(unsigned* bar, volatile LAS unsigned* st) {
    XcdBarrier b; b.bar = bar; b.x = xb_xcc_id(); b.st = st;
    if (threadIdx.x == 0) (void)xb_add(&bar[XB_XCNT(b.x)], 1u);
    return b;
}
__device__ __forceinline__ void xcd_barrier_complete(unsigned* bar, unsigned x, unsigned& nloc, unsigned& nx) {
    const unsigned G = gridDim.x * gridDim.y * gridDim.z;
    unsigned sum, cnt, mine, sp = 0u;
    for (;;) {
        sum = 0u; cnt = 0u; mine = 0u;
#pragma unroll
        for (unsigned j = 0; j < 16; ++j) { const unsigned c = xb_ld(&bar[XB_XCNT(j)]); sum += c; cnt += (c > 0u) ? 1u : 0u; mine = (j == x) ? c : mine; }
        if (sum == G) break;
        __builtin_amdgcn_s_sleep(1);
        if ((++sp & 255u) == 0u) { if (xb_ld(&bar[XB_TMO])) break; if (sp > XB_SPIN_CAP) { atomicAdd(&bar[XB_TMO], 1u); break; } }
    }
    nloc = mine > 0u ? mine : 1u; nx = cnt > 0u ? cnt : 1u;
}

__device__ __forceinline__ void xcd_barrier(const XcdBarrier& b) {
    asm volatile("s_waitcnt vmcnt(0)" ::: "memory");
    __syncthreads();
    if (threadIdx.x == 0) {
        unsigned* bar = b.bar;
        __builtin_amdgcn_s_waitcnt(0);
        unsigned nloc = b.st[0], nx = b.st[1];
        if (nloc == 0u) { xcd_barrier_complete(bar, b.x, nloc, nx); b.st[0] = nloc; b.st[1] = nx; }
        const unsigned old = xb_add(&bar[XB_XSUB(b.x)], 1u);
        const unsigned gen = old / nloc;
        if (old + 1u == (gen + 1u) * nloc) {
            __builtin_amdgcn_fence(__ATOMIC_RELEASE, "agent");
            asm volatile("s_waitcnt vmcnt(0)" ::: "memory");
            const unsigned og = xb_add(&bar[XB_TOP], 1u);
            const unsigned tg = og / nx;
            if (og + 1u == (tg + 1u) * nx) xb_add(&bar[XB_TOPGEN], 1u);
            else XB_SPIN(xb_ld(&bar[XB_TOPGEN]) == tg, bar);
            __builtin_amdgcn_fence(__ATOMIC_ACQUIRE, "agent");
            xb_add(&bar[XB_XGEN(b.x)], 1u);
            asm volatile("s_waitcnt vmcnt(0)" ::: "memory");
        } else {
            XB_SPIN(xb_ld(&bar[XB_XGEN(b.x)]) == gen, bar);
            __builtin_amdgcn_fence(__ATOMIC_ACQUIRE, "agent");
            asm volatile("s_waitcnt vmcnt(0)" ::: "memory");
        }
    }
    __syncthreads();
}

template <bool SAMPLE, int PASS, int NH>
__device__ __forceinline__ void lru_tile(Ctx& F, int m0, int bn  , int k  , float* ssl) {
    const int g = F.wave, lane = F.lane, c = g * 64 + lane;
    LAS unsigned char* ldsw = F.lds + g * 16384;
    const float* conv_w = F.in[15]; const float cw0 = conv_w[c], cw1 = conv_w[512 + c], cw2 = conv_w[1024 + c], cw3 = conv_w[1536 + c], cb = F.in[16][c];
    const float ba = F.in[18][c], bi = F.in[20][c], lamv = F.in[21][c];
    const float sp8 = 8.0f * (fmaxf(-lamv, 0.f) + log1pf(__expf(-fabsf(lamv))));
    const bf16_t* Pu = F.PROJ + (size_t)m0 * NIN + c;
    const float* scv = F.in[7] + (size_t)bn * 1536 + c;
    float x0 = 0.f, x1 = 0.f, x2 = 0.f;
    if (!SAMPLE && k > 0) { x0 = bf2f(Pu[-3 * NIN]); x1 = bf2f(Pu[-2 * NIN]); x2 = bf2f(Pu[-NIN]); }
    float h = 0.f, Ap = 1.f;
    if (!SAMPLE && PASS == 2 && k > 0) {
        const float* sa = F.SUMA + (size_t)bn * 128 * 512 + c; const float* sb = F.SUMB + (size_t)bn * 128 * 512 + c;
        const int kq = (k + 3) >> 2;
        float qa[4] = {1.f, 1.f, 1.f, 1.f}, qb[4] = {0.f, 0.f, 0.f, 0.f};
#pragma unroll 4
        for (int j = 0; j < kq; ++j) {
#pragma unroll
            for (int q = 0; q < 4; ++q) { const int jj = q * kq + j; if (jj < k) { const float a = sa[(size_t)jj * 512], b = sb[(size_t)jj * 512]; qa[q] *= a; qb[q] = a * qb[q] + b; } }
        }
#pragma unroll
        for (int q = 0; q < 4; ++q) h = qa[q] * h + qb[q];
    }
    LAS float* pre_r = (LAS float*)ldsw; LAS float* pre_i = pre_r + 2048;
#pragma unroll 1
    for (int half = 0; half < NH; ++half) {
        unsigned short uu[32], gg[32]; float st[4][3], hs[4];
        {
            const bf16_t* rp = F.PROJ + ((size_t)(m0 + 32 * half) * NIN + g * 64) + (size_t)(lane >> 3) * NIN + (lane & 7) * 8;
            u32x4 wu[4], wg[4];
#pragma unroll
            for (int i = 0; i < 4; ++i) { wu[i] = *(const u32x4*)(rp + (size_t)(8 * i) * NIN); if (PASS == 2) wg[i] = *(const u32x4*)(rp + (size_t)(8 * i) * NIN + 512); }
            LAS bf16_t* ut = (LAS bf16_t*)ldsw; LAS bf16_t* gt = ut + 2048;
#pragma unroll
            for (int i = 0; i < 4; ++i) { *(LAS u32x4*)(ut + ((lane >> 3) + 8 * i) * 64 + (lane & 7) * 8) = wu[i]; if (PASS == 2) *(LAS u32x4*)(gt + ((lane >> 3) + 8 * i) * 64 + (lane & 7) * 8) = wg[i]; }
            asm volatile("s_waitcnt lgkmcnt(0)" ::: "memory");
#pragma unroll
            for (int j = 0; j < 32; ++j) { uu[j] = ut[j * 64 + lane]; gg[j] = (PASS == 2) ? gt[j * 64 + lane] : (unsigned short)0; }
            asm volatile("s_waitcnt lgkmcnt(0)" ::: "memory");
        }
        if (SAMPLE) {
#pragma unroll
            for (int sq = 0; sq < 4; ++sq) { const float* sc = scv + (size_t)(4 * half + sq) * 1536; st[sq][0] = sc[0]; st[sq][1] = sc[512]; st[sq][2] = sc[1024]; hs[sq] = F.in[8][(size_t)(bn + 4 * half + sq) * 512 + c]; }
        }
        {
            LAS bf16_t* convb = (LAS bf16_t*)(ldsw + 8192); float xa = x0, xb = x1, xc = x2;
#pragma unroll
            for (int j = 0; j < 32; ++j) {
                if (SAMPLE && (j & 7) == 0) { xa = st[j >> 3][0]; xb = st[j >> 3][1]; xc = st[j >> 3][2]; }
                const float xi = bf2f(uu[j]);
                const float cv = (((cb + cw0 * xa) + cw1 * xb) + cw2 * xc) + cw3 * xi; xa = xb; xb = xc; xc = xi;
                convb[j * 72 + lane] = (unsigned short)cvt_pk_bf16(cv, cv);
            }
        }
        asm volatile("s_waitcnt lgkmcnt(0)" ::: "memory");
        bf16x8 Af[2][2];
        {
            const LAS bf16_t* convb = (const LAS bf16_t*)(ldsw + 8192);
#pragma unroll
            for (int tt = 0; tt < 2; ++tt)
#pragma unroll
                for (int ks = 0; ks < 2; ++ks) Af[tt][ks] = *(const LAS bf16x8*)(convb + (16 * tt + (lane & 15)) * 72 + 32 * ks + 8 * (lane >> 4));
        }
        asm volatile("s_waitcnt lgkmcnt(0)" ::: "memory");
#pragma unroll
        for (int nt = 0; nt < 4; ++nt) {
            const bf16_t* wa = F.WAB + ((size_t)g * 64 + 16 * nt + (lane & 15)) * 64 + 8 * (lane >> 4); const bf16_t* wi = wa + 8 * 64 * 64;
            const bf16x8 Ba0 = *(const bf16x8*)wa, Ba1 = *(const bf16x8*)(wa + 32), Bi0 = *(const bf16x8*)wi, Bi1 = *(const bf16x8*)(wi + 32);
#pragma unroll
            for (int tt2 = 0; tt2 < 2; ++tt2) {
                f32x4 ar = (f32x4){0.f, 0.f, 0.f, 0.f}, ai = ar;
                ar = __builtin_amdgcn_mfma_f32_16x16x32_bf16(Af[tt2][0], Ba0, ar, 0, 0, 0); ar = __builtin_amdgcn_mfma_f32_16x16x32_bf16(Af[tt2][1], Ba1, ar, 0, 0, 0);
                ai = __builtin_amdgcn_mfma_f32_16x16x32_bf16(Af[tt2][0], Bi0, ai, 0, 0, 0); ai = __builtin_amdgcn_mfma_f32_16x16x32_bf16(Af[tt2][1], Bi1, ai, 0, 0, 0);
                const int nn = (16 * nt + (lane & 15)) ^ (((lane >> 4) & 1) << 4);
#pragma unroll
                for (int j = 0; j < 4; ++j) { const int il = 16 * tt2 + 4 * (lane >> 4) + j; pre_r[il * 64 + nn] = ar[j]; pre_i[il * 64 + nn] = ai[j]; }
            }
        }
        asm volatile("s_waitcnt lgkmcnt(0)" ::: "memory");
#pragma unroll
        for (int il = 0; il < 32; il += 2) {
            typedef float v2f __attribute__((ext_vector_type(2)));
            const int i = 32 * half + il; const int nn = lane ^ (((il >> 2) & 1) << 4);
            if (SAMPLE && (il & 7) == 0) { x0 = st[il >> 3][0]; x1 = st[il >> 3][1]; x2 = st[il >> 3][2]; h = hs[il >> 3]; }
            const float xa = bf2f(uu[il]), xb = bf2f(uu[il + 1]);
            v2f cv = (v2f){cb, cb} + (v2f){x0, x1} * cw0; cv = cv + (v2f){x1, x2} * cw1; cv = cv + (v2f){x2, xa} * cw2; cv = cv + (v2f){xa, xb} * cw3;
            x0 = x2; x1 = xa; x2 = xb;
            const v2f tr = ((v2f){pre_r[il * 64 + nn], pre_r[(il + 1) * 64 + nn]} + ba) * (-LOG2E), ti = ((v2f){pre_i[il * 64 + nn], pre_i[(il + 1) * 64 + nn]} + bi) * (-LOG2E);
            const v2f r = (v2f){__builtin_amdgcn_rcpf(1.0f + fexp2(tr.x)), __builtin_amdgcn_rcpf(1.0f + fexp2(tr.y))};
            const v2f gi = (v2f){__builtin_amdgcn_rcpf(1.0f + fexp2(ti.x)), __builtin_amdgcn_rcpf(1.0f + fexp2(ti.y))};
            const v2f la = r * (-sp8), al = la * LOG2E, xx = la * 2.0f;
            const v2f a = (v2f){fexp2(al.x), fexp2(al.y)};
            const v2f ser = -xx * (1.0f + xx * 0.5f * (1.0f + xx * (1.0f / 3.0f) * (1.0f + xx * 0.25f * (1.0f + xx * 0.2f * (1.0f + xx * (1.0f / 6.0f))))));
            const v2f alt = 1.0f - a * a;
            const float om0 = xx.x > -0.25f ? ser.x : alt.x, om1 = xx.y > -0.25f ? ser.y : alt.y;
            const v2f sq = (v2f){__builtin_amdgcn_sqrtf(fmaxf(om0, 0.f)), __builtin_amdgcn_sqrtf(fmaxf(om1, 0.f))};
            const v2f bb = sq * (gi * cv);
            const float h0 = a.x * h + bb.x, h1 = a.y * h0 + bb.y; h = h1;
            if (PASS == 1) Ap *= a.x * a.y;
            if (PASS == 2) {
                const v2f g2 = (v2f){bf2f(gg[il]), bf2f(gg[il + 1])};
                const v2f z = (g2 + g2 * g2 * g2 * 0.044715f) * (-2.0f * 0.7978845608028654f * LOG2E);
                const v2f sg = (v2f){__builtin_amdgcn_rcpf(1.0f + fexp2(z.x)), __builtin_amdgcn_rcpf(1.0f + fexp2(z.y))};
                const v2f yv = (v2f){h0, h1} * g2 * sg;
                const unsigned yp = cvt_pk_bf16(yv.x, yv.y);
                ((LAS unsigned*)pre_i)[il * 64 + nn] = yp & 0xffffu; ((LAS unsigned*)pre_i)[(il + 1) * 64 + nn] = yp >> 16;
                const float y0 = __uint_as_float(yp << 16), y1 = __uint_as_float(yp & 0xffff0000u);
                pre_r[il * 64 + nn] = y0 * y0; pre_r[(il + 1) * 64 + nn] = y1 * y1;
                if (SAMPLE && (il & 7) == 6) F.out[O_HS + (size_t)(bn + (i >> 3)) * 512 + c] = h1;
            }
            if ((il & 7) == 6) __builtin_amdgcn_sched_barrier(0);
        }
        asm volatile("s_waitcnt lgkmcnt(0)" ::: "memory");
        if (PASS == 2) {
            if (lane < 32) {
                float s = 0.f;
#pragma unroll 8
                for (int j = 0; j < 64; ++j) s += pre_r[lane * 64 + ((j + lane) & 63)];
                unsafeAtomicAdd(ssl + m0 + 32 * half + lane, s);
            }
            {
                const LAS unsigned* yw = (const LAS unsigned*)pre_i;
#pragma unroll
                for (int i = 0; i < 4; ++i) {
                    const int row = (lane >> 3) + 8 * i, ch8 = ((lane & 7) * 8) ^ (((row >> 2) & 1) << 4);
                    const u32x4 lo = *(const LAS u32x4*)(yw + row * 64 + ch8), hi4 = *(const LAS u32x4*)(yw + row * 64 + ch8 + 4);
                    u32x4 w; w.x = (lo.x & 0xffffu) | (lo.y << 16); w.y = (lo.z & 0xffffu) | (lo.w << 16); w.z = (hi4.x & 0xffffu) | (hi4.y << 16); w.w = (hi4.z & 0xffffu) | (hi4.w << 16);
                    st16(F.MIX + (size_t)(m0 + 32 * half + row) * 512 + g * 64 + (lane & 7) * 8, w);
                }
            }
            asm volatile("s_waitcnt lgkmcnt(0)" ::: "memory");
        }
    }
    if (PASS == 1) {
        __hip_atomic_store((unsigned*)(F.SUMA + ((size_t)bn * 128 + k) * 512 + c), __float_as_uint(Ap), __ATOMIC_RELAXED, __HIP_MEMORY_SCOPE_AGENT);
        __hip_atomic_store((unsigned*)(F.SUMB + ((size_t)bn * 128 + k) * 512 + c), __float_as_uint(h), __ATOMIC_RELAXED, __HIP_MEMORY_SCOPE_AGENT);
    }
    if (PASS == 2) { if (!SAMPLE && k == 127) F.out[O_HP + (size_t)bn * 512 + c] = h; }
}

constexpr int SWA_KS = 136, SWA_VS = 204, SWA_VOFF = 192 * SWA_KS * 2;
__device__ __forceinline__ int crow(int r, int hi) { return (r & 3) + 8 * (r >> 2) + 4 * hi; }
__device__ __forceinline__ unsigned short bf_at(const u32x4& v, int e) { return (unsigned short)(v[e >> 1] >> ((e & 1) * 16)); }
template <bool SAMPLE>
__device__ __forceinline__ void swa_qtile(Ctx& F, const bf16_t* qrow  , int kb, int tb  , int h, float sk, bf16_t* orow, float* ssrow) {
    const int lane = F.lane, q = lane & 31, hi = lane >> 5, kvh = h >> 2;
    const LAS bf16_t* Kl = (const LAS bf16_t*)F.lds; const LAS bf16_t* Vt = (const LAS bf16_t*)(F.lds + SWA_VOFF);
    bf16x8 qf[4];
#pragma unroll
    for (int ks = 0; ks < 4; ++ks) qf[ks] = *(const bf16x8*)(qrow + 16 * ks + 8 * hi);
    f32x16 s[5];
#pragma unroll
    for (int kt = 0; kt < 5; ++kt) {
        s[kt] = (f32x16){0.f, 0.f, 0.f, 0.f, 0.f, 0.f, 0.f, 0.f, 0.f, 0.f, 0.f, 0.f, 0.f, 0.f, 0.f, 0.f};
#pragma unroll
        for (int ks = 0; ks < 4; ++ks) {
            const bf16x8 a = *(const LAS bf16x8*)(Kl + (kb + 32 * kt + q) * SWA_KS + kvh * 64 + 16 * ks + 8 * hi);
            s[kt] = __builtin_amdgcn_mfma_f32_32x32x16_bf16(a, qf[ks], s[kt], 0, 0, 0);
        }
    }
    float mx = sk;
#pragma unroll
    for (int kt = 0; kt < 5; ++kt)
#pragma unroll
        for (int r = 0; r < 16; ++r) {
            const int kk = 32 * kt + crow(r, hi); bool valid;
            if (SAMPLE) valid = (kk < 128) ? (kk >= q + 1) : (kk - 128 <= q && kk < 136);
            else valid = (kk >= q + 1) && (kk <= q + 128) && (tb + kk >= 0);
            const float sv = valid ? s[kt][r] : -INFINITY; s[kt][r] = sv; mx = fmaxf(mx, sv);
        }
    mx = fmaxf(mx, __shfl_xor(mx, 32));
    float l = 0.f; bf16x8 pb[10];
#pragma unroll
    for (int kt = 0; kt < 5; ++kt) {
        float p[16];
#pragma unroll
        for (int r = 0; r < 16; ++r) { p[r] = fexp2(s[kt][r] - mx); l += p[r]; }
#pragma unroll
        for (int hf = 0; hf < 2; ++hf) {
            u32x4 w; w.x = cvt_pk_bf16(p[8 * hf + 0], p[8 * hf + 1]); w.y = cvt_pk_bf16(p[8 * hf + 2], p[8 * hf + 3]); w.z = cvt_pk_bf16(p[8 * hf + 4], p[8 * hf + 5]); w.w = cvt_pk_bf16(p[8 * hf + 6], p[8 * hf + 7]);
            pb[2 * kt + hf] = __builtin_bit_cast(bf16x8, w);
        }
    }
    l += __shfl_xor(l, 32); l += fexp2(sk - mx);
    const float inv = 1.0f / l; float sq = 0.f;
    const bool wr_ok = !SAMPLE || q < 8;
#pragma unroll
    for (int dt = 0; dt < 2; ++dt) {
        f32x16 o = (f32x16){0.f, 0.f, 0.f, 0.f, 0.f, 0.f, 0.f, 0.f, 0.f, 0.f, 0.f, 0.f, 0.f, 0.f, 0.f, 0.f};
#pragma unroll
        for (int u = 0; u < 10; ++u) {
            const LAS bf16_t* vp = Vt + (kvh * 64 + 32 * dt + q) * SWA_VS + kb + 16 * u + 4 * hi;
            const u32x2 lo = *(const LAS u32x2*)vp, hi4 = *(const LAS u32x2*)(vp + 8);
            u32x4 w; w.x = lo.x; w.y = lo.y; w.z = hi4.x; w.w = hi4.y;
            o = __builtin_amdgcn_mfma_f32_32x32x16_bf16(__builtin_bit_cast(bf16x8, w), pb[u], o, 0, 0, 0);
        }
#pragma unroll
        for (int r = 0; r < 16; ++r) { o[r] *= inv; sq += o[r] * o[r]; }
        if (wr_ok) {
#pragma unroll
            for (int rg = 0; rg < 4; ++rg) {
                u32x2 w; w.x = cvt_pk_bf16(o[4 * rg], o[4 * rg + 1]); w.y = cvt_pk_bf16(o[4 * rg + 2], o[4 * rg + 3]);
                st8(orow + 32 * dt + 8 * rg + 4 * hi, w);
            }
        }
    }
    sq += __shfl_xor(sq, 32);
    if (wr_ok && hi == 0) unsafeAtomicAdd(ssrow, sq);
}
__device__ __forceinline__ void swa_prompt_item(Ctx& F, int b, int qb, float* ssa) {
    const int tid = F.tid, lane = F.lane, h = F.wave, q = lane & 31;
    LAS bf16_t* Kl = (LAS bf16_t*)F.lds; LAS bf16_t* Vt = (LAS bf16_t*)(F.lds + SWA_VOFF);
    const int tb = 64 * qb - 128; const size_t rowbase = (size_t)b * SEQ;
    const u32x4 z4 = (u32x4){0u, 0u, 0u, 0u};
#pragma unroll
    for (int i = 0; i < 6; ++i) { const int p = tid + 512 * i, key = p >> 4, ch = p & 15, tok = tb + key;
        const u32x4 v = tok >= 0 ? *(const u32x4*)(F.PROJ + (rowbase + tok) * NIN + 1536 + ch * 8) : z4;
        *(LAS u32x4*)(Kl + key * SWA_KS + ch * 8) = v; }
#pragma unroll
    for (int i = 0; i < 3; ++i) { const int p = tid + 512 * i, ch = (p & 3) + 4 * (p / 384), kp = (p % 384) >> 2, tok = tb + 2 * kp;
        const u32x4 v0 = tok >= 0 ? *(const u32x4*)(F.PROJ + (rowbase + tok) * NIN + 1664 + ch * 8) : z4;
        const u32x4 v1 = tok + 1 >= 0 ? *(const u32x4*)(F.PROJ + (rowbase + tok + 1) * NIN + 1664 + ch * 8) : z4;
#pragma unroll
        for (int e = 0; e < 8; ++e) *(LAS unsigned*)(Vt + (ch * 8 + e) * SWA_VS + 2 * kp) = (unsigned)bf_at(v0, e) | ((unsigned)bf_at(v1, e) << 16); }
    __syncthreads();
    const float sk = F.in[22][h] * LOG2E;
    const size_t m0 = rowbase + 64 * qb;
    swa_qtile<false>(F, F.PROJ + (m0 + q) * NIN + 1024 + h * 64, 0, tb, h, sk, (F.MIX + (size_t)M * 512) + (m0 + q) * 512 + h * 64, ssa + m0 + q);
    swa_qtile<false>(F, F.PROJ + (m0 + 32 + q) * NIN + 1024 + h * 64, 32, tb + 32, h, sk, (F.MIX + (size_t)M * 512) + (m0 + 32 + q) * 512 + h * 64, ssa + m0 + 32 + q);
    __syncthreads();
}
__device__ __forceinline__ void swa_sample_item(Ctx& F, int n, float* ssa) {
    const int tid = F.tid, lane = F.lane, h = F.wave, q = lane & 31;
    LAS bf16_t* Kl = (LAS bf16_t*)F.lds; LAS bf16_t* Vt = (LAS bf16_t*)(F.lds + SWA_VOFF);
    const size_t m0 = (size_t)MP + 8 * n;
    const float* ck = F.in[5] + (size_t)n * 16384; const float* cv = F.in[6] + (size_t)n * 16384;
    const u32x4 z4 = (u32x4){0u, 0u, 0u, 0u};
#pragma unroll
    for (int i = 0; i < 5; ++i) { const int p = tid + 512 * i, key = p >> 4, ch = p & 15;
        u32x4 v = z4;
        if (key < 128) { const f32x4 a = *(const f32x4*)(ck + key * 128 + ch * 8), bq = *(const f32x4*)(ck + key * 128 + ch * 8 + 4);
            v.x = cvt_pk_bf16(a[0], a[1]); v.y = cvt_pk_bf16(a[2], a[3]); v.z = cvt_pk_bf16(bq[0], bq[1]); v.w = cvt_pk_bf16(bq[2], bq[3]); }
        else if (key < 136) v = *(const u32x4*)(F.PROJ + (m0 + key - 128) * NIN + 1536 + ch * 8);
        *(LAS u32x4*)(Kl + key * SWA_KS + ch * 8) = v; }
#pragma unroll
    for (int i = 0; i < 3; ++i) { const int p = tid + 512 * i;
        if (p < 1280) { const int ch = (p & 3) + 4 * (p / 320), kp = (p % 320) >> 2, key = 2 * kp;
            u32x4 v0 = z4, v1 = z4;
            if (key < 128) {
                const f32x4 a0 = *(const f32x4*)(cv + key * 128 + ch * 8), b0 = *(const f32x4*)(cv + key * 128 + ch * 8 + 4), a1 = *(const f32x4*)(cv + (key + 1) * 128 + ch * 8), b1 = *(const f32x4*)(cv + (key + 1) * 128 + ch * 8 + 4);
                v0.x = cvt_pk_bf16(a0[0], a0[1]); v0.y = cvt_pk_bf16(a0[2], a0[3]); v0.z = cvt_pk_bf16(b0[0], b0[1]); v0.w = cvt_pk_bf16(b0[2], b0[3]);
                v1.x = cvt_pk_bf16(a1[0], a1[1]); v1.y = cvt_pk_bf16(a1[2], a1[3]); v1.z = cvt_pk_bf16(b1[0], b1[1]); v1.w = cvt_pk_bf16(b1[2], b1[3]);
            } else if (key < 136) { v0 = *(const u32x4*)(F.PROJ + (m0 + key - 128) * NIN + 1664 + ch * 8); v1 = *(const u32x4*)(F.PROJ + (m0 + key + 1 - 128) * NIN + 1664 + ch * 8); }
#pragma unroll
            for (int e = 0; e < 8; ++e) *(LAS unsigned*)(Vt + (ch * 8 + e) * SWA_VS + 2 * kp) = (unsigned)bf_at(v0, e) | ((unsigned)bf_at(v1, e) << 16); } }
    __syncthreads();
    const float sk = F.in[22][h] * LOG2E;
    const int qc = q < 8 ? q : 7;
    swa_qtile<true>(F, F.PROJ + (m0 + qc) * NIN + 1024 + h * 64, 0, 0, h, sk, (F.MIX + (size_t)M * 512) + (m0 + qc) * 512 + h * 64, ssa + m0 + qc);
    __syncthreads();
}

constexpr int XK_S = 72, XV_S = 260, XV_OFF = 256 * XK_S * 2;
template <bool SAMPLE>
__device__ __forceinline__ void xattn_item(Ctx& F, const float* Ksrc, const float* Vsrc, int h, size_t m0) {
    const int tid = F.tid, lane = F.lane, q = lane & 31, hi = lane >> 5;
    LAS bf16_t* Kc = (LAS bf16_t*)F.lds; LAS bf16_t* Vtc = (LAS bf16_t*)(F.lds + XV_OFF);
    const bool active = SAMPLE ? (F.wave == 0) : true;
    const size_t qr = SAMPLE ? m0 + (q < 8 ? q : 7) : m0 + 32 * F.wave + q;
    const bf16_t* qrow = F.QX + qr * D + h * 256;
    f32x16 S[8];
#pragma unroll
    for (int kt = 0; kt < 8; ++kt) S[kt] = (f32x16){0.f, 0.f, 0.f, 0.f, 0.f, 0.f, 0.f, 0.f, 0.f, 0.f, 0.f, 0.f, 0.f, 0.f, 0.f, 0.f};
#define XLD(ptr) (SAMPLE ? __builtin_nontemporal_load((const f32x4*)(ptr)) : *(const f32x4*)(ptr))
    f32x4 pre[8];
    const float* kbase = Ksrc + (size_t)(tid >> 4) * 1024 + h * 256 + 4 * (tid & 15);
    const float* vbase = Vsrc + (size_t)(2 * (tid >> 2)) * 1024 + h * 256 + 4 * (tid & 3);
#pragma unroll
    for (int i = 0; i < 8; ++i) pre[i] = XLD(kbase + (size_t)i * 32 * 1024);
    for (int ch = 0; ch < 4; ++ch) {
        __syncthreads();
#pragma unroll
        for (int i = 0; i < 8; ++i) { u32x2 w; w.x = cvt_pk_bf16(pre[i][0], pre[i][1]); w.y = cvt_pk_bf16(pre[i][2], pre[i][3]); *(LAS u32x2*)(Kc + ((tid >> 4) + 32 * i) * XK_S + 4 * (tid & 15)) = w; }
        __syncthreads();
        if (ch < 3) {
#pragma unroll
            for (int i = 0; i < 8; ++i) pre[i] = XLD(kbase + (size_t)i * 32 * 1024 + 64 * (ch + 1));
        } else {
#pragma unroll
            for (int i = 0; i < 4; ++i) { pre[2 * i] = XLD(vbase + 16 * i); pre[2 * i + 1] = XLD(vbase + 1024 + 16 * i); }
        }
        if (active) {
#pragma unroll 1
            for (int ks = 0; ks < 4; ++ks) {
                const bf16x8 qf = *(const bf16x8*)(qrow + 64 * ch + 16 * ks + 8 * hi);
#pragma unroll
                for (int kt = 0; kt < 8; ++kt) {
                    const bf16x8 a = *(const LAS bf16x8*)(Kc + (32 * kt + q) * XK_S + 16 * ks + 8 * hi);
                    S[kt] = __builtin_amdgcn_mfma_f32_32x32x16_bf16(a, qf, S[kt], 0, 0, 0);
                }
            }
        }
    }
    float mx = -INFINITY;
#pragma unroll
    for (int kt = 0; kt < 8; ++kt)
#pragma unroll
        for (int r = 0; r < 16; ++r) mx = fmaxf(mx, S[kt][r]);
    mx = fmaxf(mx, __shfl_xor(mx, 32));
    float l = 0.f; bf16x8 pb[16];
#pragma unroll
    for (int kt = 0; kt < 8; ++kt) {
        float p[16];
#pragma unroll
        for (int r = 0; r < 16; ++r) { p[r] = fexp2(S[kt][r] - mx); l += p[r]; }
#pragma unroll
        for (int hf = 0; hf < 2; ++hf) {
            u32x4 w; w.x = cvt_pk_bf16(p[8 * hf + 0], p[8 * hf + 1]); w.y = cvt_pk_bf16(p[8 * hf + 2], p[8 * hf + 3]); w.z = cvt_pk_bf16(p[8 * hf + 4], p[8 * hf + 5]); w.w = cvt_pk_bf16(p[8 * hf + 6], p[8 * hf + 7]);
            pb[2 * kt + hf] = __builtin_bit_cast(bf16x8, w);
        }
    }
    l += __shfl_xor(l, 32);
    const float inv = 1.0f / l;
    bf16_t* orow = F.XO + qr * D + h * 256;
    for (int ch = 0; ch < 4; ++ch) {
        __syncthreads();
#pragma unroll
        for (int i = 0; i < 4; ++i) {
#pragma unroll
            for (int e = 0; e < 4; ++e) *(LAS unsigned*)(Vtc + (4 * ((tid & 3) + 4 * i) + e) * XV_S + 2 * (tid >> 2)) = cvt_pk_bf16(pre[2 * i][e], pre[2 * i + 1][e]); }
        __syncthreads();
        if (ch < 3) {
#pragma unroll
            for (int i = 0; i < 4; ++i) { pre[2 * i] = XLD(vbase + 64 * (ch + 1) + 16 * i); pre[2 * i + 1] = XLD(vbase + 1024 + 64 * (ch + 1) + 16 * i); }
        }
        if (active) {
#pragma unroll
            for (int dt = 0; dt < 2; ++dt) {
                f32x16 o = (f32x16){0.f, 0.f, 0.f, 0.f, 0.f, 0.f, 0.f, 0.f, 0.f, 0.f, 0.f, 0.f, 0.f, 0.f, 0.f, 0.f};
#pragma unroll
                for (int u = 0; u < 16; ++u) {
                    const LAS bf16_t* vp = Vtc + (32 * dt + q) * XV_S + 16 * u + 4 * hi;
                    const u32x2 lo = *(const LAS u32x2*)vp, hi4 = *(const LAS u32x2*)(vp + 8);
                    u32x4 w; w.x = lo.x; w.y = lo.y; w.z = hi4.x; w.w = hi4.y;
                    o = __builtin_amdgcn_mfma_f32_32x32x16_bf16(__builtin_bit_cast(bf16x8, w), pb[u], o, 0, 0, 0);
                }
                if (!SAMPLE || q < 8) {
#pragma unroll
                    for (int rg = 0; rg < 4; ++rg) {
                        u32x2 w; w.x = cvt_pk_bf16(o[4 * rg] * inv, o[4 * rg + 1] * inv); w.y = cvt_pk_bf16(o[4 * rg + 2] * inv, o[4 * rg + 3] * inv);
                        st8(orow + 64 * ch + 32 * dt + 8 * rg + 4 * hi, w);
                    }
                }
            }
        }
    }
    __syncthreads();
}

struct MiniSeg { const bf16_t* A; const bf16_t* Bt; int K; const float* rowss; };
template <int MODE  , int NSEG>
__device__ __forceinline__ void mini_gemm(Ctx& F, const MiniSeg& sg0, const MiniSeg& sg1, float cscale, const float* base_s  , bf16_t* XB, float* ss_out, bf16_t* O, const float* ssin, float cst,
                                          unsigned* cnt_s = nullptr, const float* gfin = nullptr, float* Y = nullptr  ) {
    const int t = F.bid; if (t >= 256) return;
    const int lane = F.lane, w = F.wave, fr = lane & 15, fq = lane >> 4;
    const int R0 = (t >> 4) * 64, C0 = (t & 15) * 64;
    f32x4 acc[4][4];
#pragma unroll
    for (int mt = 0; mt < 4; ++mt)
#pragma unroll
        for (int nt = 0; nt < 4; ++nt) acc[mt][nt] = (f32x4){0.f, 0.f, 0.f, 0.f};
#pragma unroll
    for (int s_ = 0; s_ < NSEG; ++s_) {
        const MiniSeg& sg = s_ ? sg1 : sg0;
        const int K = sg.K, nsteps = K >> 8;
        const bf16_t* pa = sg.A + (size_t)(R0 + fr) * K + (size_t)w * (K >> 3) + 8 * fq; const bf16_t* pb = sg.Bt + (size_t)(C0 + fr) * K + (size_t)w * (K >> 3) + 8 * fq;
        f32x4 sacc[4][4];
        if (NSEG > 1) {
#pragma unroll
            for (int mt = 0; mt < 4; ++mt)
#pragma unroll
                for (int nt = 0; nt < 4; ++nt) sacc[mt][nt] = (f32x4){0.f, 0.f, 0.f, 0.f};
        }
        constexpr int NB = (NSEG > 1) ? 2 : 4;
#pragma unroll 1
        for (int s0 = 0; s0 < nsteps; s0 += NB) {
            bf16x8 a[NB][4], b[NB][4];
#pragma unroll
            for (int s = 0; s < NB; ++s)
                if (s0 + s < nsteps) {
#pragma unroll
                    for (int i = 0; i < 4; ++i) { a[s][i] = *(const bf16x8*)(pa + (size_t)(16 * i) * K + 32 * (s0 + s)); b[s][i] = *(const bf16x8*)(pb + (size_t)(16 * i) * K + 32 * (s0 + s)); }
                }
#pragma unroll
            for (int s = 0; s < NB; ++s)
                if (s0 + s < nsteps) {
#pragma unroll
                    for (int mt = 0; mt < 4; ++mt)
#pragma unroll
                        for (int nt = 0; nt < 4; ++nt) {
                            if (NSEG > 1) sacc[mt][nt] = __builtin_amdgcn_mfma_f32_16x16x32_bf16(b[s][nt], a[s][mt], sacc[mt][nt], 0, 0, 0);
                            else acc[mt][nt] = __builtin_amdgcn_mfma_f32_16x16x32_bf16(b[s][nt], a[s][mt], acc[mt][nt], 0, 0, 0);
                        }
                }
        }
        if (NSEG > 1) {
#pragma unroll
            for (int mt = 0; mt < 4; ++mt) {
                const float sc = rsqrtf(sg.rowss[MP + R0 + 16 * mt + fr] * (1.0f / 512.0f) + EPS);
#pragma unroll
                for (int nt = 0; nt < 4; ++nt) acc[mt][nt] = acc[mt][nt] + sacc[mt][nt] * sc;
            }
        }
    }
    LAS float* part = (LAS float*)(F.lds + w * 16384);
#pragma unroll
    for (int mt = 0; mt < 4; ++mt)
#pragma unroll
        for (int nt = 0; nt < 4; ++nt) { const int row = 16 * mt + fr, chn = (4 * nt + fq) ^ fr; *(LAS f32x4*)(part + row * 64 + 4 * chn) = acc[mt][nt]; }
    __syncthreads();
    const int r = 8 * w + (lane >> 3), j = lane & 7;
    f32x4 t0 = (f32x4){0.f, 0.f, 0.f, 0.f}, t1 = t0;
#pragma unroll
    for (int pw = 0; pw < 8; ++pw) {
        const LAS float* pp = (const LAS float*)(F.lds + pw * 16384) + r * 64;
        t0 = t0 + *(const LAS f32x4*)(pp + 4 * ((2 * j) ^ (r & 15))); t1 = t1 + *(const LAS f32x4*)(pp + 4 * ((2 * j + 1) ^ (r & 15)));
    }
    const int R = MP + R0 + r, C = C0 + 8 * j;
    if (MODE == 0 || MODE == 2) {
        if (NSEG == 1) { t0 = t0 * cscale; t1 = t1 * cscale; }
        f32x4 b0, b1;
        if (base_s) { b0 = *(const f32x4*)(base_s + (size_t)(R - MP) * D + C); b1 = *(const f32x4*)(base_s + (size_t)(R - MP) * D + C + 4); }
        else { const u32x4 wv = *(const u32x4*)(XB + (size_t)R * D + C);
            b0 = (f32x4){__uint_as_float(wv.x << 16), __uint_as_float(wv.x & 0xffff0000u), __uint_as_float(wv.y << 16), __uint_as_float(wv.y & 0xffff0000u)};
            b1 = (f32x4){__uint_as_float(wv.z << 16), __uint_as_float(wv.z & 0xffff0000u), __uint_as_float(wv.w << 16), __uint_as_float(wv.w & 0xffff0000u)}; }
        const f32x4 v0 = b0 + t0, v1 = b1 + t1;
        if (MODE == 0) { u32x4 wo; wo.x = cvt_pk_bf16(v0[0], v0[1]); wo.y = cvt_pk_bf16(v0[2], v0[3]); wo.z = cvt_pk_bf16(v1[0], v1[1]); wo.w = cvt_pk_bf16(v1[2], v1[3]);
            *(u32x4*)(XB + (size_t)R * D + C) = wo; }
        float sq = (v0[0] * v0[0] + v0[1] * v0[1]) + (v0[2] * v0[2] + v0[3] * v0[3]) + (v1[0] * v1[0] + v1[1] * v1[1]) + (v1[2] * v1[2] + v1[3] * v1[3]);
        sq += __shfl_xor(sq, 1); sq += __shfl_xor(sq, 2); sq += __shfl_xor(sq, 4);
        if (j == 0) unsafeAtomicAdd(ss_out + R, sq);
        if (MODE == 2) {
            asm volatile("s_waitcnt vmcnt(0)" ::: "memory");
            __syncthreads();
            if (threadIdx.x == 0) {
                unsigned* c = cnt_s + 64 * (t >> 4);
                __hip_atomic_fetch_add(c, 1u, __ATOMIC_RELAXED, __HIP_MEMORY_SCOPE_AGENT);
                unsigned sp = 0u;
                while (__hip_atomic_load(c, __ATOMIC_RELAXED, __HIP_MEMORY_SCOPE_AGENT) < 16u) { __builtin_amdgcn_s_sleep(2); if (++sp > (1u << 20)) break; }
            }
            __syncthreads();
            float s = 0.f; if (j == 0) s = unsafeAtomicAdd(ss_out + R, 0.0f);
            s = __shfl(s, lane & ~7);
            const float rs = rstd_of(s);
            const f32x4 g0 = *(const f32x4*)(gfin + C), g1 = *(const f32x4*)(gfin + C + 4);
            __builtin_nontemporal_store(v0 * rs * g0, (f32x4*)(Y + (size_t)R * D + C)); __builtin_nontemporal_store(v1 * rs * g1, (f32x4*)(Y + (size_t)R * D + C + 4));
        }
    } else {
        const float rs = rstd_of(ssin[R]) * cst;
        const f32x4 v0 = t0 * rs, v1 = t1 * rs;
        u32x4 wo; wo.x = cvt_pk_bf16(v0[0], v0[1]); wo.y = cvt_pk_bf16(v0[2], v0[3]); wo.z = cvt_pk_bf16(v1[0], v1[1]); wo.w = cvt_pk_bf16(v1[2], v1[3]);
        st16(O + (size_t)R * D + C, wo);
    }
    __syncthreads();
}

__global__ void __launch_bounds__(512, 2) hymba_fwd(Args args) {
    extern __shared__ __attribute__((aligned(16))) unsigned char lds_raw[];
    cg::grid_group grid = cg::this_grid();
    Ctx F;
    F.lds = (LAS unsigned char*)lds_raw; F.tid = threadIdx.x; F.lane = F.tid & 63; F.wave = __builtin_amdgcn_readfirstlane(F.tid >> 6); F.G = gridDim.x; F.bid = blockIdx.x;
    F.in = args.in; F.out = args.out; F.ws = args.ws;
    unsigned char* ws = args.ws;
    F.SS = (float*)(ws + WS_SS); F.ROPE = (float*)(ws + WS_ROPE); F.SUMA = (float*)(ws + WS_SUM); F.SUMB = F.SUMA + 256 * 512; F.WAB = (bf16_t*)(ws + WS_WAB);
    F.XB = (bf16_t*)(ws + WS_XB); F.H = (bf16_t*)(ws + WS_H); F.X = (float*)(ws + WS_X); F.PROJ = (bf16_t*)(ws + WS_PROJ); F.MIX = (bf16_t*)(ws + WS_MIX);
    F.QX = (bf16_t*)(ws + WS_QX); F.XO = (bf16_t*)(ws + WS_XO);
    float* ss0 = F.SS; float* ss1 = F.SS + M; float* ss2 = F.SS + 2 * M; float* ss3 = F.SS + 3 * M; float* ss4 = F.SS + 4 * M;
    constexpr size_t WS_BAR = WS_WAB + 2 * MiB;
    unsigned* const barw = (unsigned*)(ws + WS_BAR);
    volatile LAS unsigned* const barst = (volatile LAS unsigned*)(F.lds + MISC_OFF + 8192);
    if (threadIdx.x < 2) barst[threadIdx.x] = 0u;
    __syncthreads();
    XcdBarrier xbar = xcd_barrier_post(barw, barst);
#define GRID_SYNC() xcd_barrier(xbar)
#define RETID() do { int t_ = threadIdx.x; asm volatile("" : "+v"(t_)); F.tid = t_; F.lane = t_ & 63; F.wave = __builtin_amdgcn_readfirstlane(t_ >> 6); } while (0)
#ifndef PHASE_MASK
#define PHASE_MASK 0xFFFF
#endif
#define PH(k) if constexpr (((PHASE_MASK) >> (k)) & 1)
#ifndef DUP_MASK
#define DUP_MASK 0
#endif
#ifndef EXTRA_SYNCS
#define EXTRA_SYNCS 0
#endif
#define REP(k) for (int rep = 0; rep < 1 + (((DUP_MASK) >> (k)) & 1); ++rep)
    float* const ssdummy = (float*)(ws + WS_WAB + MiB);

    PH(0) REP(0) { RETID(); p0_prologue(F, args.inv_rev); }
    if (args.use_cg) grid.sync();
    GRID_SYNC();
    for (int e = 0; e < EXTRA_SYNCS; ++e) GRID_SYNC();
    PH(1) REP(1) {
        Gemm g{F.XB, (const bf16_t*)(ws + WS_W1GU), M, 2 * FF, D}; StaticOrder S; S.init(M, 2 * FF, F.G, F.bid);
        EpiGU E{F.H, ss0};
        gemm_phase<EpiGU, StaticOrder, true, true>(F.lds, g, S, E);
        Gemm g2{F.XB + (size_t)M * D, (const bf16_t*)(ws + WS_WCKV), MEMR, 2 * D, D}; StaticOrder S2; S2.init(MEMR, 2 * D, F.G, F.G - 1 - F.bid);
        EpiMemKV E2{F.out};
        gemm_phase<EpiMemKV, StaticOrder, true, true>(F.lds, g2, S2, E2);
    }
    GRID_SYNC();
    PH(2) {
        Gemm g{F.H, (const bf16_t*)(ws + WS_W1D), MP, D, FF}; StaticOrder S; S.init(MP, D, F.G, F.bid);
        EpiRes<false, false> E{nullptr, nullptr, F.XB, ss1, 0.5f, nullptr};
        gemm_phase<EpiRes<false, false>, StaticOrder, true, true>(F.lds, g, S, E);
        RETID(); const MiniSeg s0{F.H + (size_t)MP * FF, (const bf16_t*)(ws + WS_W1D), FF, nullptr};
        mini_gemm<0, 1>(F, s0, s0, 0.5f, nullptr, F.XB, ss1, nullptr, nullptr, 0.f);
    }
    GRID_SYNC();
    PH(3) REP(3) {
        Gemm g{F.XB, (const bf16_t*)(ws + WS_WIN), M, NIN, D}; StaticOrder S; S.init(M, NIN, F.G, F.bid);
        EpiIn E{F.PROJ, ss1, F.ROPE, F.out};
        gemm_phase<EpiIn, StaticOrder, true, true>(F.lds, g, S, E);
    }
    GRID_SYNC();
    unsigned* const cntl = barw + 9216;
    PH(4) { RETID(); for (int it = F.bid; it < 256; it += F.G) lru_tile<false, 1, 2>(F, (it >> 7) * SEQ + (it & 127) * 64, it >> 7, it & 127, nullptr); }
    asm volatile("s_waitcnt vmcnt(0)" ::: "memory");
    __syncthreads();
    if (threadIdx.x == 0 && F.bid < 256) __hip_atomic_fetch_add(cntl + 64 * (F.bid >> 7), 1u, __ATOMIC_RELAXED, __HIP_MEMORY_SCOPE_AGENT);
    PH(13) REP(13) { RETID(); float* ssa = rep ? ssdummy : F.SS + 6 * M; for (int it = F.bid; it < 256 + 128; it += F.G) { if (it < 256) swa_prompt_item(F, it >> 7, it & 127, ssa); else swa_sample_item(F, it - 256, ssa); }
        if (rep == 0 && F.bid >= 128 && F.bid < 160) { const int st = F.bid - 128; lru_tile<true, 2, 1>(F, MP + st * 32, st * 4, 0, F.SS + 5 * M); } }
    if (threadIdx.x == 0 && F.bid < 256) {
        unsigned sp = 0u;
        while (__hip_atomic_load(cntl + 64 * (F.bid >> 7), __ATOMIC_RELAXED, __HIP_MEMORY_SCOPE_AGENT) < 128u) { __builtin_amdgcn_s_sleep(2); if (++sp > (1u << 20)) break; }
        __builtin_amdgcn_fence(__ATOMIC_ACQUIRE, "agent");
        asm volatile("s_waitcnt vmcnt(0)" ::: "memory");
    }
    __syncthreads();
    PH(5) REP(5) { RETID(); float* ssl = rep ? ssdummy : F.SS + 5 * M;
        for (int it = F.bid; it < 256; it += F.G) lru_tile<false, 2, 2>(F, (it >> 7) * SEQ + (it & 127) * 64, it >> 7, it & 127, ssl);
    }
    GRID_SYNC();
    PH(6) {
        StaticOrder2 S; S.init(MP, D, F.G, F.bid);
        Gemm g{F.MIX, (const bf16_t*)(ws + WS_WOUT), MP, D, 512, F.MIX + (size_t)M * 512, (const bf16_t*)(ws + WS_WOUT + MiB)};
        EpiMix E{F.XB, ss2, F.SS + 5 * M, F.SS + 6 * M};
        gemm_phase<EpiMix, StaticOrder2, true, true>(F.lds, g, S, E);
        RETID(); const MiniSeg s0{F.MIX + (size_t)MP * 512, (const bf16_t*)(ws + WS_WOUT), 512, F.SS + 5 * M}, s1{F.MIX + (size_t)(M + MP) * 512, (const bf16_t*)(ws + WS_WOUT + MiB), 512, F.SS + 6 * M};
        mini_gemm<0, 2>(F, s0, s1, 1.0f, nullptr, F.XB, ss2, nullptr, nullptr, 0.f);
    }
    GRID_SYNC();
    PH(7) REP(7) {
        Gemm g{F.XB, (const bf16_t*)(ws + WS_WCQ), MP, D, D}; StaticOrder S; S.init(MP, D, F.G, F.bid);
        EpiRowBf16 E{F.QX, D, ss2, C2X};
        gemm_phase<EpiRowBf16, StaticOrder, true, true>(F.lds, g, S, E);
        RETID(); const MiniSeg s0{F.XB + (size_t)MP * D, (const bf16_t*)(ws + WS_WCQ), D, nullptr};
        mini_gemm<1, 1>(F, s0, s0, 1.0f, nullptr, nullptr, nullptr, F.QX, ss2, C2X);
    }
    GRID_SYNC();
    PH(8) REP(8) { RETID();
        if (F.bid < 256) {
            const int itp = F.bid, b = itp >> 7, hp = (itp >> 5) & 3, qb = itp & 31;
            if (!(F.bid & 1)) xattn_item<false>(F, F.out + O_MK + (size_t)b * 262144, F.out + O_MV + (size_t)b * 262144, hp, (size_t)b * SEQ + 256 * qb);
#pragma unroll 1
            for (int sl = 0; sl < 2; ++sl) { const int j = F.bid + 256 * sl, n = j >> 2, h = j & 3;
                xattn_item<true>(F, F.in[3] + (size_t)n * 262144, F.in[4] + (size_t)n * 262144, h, (size_t)MP + 8 * n); }
            if (F.bid & 1) xattn_item<false>(F, F.out + O_MK + (size_t)b * 262144, F.out + O_MV + (size_t)b * 262144, hp, (size_t)b * SEQ + 256 * qb);
        }
    }
    GRID_SYNC();
    PH(9) {
        Gemm g{F.XO, (const bf16_t*)(ws + WS_WCO), MP, D, D}; StaticOrder S; S.init(MP, D, F.G, F.bid);
        EpiRes<false, false> E{nullptr, nullptr, F.XB, ss3, 1.0f, nullptr};
        gemm_phase<EpiRes<false, false>, StaticOrder, true, true>(F.lds, g, S, E);
        RETID(); const MiniSeg s0{F.XO + (size_t)MP * D, (const bf16_t*)(ws + WS_WCO), D, nullptr};
        mini_gemm<0, 1>(F, s0, s0, 1.0f, nullptr, F.XB, ss3, nullptr, nullptr, 0.f);
    }
    GRID_SYNC();
    PH(10) REP(10) {
        Gemm g{F.XB, (const bf16_t*)(ws + WS_W2GU), M, 2 * FF, D}; StaticOrder S; S.init(M, 2 * FF, F.G, F.bid);
        EpiGU E{F.H, ss3};
        gemm_phase<EpiGU, StaticOrder, true, true>(F.lds, g, S, E);
    }
    GRID_SYNC();
    PH(11) {
        unsigned* cntp = barw + 4096; unsigned* cnts = barw + 8192;
        Gemm g{F.H, (const bf16_t*)(ws + WS_W2D), MP, D, FF}; StaticOrder S; S.init(MP, D, F.G, F.bid);
        EpiFinal E{F.XB, ss4, cntp, F.in[36], F.out + O_Y, 0.5f};
        gemm_phase<EpiFinal, StaticOrder, false, true>(F.lds, g, S, E);
        RETID(); const MiniSeg s0{F.H + (size_t)MP * FF, (const bf16_t*)(ws + WS_W2D), FF, nullptr};
        mini_gemm<2, 1>(F, s0, s0, 0.5f, nullptr, F.XB, ss4, nullptr, nullptr, 0.f, cnts, F.in[36], F.out + O_Y);
    }
}

extern "C" void kernel_launch(void* const* d_in, const int* in_sizes, int n_in, void* d_out, int out_size, void* d_ws, size_t ws_size, hipStream_t stream) {
    static int grid = 0;
    if (grid == 0) {
        if (n_in != 37 || (size_t)out_size != O_END || ws_size < WS_END) { fprintf(stderr, "kernel_launch: unexpected shapes: n_in %d out %d (want %zu) ws %zu (want >= %zu)\n", n_in, out_size, (size_t)O_END, ws_size, (size_t)WS_END); grid = -1; return; }
        int dev = 0, cus = 0, per_cu = 0;
        hipGetDevice(&dev); hipDeviceGetAttribute(&cus, hipDeviceAttributeMultiprocessorCount, dev);
        if (hipFuncSetAttribute((const void*)hymba_fwd, hipFuncAttributeMaxDynamicSharedMemorySize, LDS_BYTES) != hipSuccess) { fprintf(stderr, "kernel_launch: hipFuncSetAttribute failed\n"); grid = -1; return; }
        if (hipOccupancyMaxActiveBlocksPerMultiprocessor(&per_cu, (const void*)hymba_fwd, 512, LDS_BYTES) != hipSuccess || per_cu < 1) { fprintf(stderr, "kernel_launch: occupancy query says %d blocks/CU\n", per_cu); (void)hipGetLastError(); per_cu = 1; }
        grid = cus;
        if (grid != 256) fprintf(stderr, "kernel_launch: note: %d CUs\n", grid);
    }
    if (grid < 0) return;
    Args a; memset(&a, 0, sizeof(a));
    for (int i = 0; i < 37; ++i) a.in[i] = (const float*)d_in[i];
    a.out = (float*)d_out; a.ws = (unsigned char*)d_ws;
    for (int i = 0; i < 32; ++i) a.inv_rev[i] = std::pow(10000.0, -(double)i / 32.0) / 6.283185307179586476925;
    a.use_cg = 0;
    if (hipMemsetAsync((char*)d_ws + WS_WAB + 2 * MiB, 0, 40960, stream) != hipSuccess) { fprintf(stderr, "kernel_launch: memset of barrier words failed\n"); return; }
    void* kargs[] = {&a};
    hipError_t e = hipLaunchCooperativeKernel((const void*)hymba_fwd, dim3(grid), dim3(512), kargs, LDS_BYTES, stream);
    if (e != hipSuccess) fprintf(stderr, "kernel_launch: cooperative launch failed: %s (grid %d)\n", hipGetErrorString(e), grid);
}
```

```cpp
#include <hip/hip_runtime.h>
#include <hip/hip_cooperative_groups.h>
#include <cstdio>
#include <cstdint>
#include <cmath>
#include <cstring>
namespace cg = cooperative_groups;
namespace pg8 {
#define PG8_LAS __attribute__((address_space(3)))
typedef unsigned short bf16_t;
typedef short bf16x8 __attribute__((ext_vector_type(8)));
typedef float f32x4 __attribute__((ext_vector_type(4)));
typedef unsigned u32x4 __attribute__((ext_vector_type(4)));
constexpr int BM = 256, BK = 64, HALF = 128, HTB = HALF * BK * 2  , STAGE_BYTES = 8 * HTB, NXCD = 8, WGM = 8;

__host__ __device__ __forceinline__ int lds_byte(int r, int c) { const int st = (r >> 4) * 2 + (c >> 5), rr = r & 15, cc = c & 31, ob = rr * 64 + cc * 2; return st * 1024 + (ob ^ (((ob >> 9) & 1) << 5)); }
__host__ __device__ __forceinline__ void stage_rc(int b, int& R, int& C) { const int st = b / 1024, sb = b % 1024, swz = sb ^ (((sb >> 9) & 1) << 5); R = (st >> 1) * 16 + swz / 64; C = (st & 1) * 32 + (swz % 64) / 2; }
__host__ __device__ __forceinline__ int perm32(int rho) { const int n = rho >> 4, i = rho & 15; return 8 * (i >> 2) + 4 * n + (i & 3); }

struct Unit { int pm, pn, seg; };
struct Gemm { const bf16_t* A; const bf16_t* Bt; int M, N, K; const bf16_t* A2; const bf16_t* Bt2; };

struct StaticOrder {
    int nM, nN, nwg, G, c;
    __host__ __device__ void init(int M, int N, int G_, int c_) { nM = M / BM; nN = N / BM; nwg = nM * nN; G = G_; c = c_; }
    __host__ __device__ bool next(int i, Unit& u) const {
        const long L = (long)i * G + c; if (L >= nwg) return false;
        int wgid = (int)L; { const int q = nwg / NXCD, r = nwg % NXCD, xcd = wgid % NXCD, off = wgid / NXCD; wgid = (xcd < r ? xcd * (q + 1) : r * (q + 1) + (xcd - r) * q) + off; }
        const int nig = WGM * nN, gid = wgid / nig, fm = gid * WGM, gsz = (nM - fm) < WGM ? (nM - fm) : WGM;
        u.pm = fm + ((wgid % nig) % gsz); u.pn = (wgid % nig) / gsz; u.seg = 0; return true;
    }
    __device__ __forceinline__ void a_ready(const Unit&) const {}
    __device__ __forceinline__ void done(const Unit&) const {}
};

__device__ __forceinline__ unsigned cvt_pk_bf16(float lo, float hi) { unsigned r; asm volatile("v_cvt_pk_bf16_f32 %0, %1, %2" : "=v"(r) : "v"(lo), "v"(hi)); return r; }

template <class Epi, class Sched, bool ALIGN_EPI = false, bool SP2 = false>
__device__ __forceinline__ void gemm_phase(PG8_LAS unsigned char* lds, const Gemm g, const Sched& S, const Epi& E) {
    int tid_ = threadIdx.x; asm volatile("" : "+v"(tid_)); const int tid = tid_, wid = __builtin_amdgcn_readfirstlane(tid >> 6), lane = tid & 63, wr = wid >> 2, wc = wid & 3, fr = lane & 15, fq = lane >> 4;
    const int K = g.K, nt = K / BK;
    unsigned voffA[2], voffB[2];
#pragma unroll
    for (int i = 0; i < 2; ++i) { int R, C; stage_rc(tid * 16 + i * 8192, R, C); const int Rb = Epi::PERM ? ((R & ~31) + perm32(R & 31)) : R;
        voffA[i] = (unsigned)(R * K + C) * 2u; voffB[i] = (unsigned)(Rb * K + C) * 2u; }
    const size_t kstep = (size_t)(BK * 2);
    const size_t hstep = (size_t)HALF * K * 2;
    const size_t tstep = 2 * hstep;
    const unsigned ldsw = (unsigned)wid * 1024u;
    const int aoff = lds_byte(wr * 64 + fr, fq * 8), boff = lds_byte(wc * 32 + fr, fq * 8);
#define PG8_SA(b, h) (((b) * 2 + (h)) * HTB)
#define PG8_SB(b, h) ((4 + (b) * 2 + (h)) * HTB)
#define PG8_STAGE(bufoff, gbase, voff) do { _Pragma("unroll") for (int _i = 0; _i < 2; ++_i) \
        __builtin_amdgcn_global_load_lds((const unsigned*)((const char*)(gbase) + (voff)[_i]), (PG8_LAS unsigned*)(lds + (bufoff) + ldsw + _i * 8192), 16, 0, 0); } while (0)
#define PG8_LDA(dst, b, h) do { _Pragma("unroll") for (int m = 0; m < 4; ++m) _Pragma("unroll") for (int k = 0; k < 2; ++k) dst[m][k] = *(const PG8_LAS bf16x8*)(lds + PG8_SA(b, h) + aoff + m * 2048 + k * 1024); } while (0)
#define PG8_LDB(dst, b, h) do { _Pragma("unroll") for (int n = 0; n < 2; ++n) _Pragma("unroll") for (int k = 0; k < 2; ++k) dst[n][k] = *(const PG8_LAS bf16x8*)(lds + PG8_SB(b, h) + boff + n * 2048 + k * 1024); } while (0)
#define PG8_MMA(ai, bj, At, Bt) do { __builtin_amdgcn_s_setprio(1); _Pragma("unroll") for (int m = 0; m < 4; ++m) _Pragma("unroll") for (int n = 0; n < 2; ++n) _Pragma("unroll") for (int k = 0; k < 2; ++k) \
        acc[ai][bj][m][n] = __builtin_amdgcn_mfma_f32_16x16x32_bf16(Bt[n][k], At[m][k], acc[ai][bj][m][n], 0, 0, 0); __builtin_amdgcn_s_setprio(0); } while (0)
#define PG8_WAIT_V(n) asm volatile("s_waitcnt vmcnt(" #n ")" ::: "memory")
#define PG8_WAIT_L(n) asm volatile("s_waitcnt lgkmcnt(" #n ")" ::: "memory")
#define PG8_BAR __builtin_amdgcn_s_barrier()
#define PG8_SCHED __builtin_amdgcn_sched_barrier(0)
    Unit cur, nxt; int ui = 0;
    if (!S.next(0, cur)) return;
    f32x4 acc[2][2][4][2];
#pragma unroll
    for (int a = 0; a < 2; ++a)
#pragma unroll
        for (int b = 0; b < 2; ++b)
#pragma unroll
            for (int m = 0; m < 4; ++m)
#pragma unroll
                for (int n = 0; n < 2; ++n) acc[a][b][m][n] = (f32x4){0.f, 0.f, 0.f, 0.f};
    bf16x8 At[4][2], B0[2][2], B1[2][2];
    const char* cA = (const char*)((Epi::TWOSEG && cur.seg) ? g.A2 : g.A) + (size_t)cur.pm * tstep; const char* cB = (const char*)((Epi::TWOSEG && cur.seg) ? g.Bt2 : g.Bt) + (size_t)cur.pn * tstep;
    S.a_ready(cur);
    if constexpr (SP2) {
        PG8_STAGE(PG8_SB(0, 0), cB, voffB); PG8_STAGE(PG8_SB(0, 1), cB + hstep, voffB); PG8_STAGE(PG8_SA(0, 0), cA, voffA); PG8_STAGE(PG8_SA(0, 1), cA + hstep, voffA);
        if (wr == 1) PG8_BAR;
        PG8_WAIT_V(2); PG8_BAR;
        PG8_STAGE(PG8_SB(1, 0), cB + kstep, voffB); PG8_STAGE(PG8_SA(1, 0), cA + kstep, voffA); PG8_STAGE(PG8_SB(1, 1), cB + hstep + kstep, voffB);
        PG8_WAIT_V(6); PG8_BAR;
    } else {
        PG8_STAGE(PG8_SB(0, 0), cB, voffB); PG8_STAGE(PG8_SA(0, 0), cA, voffA); PG8_STAGE(PG8_SB(0, 1), cB + hstep, voffB); PG8_STAGE(PG8_SA(0, 1), cA + hstep, voffA);
        if (wr == 1) PG8_BAR;
        PG8_WAIT_V(4); PG8_BAR;
        PG8_STAGE(PG8_SB(1, 0), cB + kstep, voffB); PG8_STAGE(PG8_SA(1, 0), cA + kstep, voffA); PG8_STAGE(PG8_SB(1, 1), cB + hstep + kstep, voffB);
        PG8_WAIT_V(6); PG8_BAR;
    }
    for (;;) {
        const bool has_next = S.next(ui + 1, nxt);
        const char* nA = has_next ? (const char*)((Epi::TWOSEG && nxt.seg) ? g.A2 : g.A) + (size_t)nxt.pm * tstep : cA; const char* nB = has_next ? (const char*)((Epi::TWOSEG && nxt.seg) ? g.Bt2 : g.Bt) + (size_t)nxt.pn * tstep : cB;
        for (int t = 0; t < nt; t += 2) {
            const bool last = (t == nt - 2);
            if constexpr (Epi::MIDSCALE) { if (t == nt / 2) E.mid(acc, cur, wr, wc, fr, fq); }
            const char* a1 = cA + (size_t)(t + 1) * kstep;
            const char* a2 = last ? nA : cA + (size_t)(t + 2) * kstep; const char* b2 = last ? nB : cB + (size_t)(t + 2) * kstep;
            const char* a3 = a2 + kstep; const char* b3 = b2 + kstep;
            if (last && has_next) S.a_ready(nxt);
            if constexpr (SP2) {
            PG8_LDB(B0, 0, 0); PG8_LDB(B1, 0, 1); PG8_SCHED; PG8_LDA(At, 0, 0); PG8_STAGE(PG8_SA(1, 1), a1 + hstep, voffA);
            PG8_WAIT_V(8); PG8_WAIT_L(0); PG8_BAR; PG8_MMA(0, 0, At, B0); PG8_MMA(0, 1, At, B1); PG8_BAR; PG8_SCHED;
            PG8_LDA(At, 0, 1); PG8_STAGE(PG8_SB(0, 0), b2, voffB); PG8_STAGE(PG8_SB(0, 1), b2 + hstep, voffB); PG8_STAGE(PG8_SA(0, 0), a2, voffA);
            PG8_WAIT_V(8); PG8_WAIT_L(0); PG8_BAR; PG8_MMA(1, 0, At, B0); PG8_MMA(1, 1, At, B1); PG8_BAR; PG8_SCHED;
            PG8_LDB(B0, 1, 0); PG8_LDB(B1, 1, 1); PG8_SCHED; PG8_LDA(At, 1, 0); PG8_STAGE(PG8_SA(0, 1), a2 + hstep, voffA);
            PG8_WAIT_V(8); PG8_WAIT_L(0); PG8_BAR; PG8_MMA(0, 0, At, B0); PG8_MMA(0, 1, At, B1); PG8_BAR; PG8_SCHED;
            PG8_LDA(At, 1, 1); PG8_STAGE(PG8_SB(1, 0), b3, voffB); PG8_STAGE(PG8_SB(1, 1), b3 + hstep, voffB); PG8_STAGE(PG8_SA(1, 0), a3, voffA);
            PG8_WAIT_V(8); PG8_WAIT_L(0); PG8_BAR; PG8_MMA(1, 0, At, B0); PG8_MMA(1, 1, At, B1); PG8_BAR; PG8_SCHED;
            } else {
            PG8_LDB(B0, 0, 0); PG8_SCHED; PG8_LDA(At, 0, 0); PG8_STAGE(PG8_SA(1, 1), a1 + hstep, voffA);
            PG8_WAIT_L(8); PG8_BAR; PG8_WAIT_L(0); PG8_MMA(0, 0, At, B0); PG8_BAR; PG8_SCHED;
            PG8_LDB(B1, 0, 1); PG8_STAGE(PG8_SB(0, 0), b2, voffB);
            PG8_BAR; PG8_WAIT_L(0); PG8_MMA(0, 1, At, B1); PG8_BAR;
            PG8_LDA(At, 0, 1); PG8_STAGE(PG8_SA(0, 0), a2, voffA);
            PG8_BAR; PG8_WAIT_L(0); PG8_MMA(1, 0, At, B0); PG8_BAR; PG8_SCHED;
            PG8_STAGE(PG8_SB(0, 1), b2 + hstep, voffB);
            PG8_WAIT_V(6); PG8_BAR; PG8_MMA(1, 1, At, B1); PG8_BAR;
            PG8_LDB(B0, 1, 0); PG8_SCHED; PG8_LDA(At, 1, 0); PG8_STAGE(PG8_SA(0, 1), a2 + hstep, voffA);
            PG8_WAIT_L(8); PG8_BAR; PG8_WAIT_L(0); PG8_MMA(0, 0, At, B0); PG8_BAR; PG8_SCHED;
            PG8_LDB(B1, 1, 1); PG8_STAGE(PG8_SB(1, 0), b3, voffB);
            PG8_BAR; PG8_WAIT_L(0); PG8_MMA(0, 1, At, B1); PG8_BAR;
            PG8_LDA(At, 1, 1); PG8_STAGE(PG8_SA(1, 0), a3, voffA);
            PG8_BAR; PG8_WAIT_L(0); PG8_MMA(1, 0, At, B0); PG8_BAR; PG8_SCHED;
            PG8_STAGE(PG8_SB(1, 1), b3 + hstep, voffB);
            PG8_WAIT_V(6); PG8_BAR; PG8_MMA(1, 1, At, B1); PG8_BAR;
            }
        }
        if constexpr (ALIGN_EPI) { if (wr == 0) PG8_BAR; }
        bool keep_acc = false;
        if constexpr (Epi::TWOSEG) { if (cur.seg == 0) { E.mid(acc, cur, wr, wc, fr, fq); keep_acc = true; } else { E(acc, cur, wr, wc, fr, fq); } }
        else if constexpr (!Epi::AFTER_DRAIN) { E(acc, cur, wr, wc, fr, fq); S.done(cur); }
        if (!has_next) break;
        if (!keep_acc) {
#pragma unroll
        for (int a = 0; a < 2; ++a)
#pragma unroll
            for (int b = 0; b < 2; ++b)
#pragma unroll
                for (int m = 0; m < 4; ++m)
#pragma unroll
                    for (int n = 0; n < 2; ++n) acc[a][b][m][n] = (f32x4){0.f, 0.f, 0.f, 0.f};
        }
        cur = nxt; cA = nA; cB = nB; ++ui;
        if constexpr (ALIGN_EPI) { if (wr == 1) PG8_BAR; }
    }
    PG8_WAIT_V(0);
    if constexpr (!ALIGN_EPI) { if (wr == 0) PG8_BAR; }
    PG8_BAR;
    if constexpr (Epi::AFTER_DRAIN) { E.fused(acc, cur, wr, wc, fr, fq, lds, wid, lane); S.done(cur); }
#undef PG8_SA
#undef PG8_SB
#undef PG8_STAGE
#undef PG8_LDA
#undef PG8_LDB
#undef PG8_MMA
#undef PG8_WAIT_V
#undef PG8_WAIT_L
#undef PG8_BAR
#undef PG8_SCHED
}
}
using namespace pg8;
#define LAS __attribute__((address_space(3)))
typedef float f32x16 __attribute__((ext_vector_type(16)));
typedef unsigned u32x2 __attribute__((ext_vector_type(2)));

constexpr int D = 1024, MP = 16384, MS = 1024, M = MP + MS, FF = 2816, NIN = 1792, SEQ = 8192, MEMR = 512;
constexpr float EPS = 1e-6f, LOG2E = 1.4426950408889634f;
constexpr float C2S = 0.125f * LOG2E;
constexpr float C2X = 0.0625f * LOG2E;
constexpr size_t O_Y = 0, O_MK = (size_t)M * D, O_MV = O_MK + 524288, O_SKP = O_MV + 524288, O_SVP = O_SKP + 32768, O_CP = O_SVP + 32768,
                 O_HP = O_CP + 3072, O_SKS = O_HP + 1024, O_SVS = O_SKS + 2097152, O_CS = O_SVS + 2097152, O_HS = O_CS + 196608, O_END = O_HS + 65536;
constexpr size_t MiB = 1u << 20;
constexpr size_t WS_SS = 0, WS_ROPE = MiB / 2, WS_SUM = 3 * MiB, WS_WAB = 4 * MiB, WS_W1GU = 8 * MiB, WS_WCKV = 19 * MiB, WS_W1D = 23 * MiB, WS_WIN = 29 * MiB,
                 WS_WOUT = 33 * MiB, WS_WCQ = 35 * MiB, WS_WCO = 37 * MiB, WS_W2GU = 39 * MiB, WS_W2D = 50 * MiB, WS_XB = 56 * MiB, WS_H = 91 * MiB, WS_X = 185 * MiB,
                 WS_PROJ = 253 * MiB, WS_MIX = 313 * MiB, WS_QX = 347 * MiB, WS_XO = 381 * MiB, WS_END = 415 * MiB;
constexpr int ROPE_POS = 8200;
constexpr int RING_BYTES = 131072, MISC_OFF = RING_BYTES, LDS_BYTES = 147456;

__device__ __forceinline__ float bf2f(unsigned short b) { return __uint_as_float((unsigned)b << 16); }
__device__ __forceinline__ unsigned short f2bf(float f) { unsigned u = __float_as_uint(f); return (unsigned short)((u + 0x7fffu + ((u >> 16) & 1u)) >> 16); }
__device__ __forceinline__ unsigned pk2(float lo, float hi) { return (unsigned)f2bf(lo) | ((unsigned)f2bf(hi) << 16); }
__device__ __forceinline__ float rstd_of(float ss) { return rsqrtf(ss * (1.0f / 1024.0f) + EPS); }
__device__ __forceinline__ float fexp2(float x) { return __builtin_amdgcn_exp2f(x); }
__device__ __forceinline__ float sigmoidf_(float x) { return __builtin_amdgcn_rcpf(1.0f + fexp2(-x * LOG2E)); }
__device__ __forceinline__ float silu_mul(float g, float u) { return g * u * sigmoidf_(g); }
__device__ __forceinline__ float gelu_tanh(float x) { const float z = 0.7978845608028654f * (x + 0.044715f * x * x * x); return x * sigmoidf_(2.0f * z); }

__device__ __forceinline__ void st16(void* p, u32x4 v) { *(u32x4*)p = v; }
__device__ __forceinline__ void st8(void* p, u32x2 v) { *(u32x2*)p = v; }
struct EpiGU {
    static constexpr bool PERM = true, AFTER_DRAIN = false, MIDSCALE = false, TWOSEG = false;
    bf16_t* H; const float* ss;
    __device__ __forceinline__ void operator()(const f32x4 (&acc)[2][2][4][2], const Unit& u, int wr, int wc, int fr, int fq) const {
        const int row0 = u.pm * 256 + wr * 64 + fr, col0 = u.pn * 128 + wc * 32 + 8 * fq;
        float rsv[2][4];
#pragma unroll
        for (int ai = 0; ai < 2; ++ai)
#pragma unroll
            for (int m = 0; m < 4; ++m) rsv[ai][m] = ss[row0 + ai * 128 + m * 16];
#pragma unroll
        for (int ai = 0; ai < 2; ++ai)
#pragma unroll
            for (int m = 0; m < 4; ++m) {
                const int row = row0 + ai * 128 + m * 16; const float rs = rstd_of(rsv[ai][m]);
                const f32x4 g0 = acc[ai][0][m][0] * rs, g1 = acc[ai][0][m][1] * rs, u0 = acc[ai][1][m][0] * rs, u1 = acc[ai][1][m][1] * rs;
                u32x4 w;
                w.x = cvt_pk_bf16(silu_mul(g0[0], u0[0]), silu_mul(g0[1], u0[1])); w.y = cvt_pk_bf16(silu_mul(g0[2], u0[2]), silu_mul(g0[3], u0[3]));
                w.z = cvt_pk_bf16(silu_mul(g1[0], u1[0]), silu_mul(g1[1], u1[1])); w.w = cvt_pk_bf16(silu_mul(g1[2], u1[2]), silu_mul(g1[3], u1[3]));
                st16(H + (size_t)row * FF + col0, w);
            }
    }
};
template <bool ROWSCALE, bool F32BASE>
struct EpiRes {
    static constexpr bool PERM = true, AFTER_DRAIN = false, MIDSCALE = false, TWOSEG = false;
    const float* base_p; const float* base_s; bf16_t* XB; float* ss_out; float scale; const float* rowss;
    __device__ __forceinline__ void operator()(const f32x4 (&acc)[2][2][4][2], const Unit& u, int wr, int wc, int fr, int fq) const {
        const int row0 = u.pm * 256 + wr * 64 + fr, col0 = u.pn * 256 + wc * 32 + 8 * fq;
#pragma unroll
        for (int ai = 0; ai < 2; ++ai) {
            f32x4 bv[4][2][2]; float scv[4];
#pragma unroll
            for (int m = 0; m < 4; ++m) {
                const int row = row0 + ai * 128 + m * 16;
                scv[m] = ROWSCALE ? rowss[row] : 0.f;
                if (F32BASE) {
                    const float* b = row < MP ? base_p + (size_t)row * D : base_s + (size_t)(row - MP) * D;
#pragma unroll
                    for (int bj = 0; bj < 2; ++bj) { bv[m][bj][0] = *(const f32x4*)(b + col0 + bj * 128); bv[m][bj][1] = *(const f32x4*)(b + col0 + bj * 128 + 4); }
                } else {
#pragma unroll
                    for (int bj = 0; bj < 2; ++bj) {
                        const u32x4 w = *(const u32x4*)(XB + (size_t)row * D + col0 + bj * 128);
                        bv[m][bj][0] = (f32x4){__uint_as_float(w.x << 16), __uint_as_float(w.x & 0xffff0000u), __uint_as_float(w.y << 16), __uint_as_float(w.y & 0xffff0000u)};
                        bv[m][bj][1] = (f32x4){__uint_as_float(w.z << 16), __uint_as_float(w.z & 0xffff0000u), __uint_as_float(w.w << 16), __uint_as_float(w.w & 0xffff0000u)};
                    }
                }
            }
#pragma unroll
            for (int m = 0; m < 4; ++m) {
                const int row = row0 + ai * 128 + m * 16;
                const float sc = ROWSCALE ? rsqrtf(scv[m] * (1.0f / 512.0f) + EPS) : scale; float sq = 0.f;
#pragma unroll
                for (int bj = 0; bj < 2; ++bj) {
                    const int c = col0 + bj * 128;
                    const f32x4 v0 = bv[m][bj][0] + acc[ai][bj][m][0] * sc, v1 = bv[m][bj][1] + acc[ai][bj][m][1] * sc;
                    u32x4 w; w.x = cvt_pk_bf16(v0[0], v0[1]); w.y = cvt_pk_bf16(v0[2], v0[3]); w.z = cvt_pk_bf16(v1[0], v1[1]); w.w = cvt_pk_bf16(v1[2], v1[3]);
                    *(u32x4*)(XB + (size_t)row * D + c) = w;
                    sq += (v0[0] * v0[0] + v0[1] * v0[1]) + (v0[2] * v0[2] + v0[3] * v0[3]) + (v1[0] * v1[0] + v1[1] * v1[1]) + (v1[2] * v1[2] + v1[3] * v1[3]);
                }
                if (ss_out) { sq += __shfl_xor(sq, 16); sq += __shfl_xor(sq, 32); if (fq == 0) unsafeAtomicAdd(ss_out + row, sq); }
            }
        }
    }
};
struct EpiMix {
    static constexpr bool PERM = true, AFTER_DRAIN = false, MIDSCALE = false, TWOSEG = true;
    bf16_t* XB; float* ss_out; const float* ssl; const float* ssa;
    __device__ __forceinline__ void mid(f32x4 (&acc)[2][2][4][2], const Unit& u, int wr, int wc, int fr, int fq) const {
        const int row0 = u.pm * 256 + wr * 64 + fr;
        float sl[2][4], sa[2][4];
#pragma unroll
        for (int ai = 0; ai < 2; ++ai)
#pragma unroll
            for (int m = 0; m < 4; ++m) { sl[ai][m] = ssl[row0 + ai * 128 + m * 16]; sa[ai][m] = ssa[row0 + ai * 128 + m * 16]; }
#pragma unroll
        for (int ai = 0; ai < 2; ++ai)
#pragma unroll
            for (int m = 0; m < 4; ++m) {
                const float ratio = rsqrtf(sl[ai][m] * (1.0f / 512.0f) + EPS) * sqrtf(sa[ai][m] * (1.0f / 512.0f) + EPS);
#pragma unroll
                for (int bj = 0; bj < 2; ++bj)
#pragma unroll
                    for (int n = 0; n < 2; ++n) acc[ai][bj][m][n] = acc[ai][bj][m][n] * ratio;
            }
    }
    __device__ __forceinline__ void operator()(const f32x4 (&acc)[2][2][4][2], const Unit& u, int wr, int wc, int fr, int fq) const {
        const EpiRes<true, false> E{nullptr, nullptr, XB, ss_out, 1.0f, ssa};
        E(acc, u, wr, wc, fr, fq);
    }
};
struct StaticOrder2 {
    StaticOrder S;
    __host__ __device__ void init(int M, int N, int G_, int c_) { S.init(M, N, G_, c_); }
    __host__ __device__ bool next(int i, Unit& u) const { const bool ok = S.next(i >> 1, u); u.seg = i & 1; return ok; }
    __device__ __forceinline__ void a_ready(const Unit&) const {}
    __device__ __forceinline__ void done(const Unit&) const {}
};
struct EpiFinal {
    static constexpr bool PERM = true, AFTER_DRAIN = true, MIDSCALE = false, TWOSEG = false;
    const bf16_t* XB; float* ss; unsigned* cnt; const float* gfin; float* Y; float scale;
    __device__ __forceinline__ void fused(f32x4 (&acc)[2][2][4][2], const Unit& u, int wr, int wc, int fr, int fq, PG8_LAS unsigned char* lds, int wid, int lane) const {
        const int row0 = u.pm * 256 + wr * 64 + fr, col0 = u.pn * 256 + wc * 32 + 8 * fq;
#pragma unroll
        for (int ai = 0; ai < 2; ++ai) {
            u32x4 bw[4][2];
#pragma unroll
            for (int m = 0; m < 4; ++m)
#pragma unroll
                for (int bj = 0; bj < 2; ++bj) bw[m][bj] = __builtin_nontemporal_load((const u32x4*)(XB + (size_t)(row0 + ai * 128 + m * 16) * D + col0 + bj * 128));
#pragma unroll
            for (int m = 0; m < 4; ++m) {
                float sq = 0.f;
#pragma unroll
                for (int bj = 0; bj < 2; ++bj) {
                    const u32x4 w = bw[m][bj];
                    const f32x4 b0 = (f32x4){__uint_as_float(w.x << 16), __uint_as_float(w.x & 0xffff0000u), __uint_as_float(w.y << 16), __uint_as_float(w.y & 0xffff0000u)};
                    const f32x4 b1 = (f32x4){__uint_as_float(w.z << 16), __uint_as_float(w.z & 0xffff0000u), __uint_as_float(w.w << 16), __uint_as_float(w.w & 0xffff0000u)};
                    const f32x4 v0 = b0 + acc[ai][bj][m][0] * scale, v1 = b1 + acc[ai][bj][m][1] * scale;
                    acc[ai][bj][m][0] = v0; acc[ai][bj][m][1] = v1;
                    sq += (v0[0] * v0[0] + v0[1] * v0[1]) + (v0[2] * v0[2] + v0[3] * v0[3]) + (v1[0] * v1[0] + v1[1] * v1[1]) + (v1[2] * v1[2] + v1[3] * v1[3]);
                }
                sq += __shfl_xor(sq, 16); sq += __shfl_xor(sq, 32);
                if (fq == 0) unsafeAtomicAdd(ss + row0 + ai * 128 + m * 16, sq);
            }
        }
        asm volatile("s_waitcnt vmcnt(0)" ::: "memory");
        __syncthreads();
        if (threadIdx.x == 0) {
            unsigned* c = cnt + 64 * u.pm;
            __hip_atomic_fetch_add(c, 1u, __ATOMIC_RELAXED, __HIP_MEMORY_SCOPE_AGENT);
            unsigned sp = 0u;
            while (__hip_atomic_load(c, __ATOMIC_RELAXED, __HIP_MEMORY_SCOPE_AGENT) < 4u) { __builtin_amdgcn_s_sleep(2); if (++sp > (1u << 20)) break; }
        }
        __syncthreads();
        PG8_LAS float* S = (PG8_LAS float*)lds;
        if (threadIdx.x < 256) S[threadIdx.x] = rstd_of(unsafeAtomicAdd(ss + u.pm * 256 + (int)threadIdx.x, 0.0f));
        __syncthreads();
#pragma unroll
        for (int ai = 0; ai < 2; ++ai)
#pragma unroll
            for (int m = 0; m < 4; ++m) {
                const int rl = ai * 128 + wr * 64 + m * 16 + fr; const float rs = S[rl];
                float* yrow = Y + (size_t)(u.pm * 256 + rl) * D;
#pragma unroll
                for (int bj = 0; bj < 2; ++bj) {
                    const int c = col0 + bj * 128;
                    const f32x4 g0 = *(const f32x4*)(gfin + c), g1 = *(const f32x4*)(gfin + c + 4);
                    __builtin_nontemporal_store(acc[ai][bj][m][0] * rs * g0, (f32x4*)(yrow + c)); __builtin_nontemporal_store(acc[ai][bj][m][1] * rs * g1, (f32x4*)(yrow + c + 4));
                }
            }
        __syncthreads();
    }
};
struct EpiRowBf16 {
    static constexpr bool PERM = true, AFTER_DRAIN = false, MIDSCALE = false, TWOSEG = false;
    bf16_t* O; int ldc; const float* ss; float cst;
    __device__ __forceinline__ void operator()(const f32x4 (&acc)[2][2][4][2], const Unit& u, int wr, int wc, int fr, int fq) const {
        const int row0 = u.pm * 256 + wr * 64 + fr, col0 = u.pn * 256 + wc * 32 + 8 * fq;
        float rsv[2][4];
#pragma unroll
        for (int ai = 0; ai < 2; ++ai)
#pragma unroll
            for (int m = 0; m < 4; ++m) rsv[ai][m] = ss[row0 + ai * 128 + m * 16];
#pragma unroll
        for (int ai = 0; ai < 2; ++ai)
#pragma unroll
            for (int m = 0; m < 4; ++m) {
                const int row = row0 + ai * 128 + m * 16; const float rs = rstd_of(rsv[ai][m]) * cst;
#pragma unroll
                for (int bj = 0; bj < 2; ++bj) {
                    const f32x4 v0 = acc[ai][bj][m][0] * rs, v1 = acc[ai][bj][m][1] * rs;
                    u32x4 w; w.x = cvt_pk_bf16(v0[0], v0[1]); w.y = cvt_pk_bf16(v0[2], v0[3]); w.z = cvt_pk_bf16(v1[0], v1[1]); w.w = cvt_pk_bf16(v1[2], v1[3]);
                    st16(O + (size_t)row * ldc + col0 + bj * 128, w);
                }
            }
    }
};
struct EpiMemKV {
    static constexpr bool PERM = true, AFTER_DRAIN = false, MIDSCALE = false, TWOSEG = false;
    float* out;
    __device__ __forceinline__ void operator()(const f32x4 (&acc)[2][2][4][2], const Unit& u, int wr, int wc, int fr, int fq) const {
        const int row0 = u.pm * 256 + wr * 64 + fr, col0 = u.pn * 256 + wc * 32 + 8 * fq;
#pragma unroll
        for (int ai = 0; ai < 2; ++ai)
#pragma unroll
            for (int m = 0; m < 4; ++m) {
                const int row = row0 + ai * 128 + m * 16;
#pragma unroll
                for (int bj = 0; bj < 2; ++bj) {
                    const int c = col0 + bj * 128;
                    float* dst = out + (c < 1024 ? O_MK : O_MV) + (size_t)row * 1024 + (c & 1023);
                    *(f32x4*)dst = acc[ai][bj][m][0]; *(f32x4*)(dst + 4) = acc[ai][bj][m][1];
                }
            }
    }
};
struct EpiIn {
    static constexpr bool PERM = true, AFTER_DRAIN = false, MIDSCALE = false, TWOSEG = false;
    bf16_t* P; const float* ss; const float* rope; float* out;
    __device__ __forceinline__ void operator()(const f32x4 (&acc)[2][2][4][2], const Unit& u, int wr, int wc, int fr, int fq) const {
        const int row0 = u.pm * 256 + wr * 64 + fr; const int pn = u.pn;
        const int ip = (wc & 1) * 4 + fq, hl = wc >> 1;
        float rsv[2][4];
#pragma unroll
        for (int ai = 0; ai < 2; ++ai)
#pragma unroll
            for (int m = 0; m < 4; ++m) rsv[ai][m] = ss[row0 + ai * 128 + m * 16];
#pragma unroll
        for (int ai = 0; ai < 2; ++ai) {
            f32x4 csv[4][2];
            if (pn >= 4) {
#pragma unroll
                for (int m = 0; m < 4; ++m) {
                    const int row = row0 + ai * 128 + m * 16;
                    const bool smp = row >= MP; const int pos = smp ? SEQ + ((row - MP) & 7) : (row & (SEQ - 1));
                    const float* rp = rope + ((size_t)pos * 32 + 4 * ip) * 2; csv[m][0] = *(const f32x4*)rp; csv[m][1] = *(const f32x4*)(rp + 4);
                }
            }
#pragma unroll
            for (int m = 0; m < 4; ++m) {
                const int row = row0 + ai * 128 + m * 16; const float rs = rstd_of(rsv[ai][m]);
                const bool smp = row >= MP; const int t = smp ? ((row - MP) & 7) : (row & (SEQ - 1)); const int sq = smp ? ((row - MP) >> 3) : (row >> 13);
                bf16_t* prow = P + (size_t)row * NIN;
                if (pn < 4) {
#pragma unroll
                    for (int bj = 0; bj < 2; ++bj) {
                        const int c = pn * 256 + bj * 128 + wc * 32 + 8 * fq;
                        const f32x4 v0 = acc[ai][bj][m][0] * rs, v1 = acc[ai][bj][m][1] * rs;
                        u32x4 w; w.x = cvt_pk_bf16(v0[0], v0[1]); w.y = cvt_pk_bf16(v0[2], v0[3]); w.z = cvt_pk_bf16(v1[0], v1[1]); w.w = cvt_pk_bf16(v1[2], v1[3]);
                        st16(prow + c, w);
                        if (pn < 2) {
                            float* dst = nullptr;
                            if (!smp && t >= SEQ - 3) dst = out + O_CP + ((size_t)sq * 3 + (t - (SEQ - 3))) * 512 + c;
                            else if (smp && t >= 5) dst = out + O_CS + ((size_t)sq * 3 + (t - 5)) * 512 + c;
                            if (dst) { *(f32x4*)dst = v0; *(f32x4*)(dst + 4) = v1; }
                        }
                    }
                } else {
                    const f32x4 cs0 = csv[m][0], cs1 = csv[m][1];
#pragma unroll
                    for (int bj = 0; bj < 2; ++bj) {
                        const bool isv = (pn == 6 && bj == 1);
                        if (!isv) {
                            const f32x4 z1 = acc[ai][bj][m][0] * rs, z2 = acc[ai][bj][m][1] * rs;
                            f32x4 o1, o2;
                            o1[0] = z1[0] * cs0[0] - z2[0] * cs0[1]; o2[0] = z2[0] * cs0[0] + z1[0] * cs0[1];
                            o1[1] = z1[1] * cs0[2] - z2[1] * cs0[3]; o2[1] = z2[1] * cs0[2] + z1[1] * cs0[3];
                            o1[2] = z1[2] * cs1[0] - z2[2] * cs1[1]; o2[2] = z2[2] * cs1[0] + z1[2] * cs1[1];
                            o1[3] = z1[3] * cs1[2] - z2[3] * cs1[3]; o2[3] = z2[3] * cs1[2] + z1[3] * cs1[3];
                            if (pn < 6) {
                                const int head = (pn - 4) * 4 + bj * 2 + hl; o1 = o1 * C2S; o2 = o2 * C2S;
                                bf16_t* d = prow + 1024 + head * 64 + 4 * ip;
                                u32x2 a; a.x = cvt_pk_bf16(o1[0], o1[1]); a.y = cvt_pk_bf16(o1[2], o1[3]); st8(d, a);
                                u32x2 b; b.x = cvt_pk_bf16(o2[0], o2[1]); b.y = cvt_pk_bf16(o2[2], o2[3]); st8(d + 32, b);
                            } else {
                                const int head = hl;
                                bf16_t* d = prow + 1536 + head * 64 + 4 * ip;
                                u32x2 a; a.x = cvt_pk_bf16(o1[0], o1[1]); a.y = cvt_pk_bf16(o1[2], o1[3]); st8(d, a);
                                u32x2 b; b.x = cvt_pk_bf16(o2[0], o2[1]); b.y = cvt_pk_bf16(o2[2], o2[3]); st8(d + 32, b);
                                float* dst = nullptr;
                                if (!smp && t >= SEQ - 128) dst = out + O_SKP + ((size_t)sq * 128 + (t - (SEQ - 128))) * 128 + head * 64 + 4 * ip;
                                else if (smp) dst = out + O_SKS + ((size_t)sq * 128 + 120 + t) * 128 + head * 64 + 4 * ip;
                                if (dst) { *(f32x4*)dst = o1; *(f32x4*)(dst + 32) = o2; }
                            }
                        } else {
                            const int cv = wc * 32 + 8 * fq;
                            const f32x4 v0 = acc[ai][bj][m][0] * rs, v1 = acc[ai][bj][m][1] * rs;
                            u32x4 w; w.x = cvt_pk_bf16(v0[0], v0[1]); w.y = cvt_pk_bf16(v0[2], v0[3]); w.z = cvt_pk_bf16(v1[0], v1[1]); w.w = cvt_pk_bf16(v1[2], v1[3]);
                            st16(prow + 1664 + cv, w);
                            float* dst = nullptr;
                            if (!smp && t >= SEQ - 128) dst = out + O_SVP + ((size_t)sq * 128 + (t - (SEQ - 128))) * 128 + cv;
                            else if (smp) dst = out + O_SVS + ((size_t)sq * 128 + 120 + t) * 128 + cv;
                            if (dst) { *(f32x4*)dst = v0; *(f32x4*)(dst + 4) = v1; }
                        }
                    }
                }
            }
        }
    }
};

struct Args { const float* in[37]; float* out; unsigned char* ws; double inv_rev[32]; int use_cg; int pad; };
struct Ctx {
    LAS unsigned char* lds; int tid, lane, wave, G, bid;
    const float* const* in; float* out; unsigned char* ws;
    float* SS; float* ROPE; float* SUMA; float* SUMB; bf16_t* WAB; bf16_t* XB; bf16_t* H; float* X; bf16_t* PROJ; bf16_t* MIX; bf16_t* QX; bf16_t* XO;
};
__device__ __forceinline__ float wave_sum(float v) {
#pragma unroll
    for (int o = 1; o < 64; o <<= 1) v += __shfl_xor(v, o);
    return v;
}
__device__ __forceinline__ int dst_row_of(int mode, int row_off, int n) {
    if (mode == 0) return row_off + n;
    if (mode == 1) return (n >> 7) * 256 + row_off + (n & 127);
    if (n < 1024 || n >= 1664) return n;
    const int hb = (n - 1024) >> 6, dd = (n - 1024) & 63, nn = dd >> 5, rem = dd & 31, i = rem >> 2, e = rem & 3;
    return 1024 + hb * 64 + 8 * i + 4 * nn + e;
}
struct P0Item { const float* W; bf16_t* WT; const float* g0; int K, N, mode, row_off, r; };
__device__ __forceinline__ P0Item p0_item(Ctx& F, int it) {
    unsigned char* ws = F.ws;
    constexpr int I_GU = 16 * 88, I_DN = 44 * 32, I_IN = 16 * 56, I_SQ = 16 * 32;
    static_assert(I_GU == I_DN, "");
    int r = it; P0Item d;
    if (r < I_GU) { d = P0Item{F.in[10], (bf16_t*)(ws + WS_W1GU), F.in[9], D, FF, 1, 0, r}; return d; } r -= I_GU;
    if (r < I_GU) { d = P0Item{F.in[11], (bf16_t*)(ws + WS_W1GU), F.in[9], D, FF, 1, 128, r}; return d; } r -= I_GU;
    if (r < I_DN) { d = P0Item{F.in[12], (bf16_t*)(ws + WS_W1D), nullptr, FF, D, 0, 0, r}; return d; } r -= I_DN;
    if (r < I_GU) { d = P0Item{F.in[33], (bf16_t*)(ws + WS_W2GU), F.in[32], D, FF, 1, 0, r}; return d; } r -= I_GU;
    if (r < I_GU) { d = P0Item{F.in[34], (bf16_t*)(ws + WS_W2GU), F.in[32], D, FF, 1, 128, r}; return d; } r -= I_GU;
    if (r < I_DN) { d = P0Item{F.in[35], (bf16_t*)(ws + WS_W2D), nullptr, FF, D, 0, 0, r}; return d; } r -= I_DN;
    if (r < I_IN) { d = P0Item{F.in[14], (bf16_t*)(ws + WS_WIN), F.in[13], D, NIN, 2, 0, r}; return d; } r -= I_IN;
    if (r < I_SQ / 2) { d = P0Item{F.in[25], (bf16_t*)(ws + WS_WOUT), F.in[23], 512, D, 0, 0, r}; return d; } r -= I_SQ / 2;
    if (r < I_SQ / 2) { d = P0Item{F.in[25] + 512 * 1024, (bf16_t*)(ws + WS_WOUT + MiB), F.in[24], 512, D, 0, 0, r}; return d; } r -= I_SQ / 2;
    if (r < I_SQ) { d = P0Item{F.in[28], (bf16_t*)(ws + WS_WCQ), F.in[26], D, D, 0, 0, r}; return d; } r -= I_SQ;
    if (r < I_SQ) { d = P0Item{F.in[29], (bf16_t*)(ws + WS_WCKV), nullptr, D, D, 0, 0, r}; return d; } r -= I_SQ;
    if (r < I_SQ) { d = P0Item{F.in[30], (bf16_t*)(ws + WS_WCKV), nullptr, D, D, 0, 1024, r}; return d; } r -= I_SQ;
    d = P0Item{F.in[31], (bf16_t*)(ws + WS_WCO), nullptr, D, D, 0, 0, r}; return d;
}
__device__ __forceinline__ void p0_load_item(const P0Item& d, float (&v)[32], int lane) {
    const int nblk = d.N / 32, kb = d.r / nblk, nb = d.r % nblk, k0 = 64 * kb, n0 = 32 * nb;
#pragma unroll
    for (int i = 0; i < 32; ++i) { const int k = k0 + 2 * i + (lane >> 5); v[i] = __builtin_nontemporal_load(d.W + (size_t)k * d.N + n0 + (lane & 31)) * (d.g0 ? d.g0[k] : 1.0f); }
}
__device__ __forceinline__ void p0_store_item(const P0Item& d, const float (&v)[32], LAS float* scr, int lane) {
    const int nblk = d.N / 32, kb = d.r / nblk, nb = d.r % nblk, k0 = 64 * kb, n0 = 32 * nb;
#pragma unroll
    for (int i = 0; i < 32; ++i) scr[(2 * i + (lane >> 5)) * 33 + (lane & 31)] = v[i];
    asm volatile("s_waitcnt lgkmcnt(0)" ::: "memory");
    const int c = lane & 7;
#pragma unroll
    for (int j = 0; j < 4; ++j) {
        const int n = (lane >> 3) + 8 * j; const LAS float* s = scr + (8 * c) * 33 + n;
        u32x4 o; o.x = cvt_pk_bf16(s[0 * 33], s[1 * 33]); o.y = cvt_pk_bf16(s[2 * 33], s[3 * 33]); o.z = cvt_pk_bf16(s[4 * 33], s[5 * 33]); o.w = cvt_pk_bf16(s[6 * 33], s[7 * 33]);
        *(u32x4*)(d.WT + (size_t)dst_row_of(d.mode, d.row_off, n0 + n) * d.K + k0 + 8 * c) = o;
    }
    asm volatile("s_waitcnt lgkmcnt(0)" ::: "memory");
}
__device__ __forceinline__ void p0_prologue(Ctx& F, const double* inv_rev) {
    LAS float* scr = (LAS float*)(F.lds + F.wave * 16384);
    const int gw = F.bid * 8 + F.wave, NGW = F.G * 8;
    constexpr int NITEMS = 6 * 1408 + 896 + 5 * 512;
#ifndef DUP_P0A
#define DUP_P0A 0
#endif
#ifndef DUP_P0B
#define DUP_P0B 0
#endif
#ifndef DUP_P0C
#define DUP_P0C 0
#endif
    for (int rp_ = 0; rp_ <= DUP_P0A; ++rp_) {
        float cur[32]; int it = gw;
        if (it < NITEMS) { const P0Item d = p0_item(F, it); p0_load_item(d, cur, F.lane); }
        for (; it < NITEMS; it += NGW) {
            float nxt[32]; const bool more = it + NGW < NITEMS;
            if (more) { const P0Item dn = p0_item(F, it + NGW); p0_load_item(dn, nxt, F.lane); }
            const P0Item d = p0_item(F, it);
            p0_store_item(d, cur, scr, F.lane);
            if (more) {
#pragma unroll
                for (int i = 0; i < 32; ++i) cur[i] = nxt[i];
            }
        }
    }
    for (int rp_ = 0; rp_ <= DUP_P0B; ++rp_)
    for (int mb = gw; mb < M + MEMR; mb += 4 * NGW) {
        f32x4 v[4][4]; float s[4];
#pragma unroll
        for (int r = 0; r < 4; ++r) {
            const int m = mb + r * NGW; s[r] = 0.f;
            if (m < M + MEMR) {
                const float* src = m < MP ? F.in[0] + (size_t)m * D : (m < M ? F.in[1] + (size_t)(m - MP) * D : F.in[2] + (size_t)(m - M) * D);
                const f32x4* xr = (const f32x4*)src + F.lane;
#pragma unroll
                for (int j = 0; j < 4; ++j) v[r][j] = __builtin_nontemporal_load(xr + 64 * j);
            }
        }
#pragma unroll
        for (int r = 0; r < 4; ++r) {
            const int m = mb + r * NGW;
            if (m < M + MEMR) {
#pragma unroll
                for (int j = 0; j < 4; ++j) s[r] += (v[r][j][0] * v[r][j][0] + v[r][j][1] * v[r][j][1]) + (v[r][j][2] * v[r][j][2] + v[r][j][3] * v[r][j][3]);
                s[r] = wave_sum(s[r]);
                if (m < M) { if (F.lane == 0) F.SS[m] = s[r]; }
                else { const float rs = rstd_of(s[r]); const f32x4* gr = (const f32x4*)F.in[27] + F.lane;
#pragma unroll
                    for (int j = 0; j < 4; ++j) v[r][j] = v[r][j] * rs * gr[64 * j]; }
                u32x2* o8 = (u32x2*)(F.XB + (size_t)m * D) + F.lane;
#pragma unroll
                for (int j = 0; j < 4; ++j) { u32x2 w; w.x = pk2(v[r][j][0], v[r][j][1]); w.y = pk2(v[r][j][2], v[r][j][3]); o8[64 * j] = w; }
            }
        }
    }
    const int gt = F.bid * 512 + F.tid, NGT = F.G * 512;
    for (int rp_ = 0; rp_ <= DUP_P0C; ++rp_) {
    for (int i = gt; i < 6 * M; i += NGT) F.SS[M + i] = 0.f;
    for (int i = gt; i < ROPE_POS * 32; i += NGT) {
        const int pos = i >> 5, fi = i & 31; const double rev = (double)pos * inv_rev[fi]; const float fr = (float)(rev - floor(rev));
        F.ROPE[2 * i] = __builtin_amdgcn_cosf(fr); F.ROPE[2 * i + 1] = __builtin_amdgcn_sinf(fr);
    }
    {
        f32x4 ck[4], cv[4];
#pragma unroll
        for (int u = 0; u < 4; ++u) { const int i = gt + u * NGT; if (i < 128 * 3840) { const int n = i / 3840, r = i % 3840;
            ck[u] = __builtin_nontemporal_load((const f32x4*)(F.in[5] + (size_t)n * 16384 + 1024) + r); cv[u] = __builtin_nontemporal_load((const f32x4*)(F.in[6] + (size_t)n * 16384 + 1024) + r); } }
#pragma unroll
        for (int u = 0; u < 4; ++u) { const int i = gt + u * NGT; if (i < 128 * 3840) { const int n = i / 3840, r = i % 3840;
            __builtin_nontemporal_store(ck[u], (f32x4*)(F.out + O_SKS + (size_t)n * 16384) + r); __builtin_nontemporal_store(cv[u], (f32x4*)(F.out + O_SVS + (size_t)n * 16384) + r); } }
    }
    for (int i = gt; i < 2 * 8 * 64 * 64; i += NGT) {
        const int k = i & 63, n = (i >> 6) & 63, g = (i >> 12) & 7, mat = i >> 15;
        F.WAB[i] = f2bf((mat ? F.in[19] : F.in[17])[((size_t)g * 64 + k) * 64 + n]);
    }
    }
}
#define XB_TMO      128
#define XB_XCNT(j)  (256  + 64 * (j))
#define XB_XSUB(j)  (1280 + 64 * (j))
#define XB_XGEN(j)  (2304 + 64 * (j))
#define XB_TOP      3328
#define XB_TOPGEN   3392
#define XCD_BAR_WORDS 3456
#define XB_SPIN_CAP (1u << 18)

__device__ __forceinline__ unsigned xb_ld(unsigned* p)              { return __hip_atomic_load(p, __ATOMIC_RELAXED, __HIP_MEMORY_SCOPE_AGENT); }
__device__ __forceinline__ unsigned xb_add(unsigned* p, unsigned v) { return __hip_atomic_fetch_add(p, v, __ATOMIC_RELAXED, __HIP_MEMORY_SCOPE_AGENT); }
__device__ __forceinline__ unsigned xb_xcc_id() { return (unsigned)__builtin_amdgcn_s_getreg((3 << 11) | 20) & 0xFu; }
#define XB_SPIN(cond, bar) do { unsigned _sp = 0; while (cond) { __builtin_amdgcn_s_sleep(1); \
    if ((++_sp & 255u) == 0u) { if (xb_ld(&(bar)[XB_TMO])) break; if (_sp > XB_SPIN_CAP) { atomicAdd(&(bar)[XB_TMO], 1u); break; } } } } while (0)

struct XcdBarrier {
    unsigned* bar; unsigned x;
    volatile LAS unsigned* st;
};

__device__ __forceinline__ XcdBarrier xcd_barrier_post(unsigned* bar, volatile LAS unsigned* st) {
    XcdBarrier b; b.bar = bar; b.x = xb_xcc_id(); b.st = st;
    if (threadIdx.x == 0) (void)xb_add(&bar[XB_XCNT(b.x)], 1u);
    return b;
}
__device__ __forceinline__ void xcd_barrier_complete(unsigned* bar, unsigned x, unsigned& nloc, unsigned& nx) {
    const unsigned G = gridDim.x * gridDim.y * gridDim.z;
    unsigned sum, cnt, mine, sp = 0u;
    for (;;) {
        sum = 0u; cnt = 0u; mine = 0u;
#pragma unroll
        for (unsigned j = 0; j < 16; ++j) { const unsigned c = xb_ld(&bar[XB_XCNT(j)]); sum += c; cnt += (c > 0u) ? 1u : 0u; mine = (j == x) ? c : mine; }
        if (sum == G) break;
        __builtin_amdgcn_s_sleep(1);
        if ((++sp & 255u) == 0u) { if (xb_ld(&bar[XB_TMO])) break; if (sp > XB_SPIN_CAP) { atomicAdd(&bar[XB_TMO], 1u); break; } }
    }
    nloc = mine > 0u ? mine : 1u; nx = cnt > 0u ? cnt : 1u;
}

__device__ __forceinline__ void xcd_barrier(const XcdBarrier& b) {
    asm volatile("s_waitcnt vmcnt(0)" ::: "memory");
    __syncthreads();
    if (threadIdx.x == 0) {
        unsigned* bar = b.bar;
        __builtin_amdgcn_s_waitcnt(0);
        unsigned nloc = b.st[0], nx = b.st[1];
        if (nloc == 0u) { xcd_barrier_complete(bar, b.x, nloc, nx); b.st[0] = nloc; b.st[1] = nx; }
        const unsigned old = xb_add(&bar[XB_XSUB(b.x)], 1u);
        const unsigned gen = old / nloc;
        if (old + 1u == (gen + 1u) * nloc) {
            __builtin_amdgcn_fence(__ATOMIC_RELEASE, "agent");
            asm volatile("s_waitcnt vmcnt(0)" ::: "memory");
            const unsigned og = xb_add(&bar[XB_TOP], 1u);
            const unsigned tg = og / nx;
            if (og + 1u == (tg + 1u) * nx) xb_add(&bar[XB_TOPGEN], 1u);
            else XB_SPIN(xb_ld(&bar[XB_TOPGEN]) == tg, bar);
            __builtin_amdgcn_fence(__ATOMIC_ACQUIRE, "agent");
            xb_add(&bar[XB_XGEN(b.x)], 1u);
            asm volatile("s_waitcnt vmcnt(0)" ::: "memory");
        } else {
            XB_SPIN(xb_ld(&bar[XB_XGEN(b.x)]) == gen, bar);
            __builtin_amdgcn_fence(__ATOMIC_ACQUIRE, "agent");
            asm volatile("s_waitcnt vmcnt(0)" ::: "memory");
        }
    }
    __syncthreads();
}

template <bool SAMPLE, int PASS, int NH>
__device__ __forceinline__ void lru_tile(Ctx& F, int m0, int bn  , int k  , float* ssl) {
    const int g = F.wave, lane = F.lane, c = g * 64 + lane;
    LAS unsigned char* ldsw = F.lds + g * 16384;
    const float* conv_w = F.in[15]; const float cw0 = conv_w[c], cw1 = conv_w[512 + c], cw2 = conv_w[1024 + c], cw3 = conv_w[1536 + c], cb = F.in[16][c];
    const float ba = F.in[18][c], bi = F.in[20][c], lamv = F.in[21][c];
    const float sp8 = 8.0f * (fmaxf(-lamv, 0.f) + log1pf(__expf(-fabsf(lamv))));
    const bf16_t* Pu = F.PROJ + (size_t)m0 * NIN + c;
    const float* scv = F.in[7] + (size_t)bn * 1536 + c;
    float x0 = 0.f, x1 = 0.f, x2 = 0.f;
    if (!SAMPLE && k > 0) { x0 = bf2f(Pu[-3 * NIN]); x1 = bf2f(Pu[-2 * NIN]); x2 = bf2f(Pu[-NIN]); }
    float h = 0.f, Ap = 1.f;
    if (!SAMPLE && PASS == 2 && k > 0) {
        const float* sa = F.SUMA + (size_t)bn * 128 * 512 + c; const float* sb = F.SUMB + (size_t)bn * 128 * 512 + c;
        const int kq = (k + 3) >> 2;
        float qa[4] = {1.f, 1.f, 1.f, 1.f}, qb[4] = {0.f, 0.f, 0.f, 0.f};
#pragma unroll 4
        for (int j = 0; j < kq; ++j) {
#pragma unroll
            for (int q = 0; q < 4; ++q) { const int jj = q * kq + j; if (jj < k) { const float a = sa[(size_t)jj * 512], b = sb[(size_t)jj * 512]; qa[q] *= a; qb[q] = a * qb[q] + b; } }
        }
#pragma unroll
        for (int q = 0; q < 4; ++q) h = qa[q] * h + qb[q];
    }
    LAS float* pre_r = (LAS float*)ldsw; LAS float* pre_i = pre_r + 2048;
#pragma unroll 1
    for (int half = 0; half < NH; ++half) {
        unsigned short uu[32], gg[32]; float st[4][3], hs[4];
        {
            const bf16_t* rp = F.PROJ + ((size_t)(m0 + 32 * half) * NIN + g * 64) + (size_t)(lane >> 3) * NIN + (lane & 7) * 8;
            u32x4 wu[4], wg[4];
#pragma unroll
            for (int i = 0; i < 4; ++i) { wu[i] = *(const u32x4*)(rp + (size_t)(8 * i) * NIN); if (PASS == 2) wg[i] = *(const u32x4*)(rp + (size_t)(8 * i) * NIN + 512); }
            LAS bf16_t* ut = (LAS bf16_t*)ldsw; LAS bf16_t* gt = ut + 2048;
#pragma unroll
            for (int i = 0; i < 4; ++i) { *(LAS u32x4*)(ut + ((lane >> 3) + 8 * i) * 64 + (lane & 7) * 8) = wu[i]; if (PASS == 2) *(LAS u32x4*)(gt + ((lane >> 3) + 8 * i) * 64 + (lane & 7) * 8) = wg[i]; }
            asm volatile("s_waitcnt lgkmcnt(0)" ::: "memory");
#pragma unroll
            for (int j = 0; j < 32; ++j) { uu[j] = ut[j * 64 + lane]; gg[j] = (PASS == 2) ? gt[j * 64 + lane] : (unsigned short)0; }
            asm volatile("s_waitcnt lgkmcnt(0)" ::: "memory");
        }
        if (SAMPLE) {
#pragma unroll
            for (int sq = 0; sq < 4; ++sq) { const float* sc = scv + (size_t)(4 * half + sq) * 1536; st[sq][0] = sc[0]; st[sq][1] = sc[512]; st[sq][2] = sc[1024]; hs[sq] = F.in[8][(size_t)(bn + 4 * half + sq) * 512 + c]; }
        }
        {
            LAS bf16_t* convb = (LAS bf16_t*)(ldsw + 8192); float xa = x0, xb = x1, xc = x2;
#pragma unroll
            for (int j = 0; j < 32; ++j) {
                if (SAMPLE && (j & 7) == 0) { xa = st[j >> 3][0]; xb = st[j >> 3][1]; xc = st[j >> 3][2]; }
                const float xi = bf2f(uu[j]);
                const float cv = (((cb + cw0 * xa) + cw1 * xb) + cw2 * xc) + cw3 * xi; xa = xb; xb = xc; xc = xi;
                convb[j * 72 + lane] = (unsigned short)cvt_pk_bf16(cv, cv);
            }
        }
        asm volatile("s_waitcnt lgkmcnt(0)" ::: "memory");
        bf16x8 Af[2][2];
        {
            const LAS bf16_t* convb = (const LAS bf16_t*)(ldsw + 8192);
#pragma unroll
            for (int tt = 0; tt < 2; ++tt)
#pragma unroll
                for (int ks = 0; ks < 2; ++ks) Af[tt][ks] = *(const LAS bf16x8*)(convb + (16 * tt + (lane & 15)) * 72 + 32 * ks + 8 * (lane >> 4));
        }
        asm volatile("s_waitcnt lgkmcnt(0)" ::: "memory");
#pragma unroll
        for (int nt = 0; nt < 4; ++nt) {
            const bf16_t* wa = F.WAB + ((size_t)g * 64 + 16 * nt + (lane & 15)) * 64 + 8 * (lane >> 4); const bf16_t* wi = wa + 8 * 64 * 64;
            const bf16x8 Ba0 = *(const bf16x8*)wa, Ba1 = *(const bf16x8*)(wa + 32), Bi0 = *(const bf16x8*)wi, Bi1 = *(const bf16x8*)(wi + 32);
#pragma unroll
            for (int tt2 = 0; tt2 < 2; ++tt2) {
                f32x4 ar = (f32x4){0.f, 0.f, 0.f, 0.f}, ai = ar;
                ar = __builtin_amdgcn_mfma_f32_16x16x32_bf16(Af[tt2][0], Ba0, ar, 0, 0, 0); ar = __builtin_amdgcn_mfma_f32_16x16x32_bf16(Af[tt2][1], Ba1, ar, 0, 0, 0);
                ai = __builtin_amdgcn_mfma_f32_16x16x32_bf16(Af[tt2][0], Bi0, ai, 0, 0, 0); ai = __builtin_amdgcn_mfma_f32_16x16x32_bf16(Af[tt2][1], Bi1, ai, 0, 0, 0);
                const int nn = (16 * nt + (lane & 15)) ^ (((lane >> 4) & 1) << 4);
#pragma unroll
                for (int j = 0; j < 4; ++j) { const int il = 16 * tt2 + 4 * (lane >> 4) + j; pre_r[il * 64 + nn] = ar[j]; pre_i[il * 64 + nn] = ai[j]; }
            }
        }
        asm volatile("s_waitcnt lgkmcnt(0)" ::: "memory");
#pragma unroll
        for (int il = 0; il < 32; il += 2) {
            typedef float v2f __attribute__((ext_vector_type(2)));
            const int i = 32 * half + il; const int nn = lane ^ (((il >> 2) & 1) << 4);
            if (SAMPLE && (il & 7) == 0) { x0 = st[il >> 3][0]; x1 = st[il >> 3][1]; x2 = st[il >> 3][2]; h = hs[il >> 3]; }
            const float xa = bf2f(uu[il]), xb = bf2f(uu[il + 1]);
            v2f cv = (v2f){cb, cb} + (v2f){x0, x1} * cw0; cv = cv + (v2f){x1, x2} * cw1; cv = cv + (v2f){x2, xa} * cw2; cv = cv + (v2f){xa, xb} * cw3;
            x0 = x2; x1 = xa; x2 = xb;
            const v2f tr = ((v2f){pre_r[il * 64 + nn], pre_r[(il + 1) * 64 + nn]} + ba) * (-LOG2E), ti = ((v2f){pre_i[il * 64 + nn], pre_i[(il + 1) * 64 + nn]} + bi) * (-LOG2E);
            const v2f r = (v2f){__builtin_amdgcn_rcpf(1.0f + fexp2(tr.x)), __builtin_amdgcn_rcpf(1.0f + fexp2(tr.y))};
            const v2f gi = (v2f){__builtin_amdgcn_rcpf(1.0f + fexp2(ti.x)), __builtin_amdgcn_rcpf(1.0f + fexp2(ti.y))};
            const v2f la = r * (-sp8), al = la * LOG2E, xx = la * 2.0f;
            const v2f a = (v2f){fexp2(al.x), fexp2(al.y)};
            const v2f ser = -xx * (1.0f + xx * 0.5f * (1.0f + xx * (1.0f / 3.0f) * (1.0f + xx * 0.25f * (1.0f + xx * 0.2f * (1.0f + xx * (1.0f / 6.0f))))));
            const v2f alt = 1.0f - a * a;
            const float om0 = xx.x > -0.25f ? ser.x : alt.x, om1 = xx.y > -0.25f ? ser.y : alt.y;
            const v2f sq = (v2f){__builtin_amdgcn_sqrtf(fmaxf(om0, 0.f)), __builtin_amdgcn_sqrtf(fmaxf(om1, 0.f))};
            const v2f bb = sq * (gi * cv);
            const float h0 = a.x * h + bb.x, h1 = a.y * h0 + bb.y; h = h1;
            if (PASS == 1) Ap *= a.x * a.y;
            if (PASS == 2) {
                const v2f g2 = (v2f){bf2f(gg[il]), bf2f(gg[il + 1])};
                const v2f z = (g2 + g2 * g2 * g2 * 0.044715f) * (-2.0f * 0.7978845608028654f * LOG2E);
                const v2f sg = (v2f){__builtin_amdgcn_rcpf(1.0f + fexp2(z.x)), __builtin_amdgcn_rcpf(1.0f + fexp2(z.y))};
                const v2f yv = (v2f){h0, h1} * g2 * sg;
                const unsigned yp = cvt_pk_bf16(yv.x, yv.y);
                ((LAS unsigned*)pre_i)[il * 64 + nn] = yp & 0xffffu; ((LAS unsigned*)pre_i)[(il + 1) * 64 + nn] = yp >> 16;
                const float y0 = __uint_as_float(yp << 16), y1 = __uint_as_float(yp & 0xffff0000u);
                pre_r[il * 64 + nn] = y0 * y0; pre_r[(il + 1) * 64 + nn] = y1 * y1;
                if (SAMPLE && (il & 7) == 6) F.out[O_HS + (size_t)(bn + (i >> 3)) * 512 + c] = h1;
            }
            if ((il & 7) == 6) __builtin_amdgcn_sched_barrier(0);
        }
        asm volatile("s_waitcnt lgkmcnt(0)" ::: "memory");
        if (PASS == 2) {
            if (lane < 32) {
                float s = 0.f;
#pragma unroll 8
                for (int j = 0; j < 64; ++j) s += pre_r[lane * 64 + ((j + lane) & 63)];
                unsafeAtomicAdd(ssl + m0 + 32 * half + lane, s);
            }
            {
                const LAS unsigned* yw = (const LAS unsigned*)pre_i;
#pragma unroll
                for (int i = 0; i < 4; ++i) {
                    const int row = (lane >> 3) + 8 * i, ch8 = ((lane & 7) * 8) ^ (((row >> 2) & 1) << 4);
                    const u32x4 lo = *(const LAS u32x4*)(yw + row * 64 + ch8), hi4 = *(const LAS u32x4*)(yw + row * 64 + ch8 + 4);
                    u32x4 w; w.x = (lo.x & 0xffffu) | (lo.y << 16); w.y = (lo.z & 0xffffu) | (lo.w << 16); w.z = (hi4.x & 0xffffu) | (hi4.y << 16); w.w = (hi4.z & 0xffffu) | (hi4.w << 16);
                    st16(F.MIX + (size_t)(m0 + 32 * half + row) * 512 + g * 64 + (lane & 7) * 8, w);
                }
            }
            asm volatile("s_waitcnt lgkmcnt(0)" ::: "memory");
        }
    }
    if (PASS == 1) {
        __hip_atomic_store((unsigned*)(F.SUMA + ((size_t)bn * 128 + k) * 512 + c), __float_as_uint(Ap), __ATOMIC_RELAXED, __HIP_MEMORY_SCOPE_AGENT);
        __hip_atomic_store((unsigned*)(F.SUMB + ((size_t)bn * 128 + k) * 512 + c), __float_as_uint(h), __ATOMIC_RELAXED, __HIP_MEMORY_SCOPE_AGENT);
    }
    if (PASS == 2) { if (!SAMPLE && k == 127) F.out[O_HP + (size_t)bn * 512 + c] = h; }
}

constexpr int SWA_KS = 136, SWA_VS = 204, SWA_VOFF = 192 * SWA_KS * 2;
__device__ __forceinline__ int crow(int r, int hi) { return (r & 3) + 8 * (r >> 2) + 4 * hi; }
__device__ __forceinline__ unsigned short bf_at(const u32x4& v, int e) { return (unsigned short)(v[e >> 1] >> ((e & 1) * 16)); }
template <bool SAMPLE>
__device__ __forceinline__ void swa_qtile(Ctx& F, const bf16_t* qrow  , int kb, int tb  , int h, float sk, bf16_t* orow, float* ssrow) {
    const int lane = F.lane, q = lane & 31, hi = lane >> 5, kvh = h >> 2;
    const LAS bf16_t* Kl = (const LAS bf16_t*)F.lds; const LAS bf16_t* Vt = (const LAS bf16_t*)(F.lds + SWA_VOFF);
    bf16x8 qf[4];
#pragma unroll
    for (int ks = 0; ks < 4; ++ks) qf[ks] = *(const bf16x8*)(qrow + 16 * ks + 8 * hi);
    f32x16 s[5];
#pragma unroll
    for (int kt = 0; kt < 5; ++kt) {
        s[kt] = (f32x16){0.f, 0.f, 0.f, 0.f, 0.f, 0.f, 0.f, 0.f, 0.f, 0.f, 0.f, 0.f, 0.f, 0.f, 0.f, 0.f};
#pragma unroll
        for (int ks = 0; ks < 4; ++ks) {
            const bf16x8 a = *(const LAS bf16x8*)(Kl + (kb + 32 * kt + q) * SWA_KS + kvh * 64 + 16 * ks + 8 * hi);
            s[kt] = __builtin_amdgcn_mfma_f32_32x32x16_bf16(a, qf[ks], s[kt], 0, 0, 0);
        }
    }
    float mx = sk;
#pragma unroll
    for (int kt = 0; kt < 5; ++kt)
#pragma unroll
        for (int r = 0; r < 16; ++r) {
            const int kk = 32 * kt + crow(r, hi); bool valid;
            if (SAMPLE) valid = (kk < 128) ? (kk >= q + 1) : (kk - 128 <= q && kk < 136);
            else valid = (kk >= q + 1) && (kk <= q + 128) && (tb + kk >= 0);
            const float sv = valid ? s[kt][r] : -INFINITY; s[kt][r] = sv; mx = fmaxf(mx, sv);
        }
    mx = fmaxf(mx, __shfl_xor(mx, 32));
    float l = 0.f; bf16x8 pb[10];
#pragma unroll
    for (int kt = 0; kt < 5; ++kt) {
        float p[16];
#pragma unroll
        for (int r = 0; r < 16; ++r) { p[r] = fexp2(s[kt][r] - mx); l += p[r]; }
#pragma unroll
        for (int hf = 0; hf < 2; ++hf) {
            u32x4 w; w.x = cvt_pk_bf16(p[8 * hf + 0], p[8 * hf + 1]); w.y = cvt_pk_bf16(p[8 * hf + 2], p[8 * hf + 3]); w.z = cvt_pk_bf16(p[8 * hf + 4], p[8 * hf + 5]); w.w = cvt_pk_bf16(p[8 * hf + 6], p[8 * hf + 7]);
            pb[2 * kt + hf] = __builtin_bit_cast(bf16x8, w);
        }
    }
    l += __shfl_xor(l, 32); l += fexp2(sk - mx);
    const float inv = 1.0f / l; float sq = 0.f;
    const bool wr_ok = !SAMPLE || q < 8;
#pragma unroll
    for (int dt = 0; dt < 2; ++dt) {
        f32x16 o = (f32x16){0.f, 0.f, 0.f, 0.f, 0.f, 0.f, 0.f, 0.f, 0.f, 0.f, 0.f, 0.f, 0.f, 0.f, 0.f, 0.f};
#pragma unroll
        for (int u = 0; u < 10; ++u) {
            const LAS bf16_t* vp = Vt + (kvh * 64 + 32 * dt + q) * SWA_VS + kb + 16 * u + 4 * hi;
            const u32x2 lo = *(const LAS u32x2*)vp, hi4 = *(const LAS u32x2*)(vp + 8);
            u32x4 w; w.x = lo.x; w.y = lo.y; w.z = hi4.x; w.w = hi4.y;
            o = __builtin_amdgcn_mfma_f32_32x32x16_bf16(__builtin_bit_cast(bf16x8, w), pb[u], o, 0, 0, 0);
        }
#pragma unroll
        for (int r = 0; r < 16; ++r) { o[r] *= inv; sq += o[r] * o[r]; }
        if (wr_ok) {
#pragma unroll
            for (int rg = 0; rg < 4; ++rg) {
                u32x2 w; w.x = cvt_pk_bf16(o[4 * rg], o[4 * rg + 1]); w.y = cvt_pk_bf16(o[4 * rg + 2], o[4 * rg + 3]);
                st8(orow + 32 * dt + 8 * rg + 4 * hi, w);
            }
        }
    }
    sq += __shfl_xor(sq, 32);
    if (wr_ok && hi == 0) unsafeAtomicAdd(ssrow, sq);
}
__device__ __forceinline__ void swa_prompt_item(Ctx& F, int b, int qb, float* ssa) {
    const int tid = F.tid, lane = F.lane, h = F.wave, q = lane & 31;
    LAS bf16_t* Kl = (LAS bf16_t*)F.lds; LAS bf16_t* Vt = (LAS bf16_t*)(F.lds + SWA_VOFF);
    const int tb = 64 * qb - 128; const size_t rowbase = (size_t)b * SEQ;
    const u32x4 z4 = (u32x4){0u, 0u, 0u, 0u};
#pragma unroll
    for (int i = 0; i < 6; ++i) { const int p = tid + 512 * i, key = p >> 4, ch = p & 15, tok = tb + key;
        const u32x4 v = tok >= 0 ? *(const u32x4*)(F.PROJ + (rowbase + tok) * NIN + 1536 + ch * 8) : z4;
        *(LAS u32x4*)(Kl + key * SWA_KS + ch * 8) = v; }
#pragma unroll
    for (int i = 0; i < 3; ++i) { const int p = tid + 512 * i, ch = (p & 3) + 4 * (p / 384), kp = (p % 384) >> 2, tok = tb + 2 * kp;
        const u32x4 v0 = tok >= 0 ? *(const u32x4*)(F.PROJ + (rowbase + tok) * NIN + 1664 + ch * 8) : z4;
        const u32x4 v1 = tok + 1 >= 0 ? *(const u32x4*)(F.PROJ + (rowbase + tok + 1) * NIN + 1664 + ch * 8) : z4;
#pragma unroll
        for (int e = 0; e < 8; ++e) *(LAS unsigned*)(Vt + (ch * 8 + e) * SWA_VS + 2 * kp) = (unsigned)bf_at(v0, e) | ((unsigned)bf_at(v1, e) << 16); }
    __syncthreads();
    const float sk = F.in[22][h] * LOG2E;
    const size_t m0 = rowbase + 64 * qb;
    swa_qtile<false>(F, F.PROJ + (m0 + q) * NIN + 1024 + h * 64, 0, tb, h, sk, (F.MIX + (size_t)M * 512) + (m0 + q) * 512 + h * 64, ssa + m0 + q);
    swa_qtile<false>(F, F.PROJ + (m0 + 32 + q) * NIN + 1024 + h * 64, 32, tb + 32, h, sk, (F.MIX + (size_t)M * 512) + (m0 + 32 + q) * 512 + h * 64, ssa + m0 + 32 + q);
    __syncthreads();
}
__device__ __forceinline__ void swa_sample_item(Ctx& F, int n, float* ssa) {
    const int tid = F.tid, lane = F.lane, h = F.wave, q = lane & 31;
    LAS bf16_t* Kl = (LAS bf16_t*)F.lds; LAS bf16_t* Vt = (LAS bf16_t*)(F.lds + SWA_VOFF);
    const size_t m0 = (size_t)MP + 8 * n;
    const float* ck = F.in[5] + (size_t)n * 16384; const float* cv = F.in[6] + (size_t)n * 16384;
    const u32x4 z4 = (u32x4){0u, 0u, 0u, 0u};
#pragma unroll
    for (int i = 0; i < 5; ++i) { const int p = tid + 512 * i, key = p >> 4, ch = p & 15;
        u32x4 v = z4;
        if (key < 128) { const f32x4 a = __builtin_nontemporal_load((const f32x4*)(ck + key * 128 + ch * 8)), bq = __builtin_nontemporal_load((const f32x4*)(ck + key * 128 + ch * 8 + 4));
            v.x = cvt_pk_bf16(a[0], a[1]); v.y = cvt_pk_bf16(a[2], a[3]); v.z = cvt_pk_bf16(bq[0], bq[1]); v.w = cvt_pk_bf16(bq[2], bq[3]); }
        else if (key < 136) v = *(const u32x4*)(F.PROJ + (m0 + key - 128) * NIN + 1536 + ch * 8);
        *(LAS u32x4*)(Kl + key * SWA_KS + ch * 8) = v; }
#pragma unroll
    for (int i = 0; i < 3; ++i) { const int p = tid + 512 * i;
        if (p < 1280) { const int ch = (p & 3) + 4 * (p / 320), kp = (p % 320) >> 2, key = 2 * kp;
            u32x4 v0 = z4, v1 = z4;
            if (key < 128) {
                const f32x4 a0 = __builtin_nontemporal_load((const f32x4*)(cv + key * 128 + ch * 8)), b0 = __builtin_nontemporal_load((const f32x4*)(cv + key * 128 + ch * 8 + 4)), a1 = __builtin_nontemporal_load((const f32x4*)(cv + (key + 1) * 128 + ch * 8)), b1 = __builtin_nontemporal_load((const f32x4*)(cv + (key + 1) * 128 + ch * 8 + 4));
                v0.x = cvt_pk_bf16(a0[0], a0[1]); v0.y = cvt_pk_bf16(a0[2], a0[3]); v0.z = cvt_pk_bf16(b0[0], b0[1]); v0.w = cvt_pk_bf16(b0[2], b0[3]);
                v1.x = cvt_pk_bf16(a1[0], a1[1]); v1.y = cvt_pk_bf16(a1[2], a1[3]); v1.z = cvt_pk_bf16(b1[0], b1[1]); v1.w = cvt_pk_bf16(b1[2], b1[3]);
            } else if (key < 136) { v0 = *(const u32x4*)(F.PROJ + (m0 + key - 128) * NIN + 1664 + ch * 8); v1 = *(const u32x4*)(F.PROJ + (m0 + key + 1 - 128) * NIN + 1664 + ch * 8); }
#pragma unroll
            for (int e = 0; e < 8; ++e) *(LAS unsigned*)(Vt + (ch * 8 + e) * SWA_VS + 2 * kp) = (unsigned)bf_at(v0, e) | ((unsigned)bf_at(v1, e) << 16); } }
    __syncthreads();
    const float sk = F.in[22][h] * LOG2E;
    const int qc = q < 8 ? q : 7;
    swa_qtile<true>(F, F.PROJ + (m0 + qc) * NIN + 1024 + h * 64, 0, 0, h, sk, (F.MIX + (size_t)M * 512) + (m0 + qc) * 512 + h * 64, ssa + m0 + qc);
    __syncthreads();
}

constexpr int XK_S = 72, XV_S = 260, XV_OFF = 256 * XK_S * 2;
template <bool SAMPLE>
__device__ __forceinline__ void xattn_item(Ctx& F, const float* Ksrc, const float* Vsrc, int h, size_t m0) {
    const int tid = F.tid, lane = F.lane, q = lane & 31, hi = lane >> 5;
    LAS bf16_t* Kc = (LAS bf16_t*)F.lds; LAS bf16_t* Vtc = (LAS bf16_t*)(F.lds + XV_OFF);
    const bool active = SAMPLE ? (F.wave == 0) : true;
    const size_t qr = SAMPLE ? m0 + (q < 8 ? q : 7) : m0 + 32 * F.wave + q;
    const bf16_t* qrow = F.QX + qr * D + h * 256;
    f32x16 S[8];
#pragma unroll
    for (int kt = 0; kt < 8; ++kt) S[kt] = (f32x16){0.f, 0.f, 0.f, 0.f, 0.f, 0.f, 0.f, 0.f, 0.f, 0.f, 0.f, 0.f, 0.f, 0.f, 0.f, 0.f};
#define XLD(ptr) (SAMPLE ? __builtin_nontemporal_load((const f32x4*)(ptr)) : *(const f32x4*)(ptr))
    f32x4 pre[8];
    const float* kbase = Ksrc + (size_t)(tid >> 4) * 1024 + h * 256 + 4 * (tid & 15);
    const float* vbase = Vsrc + (size_t)(2 * (tid >> 2)) * 1024 + h * 256 + 4 * (tid & 3);
#pragma unroll
    for (int i = 0; i < 8; ++i) pre[i] = XLD(kbase + (size_t)i * 32 * 1024);
    for (int ch = 0; ch < 4; ++ch) {
        __syncthreads();
#pragma unroll
        for (int i = 0; i < 8; ++i) { u32x2 w; w.x = cvt_pk_bf16(pre[i][0], pre[i][1]); w.y = cvt_pk_bf16(pre[i][2], pre[i][3]); *(LAS u32x2*)(Kc + ((tid >> 4) + 32 * i) * XK_S + 4 * (tid & 15)) = w; }
        __syncthreads();
        if (ch < 3) {
#pragma unroll
            for (int i = 0; i < 8; ++i) pre[i] = XLD(kbase + (size_t)i * 32 * 1024 + 64 * (ch + 1));
        } else {
#pragma unroll
            for (int i = 0; i < 4; ++i) { pre[2 * i] = XLD(vbase + 16 * i); pre[2 * i + 1] = XLD(vbase + 1024 + 16 * i); }
        }
        if (active) {
#pragma unroll 1
            for (int ks = 0; ks < 4; ++ks) {
                const bf16x8 qf = *(const bf16x8*)(qrow + 64 * ch + 16 * ks + 8 * hi);
#pragma unroll
                for (int kt = 0; kt < 8; ++kt) {
                    const bf16x8 a = *(const LAS bf16x8*)(Kc + (32 * kt + q) * XK_S + 16 * ks + 8 * hi);
                    S[kt] = __builtin_amdgcn_mfma_f32_32x32x16_bf16(a, qf, S[kt], 0, 0, 0);
                }
            }
        }
    }
    float mx = -INFINITY;
#pragma unroll
    for (int kt = 0; kt < 8; ++kt)
#pragma unroll
        for (int r = 0; r < 16; ++r) mx = fmaxf(mx, S[kt][r]);
    mx = fmaxf(mx, __shfl_xor(mx, 32));
    float l = 0.f; bf16x8 pb[16];
#pragma unroll
    for (int kt = 0; kt < 8; ++kt) {
        float p[16];
#pragma unroll
        for (int r = 0; r < 16; ++r) { p[r] = fexp2(S[kt][r] - mx); l += p[r]; }
#pragma unroll
        for (int hf = 0; hf < 2; ++hf) {
            u32x4 w; w.x = cvt_pk_bf16(p[8 * hf + 0], p[8 * hf + 1]); w.y = cvt_pk_bf16(p[8 * hf + 2], p[8 * hf + 3]); w.z = cvt_pk_bf16(p[8 * hf + 4], p[8 * hf + 5]); w.w = cvt_pk_bf16(p[8 * hf + 6], p[8 * hf + 7]);
            pb[2 * kt + hf] = __builtin_bit_cast(bf16x8, w);
        }
    }
    l += __shfl_xor(l, 32);
    const float inv = 1.0f / l;
    bf16_t* orow = F.XO + qr * D + h * 256;
    for (int ch = 0; ch < 4; ++ch) {
        __syncthreads();
#pragma unroll
        for (int i = 0; i < 4; ++i) {
#pragma unroll
            for (int e = 0; e < 4; ++e) *(LAS unsigned*)(Vtc + (4 * ((tid & 3) + 4 * i) + e) * XV_S + 2 * (tid >> 2)) = cvt_pk_bf16(pre[2 * i][e], pre[2 * i + 1][e]); }
        __syncthreads();
        if (ch < 3) {
#pragma unroll
            for (int i = 0; i < 4; ++i) { pre[2 * i] = XLD(vbase + 64 * (ch + 1) + 16 * i); pre[2 * i + 1] = XLD(vbase + 1024 + 64 * (ch + 1) + 16 * i); }
        }
        if (active) {
#pragma unroll
            for (int dt = 0; dt < 2; ++dt) {
                f32x16 o = (f32x16){0.f, 0.f, 0.f, 0.f, 0.f, 0.f, 0.f, 0.f, 0.f, 0.f, 0.f, 0.f, 0.f, 0.f, 0.f, 0.f};
#pragma unroll
                for (int u = 0; u < 16; ++u) {
                    const LAS bf16_t* vp = Vtc + (32 * dt + q) * XV_S + 16 * u + 4 * hi;
                    const u32x2 lo = *(const LAS u32x2*)vp, hi4 = *(const LAS u32x2*)(vp + 8);
                    u32x4 w; w.x = lo.x; w.y = lo.y; w.z = hi4.x; w.w = hi4.y;
                    o = __builtin_amdgcn_mfma_f32_32x32x16_bf16(__builtin_bit_cast(bf16x8, w), pb[u], o, 0, 0, 0);
                }
                if (!SAMPLE || q < 8) {
#pragma unroll
                    for (int rg = 0; rg < 4; ++rg) {
                        u32x2 w; w.x = cvt_pk_bf16(o[4 * rg] * inv, o[4 * rg + 1] * inv); w.y = cvt_pk_bf16(o[4 * rg + 2] * inv, o[4 * rg + 3] * inv);
                        st8(orow + 64 * ch + 32 * dt + 8 * rg + 4 * hi, w);
                    }
                }
            }
        }
    }
    __syncthreads();
}

struct MiniSeg { const bf16_t* A; const bf16_t* Bt; int K; const float* rowss; };
template <int MODE  , int NSEG>
__device__ __forceinline__ void mini_gemm(Ctx& F, const MiniSeg& sg0, const MiniSeg& sg1, float cscale, const float* base_s  , bf16_t* XB, float* ss_out, bf16_t* O, const float* ssin, float cst,
                                          unsigned* cnt_s = nullptr, const float* gfin = nullptr, float* Y = nullptr  ) {
    const int t = F.bid; if (t >= 256) return;
    const int lane = F.lane, w = F.wave, fr = lane & 15, fq = lane >> 4;
    const int R0 = (t >> 4) * 64, C0 = (t & 15) * 64;
    f32x4 acc[4][4];
#pragma unroll
    for (int mt = 0; mt < 4; ++mt)
#pragma unroll
        for (int nt = 0; nt < 4; ++nt) acc[mt][nt] = (f32x4){0.f, 0.f, 0.f, 0.f};
#pragma unroll
    for (int s_ = 0; s_ < NSEG; ++s_) {
        const MiniSeg& sg = s_ ? sg1 : sg0;
        const int K = sg.K, nsteps = K >> 8;
        const bf16_t* pa = sg.A + (size_t)(R0 + fr) * K + (size_t)w * (K >> 3) + 8 * fq; const bf16_t* pb = sg.Bt + (size_t)(C0 + fr) * K + (size_t)w * (K >> 3) + 8 * fq;
        f32x4 sacc[4][4];
        if (NSEG > 1) {
#pragma unroll
            for (int mt = 0; mt < 4; ++mt)
#pragma unroll
                for (int nt = 0; nt < 4; ++nt) sacc[mt][nt] = (f32x4){0.f, 0.f, 0.f, 0.f};
        }
        constexpr int NB = (NSEG > 1) ? 2 : 4;
#pragma unroll 1
        for (int s0 = 0; s0 < nsteps; s0 += NB) {
            bf16x8 a[NB][4], b[NB][4];
#pragma unroll
            for (int s = 0; s < NB; ++s)
                if (s0 + s < nsteps) {
#pragma unroll
                    for (int i = 0; i < 4; ++i) { a[s][i] = *(const bf16x8*)(pa + (size_t)(16 * i) * K + 32 * (s0 + s)); b[s][i] = *(const bf16x8*)(pb + (size_t)(16 * i) * K + 32 * (s0 + s)); }
                }
#pragma unroll
            for (int s = 0; s < NB; ++s)
                if (s0 + s < nsteps) {
#pragma unroll
                    for (int mt = 0; mt < 4; ++mt)
#pragma unroll
                        for (int nt = 0; nt < 4; ++nt) {
                            if (NSEG > 1) sacc[mt][nt] = __builtin_amdgcn_mfma_f32_16x16x32_bf16(b[s][nt], a[s][mt], sacc[mt][nt], 0, 0, 0);
                            else acc[mt][nt] = __builtin_amdgcn_mfma_f32_16x16x32_bf16(b[s][nt], a[s][mt], acc[mt][nt], 0, 0, 0);
                        }
                }
        }
        if (NSEG > 1) {
#pragma unroll
            for (int mt = 0; mt < 4; ++mt) {
                const float sc = rsqrtf(sg.rowss[MP + R0 + 16 * mt + fr] * (1.0f / 512.0f) + EPS);
#pragma unroll
                for (int nt = 0; nt < 4; ++nt) acc[mt][nt] = acc[mt][nt] + sacc[mt][nt] * sc;
            }
        }
    }
    LAS float* part = (LAS float*)(F.lds + w * 16384);
#pragma unroll
    for (int mt = 0; mt < 4; ++mt)
#pragma unroll
        for (int nt = 0; nt < 4; ++nt) { const int row = 16 * mt + fr, chn = (4 * nt + fq) ^ fr; *(LAS f32x4*)(part + row * 64 + 4 * chn) = acc[mt][nt]; }
    __syncthreads();
    const int r = 8 * w + (lane >> 3), j = lane & 7;
    f32x4 t0 = (f32x4){0.f, 0.f, 0.f, 0.f}, t1 = t0;
#pragma unroll
    for (int pw = 0; pw < 8; ++pw) {
        const LAS float* pp = (const LAS float*)(F.lds + pw * 16384) + r * 64;
        t0 = t0 + *(const LAS f32x4*)(pp + 4 * ((2 * j) ^ (r & 15))); t1 = t1 + *(const LAS f32x4*)(pp + 4 * ((2 * j + 1) ^ (r & 15)));
    }
    const int R = MP + R0 + r, C = C0 + 8 * j;
    if (MODE == 0 || MODE == 2) {
        if (NSEG == 1) { t0 = t0 * cscale; t1 = t1 * cscale; }
        f32x4 b0, b1;
        if (base_s) { b0 = *(const f32x4*)(base_s + (size_t)(R - MP) * D + C); b1 = *(const f32x4*)(base_s + (size_t)(R - MP) * D + C + 4); }
        else { const u32x4 wv = *(const u32x4*)(XB + (size_t)R * D + C);
            b0 = (f32x4){__uint_as_float(wv.x << 16), __uint_as_float(wv.x & 0xffff0000u), __uint_as_float(wv.y << 16), __uint_as_float(wv.y & 0xffff0000u)};
            b1 = (f32x4){__uint_as_float(wv.z << 16), __uint_as_float(wv.z & 0xffff0000u), __uint_as_float(wv.w << 16), __uint_as_float(wv.w & 0xffff0000u)}; }
        const f32x4 v0 = b0 + t0, v1 = b1 + t1;
        if (MODE == 0) { u32x4 wo; wo.x = cvt_pk_bf16(v0[0], v0[1]); wo.y = cvt_pk_bf16(v0[2], v0[3]); wo.z = cvt_pk_bf16(v1[0], v1[1]); wo.w = cvt_pk_bf16(v1[2], v1[3]);
            *(u32x4*)(XB + (size_t)R * D + C) = wo; }
        float sq = (v0[0] * v0[0] + v0[1] * v0[1]) + (v0[2] * v0[2] + v0[3] * v0[3]) + (v1[0] * v1[0] + v1[1] * v1[1]) + (v1[2] * v1[2] + v1[3] * v1[3]);
        sq += __shfl_xor(sq, 1); sq += __shfl_xor(sq, 2); sq += __shfl_xor(sq, 4);
        if (j == 0) unsafeAtomicAdd(ss_out + R, sq);
        if (MODE == 2) {
            asm volatile("s_waitcnt vmcnt(0)" ::: "memory");
            __syncthreads();
            if (threadIdx.x == 0) {
                unsigned* c = cnt_s + 64 * (t >> 4);
                __hip_atomic_fetch_add(c, 1u, __ATOMIC_RELAXED, __HIP_MEMORY_SCOPE_AGENT);
                unsigned sp = 0u;
                while (__hip_atomic_load(c, __ATOMIC_RELAXED, __HIP_MEMORY_SCOPE_AGENT) < 16u) { __builtin_amdgcn_s_sleep(2); if (++sp > (1u << 20)) break; }
            }
            __syncthreads();
            float s = 0.f; if (j == 0) s = unsafeAtomicAdd(ss_out + R, 0.0f);
            s = __shfl(s, lane & ~7);
            const float rs = rstd_of(s);
            const f32x4 g0 = *(const f32x4*)(gfin + C), g1 = *(const f32x4*)(gfin + C + 4);
            __builtin_nontemporal_store(v0 * rs * g0, (f32x4*)(Y + (size_t)R * D + C)); __builtin_nontemporal_store(v1 * rs * g1, (f32x4*)(Y + (size_t)R * D + C + 4));
        }
    } else {
        const float rs = rstd_of(ssin[R]) * cst;
        const f32x4 v0 = t0 * rs, v1 = t1 * rs;
        u32x4 wo; wo.x = cvt_pk_bf16(v0[0], v0[1]); wo.y = cvt_pk_bf16(v0[2], v0[3]); wo.z = cvt_pk_bf16(v1[0], v1[1]); wo.w = cvt_pk_bf16(v1[2], v1[3]);
        st16(O + (size_t)R * D + C, wo);
    }
    __syncthreads();
}

__global__ void __launch_bounds__(512, 2) hymba_fwd(Args args) {
    extern __shared__ __attribute__((aligned(16))) unsigned char lds_raw[];
    cg::grid_group grid = cg::this_grid();
    Ctx F;
    F.lds = (LAS unsigned char*)lds_raw; F.tid = threadIdx.x; F.lane = F.tid & 63; F.wave = __builtin_amdgcn_readfirstlane(F.tid >> 6); F.G = gridDim.x; F.bid = blockIdx.x;
    F.in = args.in; F.out = args.out; F.ws = args.ws;
    unsigned char* ws = args.ws;
    F.SS = (float*)(ws + WS_SS); F.ROPE = (float*)(ws + WS_ROPE); F.SUMA = (float*)(ws + WS_SUM); F.SUMB = F.SUMA + 256 * 512; F.WAB = (bf16_t*)(ws + WS_WAB);
    F.XB = (bf16_t*)(ws + WS_XB); F.H = (bf16_t*)(ws + WS_H); F.X = (float*)(ws + WS_X); F.PROJ = (bf16_t*)(ws + WS_PROJ); F.MIX = (bf16_t*)(ws + WS_MIX);
    F.QX = (bf16_t*)(ws + WS_QX); F.XO = (bf16_t*)(ws + WS_XO);
    float* ss0 = F.SS; float* ss1 = F.SS + M; float* ss2 = F.SS + 2 * M; float* ss3 = F.SS + 3 * M; float* ss4 = F.SS + 4 * M;
    constexpr size_t WS_BAR = WS_WAB + 2 * MiB;
    unsigned* const barw = (unsigned*)(ws + WS_BAR);
    volatile LAS unsigned* const barst = (volatile LAS unsigned*)(F.lds + MISC_OFF + 8192);
    if (threadIdx.x < 2) barst[threadIdx.x] = 0u;
    __syncthreads();
    XcdBarrier xbar = xcd_barrier_post(barw, barst);
#define GRID_SYNC() xcd_barrier(xbar)
#define RETID() do { int t_ = threadIdx.x; asm volatile("" : "+v"(t_)); F.tid = t_; F.lane = t_ & 63; F.wave = __builtin_amdgcn_readfirstlane(t_ >> 6); } while (0)
#ifndef PHASE_MASK
#define PHASE_MASK 0xFFFF
#endif
#define PH(k) if constexpr (((PHASE_MASK) >> (k)) & 1)
#ifndef DUP_MASK
#define DUP_MASK 0
#endif
#ifndef EXTRA_SYNCS
#define EXTRA_SYNCS 0
#endif
#define REP(k) for (int rep = 0; rep < 1 + (((DUP_MASK) >> (k)) & 1); ++rep)
    float* const ssdummy = (float*)(ws + WS_WAB + MiB);

    PH(0) REP(0) { RETID(); p0_prologue(F, args.inv_rev); }
    if (args.use_cg) grid.sync();
    GRID_SYNC();
    for (int e = 0; e < EXTRA_SYNCS; ++e) GRID_SYNC();
    PH(1) REP(1) {
        Gemm g{F.XB, (const bf16_t*)(ws + WS_W1GU), M, 2 * FF, D}; StaticOrder S; S.init(M, 2 * FF, F.G, F.bid);
        EpiGU E{F.H, ss0};
        gemm_phase<EpiGU, StaticOrder, true, true>(F.lds, g, S, E);
        Gemm g2{F.XB + (size_t)M * D, (const bf16_t*)(ws + WS_WCKV), MEMR, 2 * D, D}; StaticOrder S2; S2.init(MEMR, 2 * D, F.G, F.G - 1 - F.bid);
        EpiMemKV E2{F.out};
        gemm_phase<EpiMemKV, StaticOrder, true, true>(F.lds, g2, S2, E2);
    }
    GRID_SYNC();
    PH(2) {
        Gemm g{F.H, (const bf16_t*)(ws + WS_W1D), MP, D, FF}; StaticOrder S; S.init(MP, D, F.G, F.bid);
        EpiRes<false, false> E{nullptr, nullptr, F.XB, ss1, 0.5f, nullptr};
        gemm_phase<EpiRes<false, false>, StaticOrder, true, true>(F.lds, g, S, E);
        RETID(); const MiniSeg s0{F.H + (size_t)MP * FF, (const bf16_t*)(ws + WS_W1D), FF, nullptr};
        mini_gemm<0, 1>(F, s0, s0, 0.5f, nullptr, F.XB, ss1, nullptr, nullptr, 0.f);
    }
    GRID_SYNC();
    PH(3) REP(3) {
        Gemm g{F.XB, (const bf16_t*)(ws + WS_WIN), M, NIN, D}; StaticOrder S; S.init(M, NIN, F.G, F.bid);
        EpiIn E{F.PROJ, ss1, F.ROPE, F.out};
        gemm_phase<EpiIn, StaticOrder, true, true>(F.lds, g, S, E);
    }
    GRID_SYNC();
    unsigned* const cntl = barw + 9216;
    PH(4) { RETID(); for (int it = F.bid; it < 256; it += F.G) lru_tile<false, 1, 2>(F, (it >> 7) * SEQ + (it & 127) * 64, it >> 7, it & 127, nullptr); }
    asm volatile("s_waitcnt vmcnt(0)" ::: "memory");
    __syncthreads();
    if (threadIdx.x == 0 && F.bid < 256) __hip_atomic_fetch_add(cntl + 64 * (F.bid >> 7), 1u, __ATOMIC_RELAXED, __HIP_MEMORY_SCOPE_AGENT);
    PH(13) REP(13) { RETID(); float* ssa = rep ? ssdummy : F.SS + 6 * M; for (int it = F.bid; it < 256 + 128; it += F.G) { if (it < 256) swa_prompt_item(F, it >> 7, it & 127, ssa); else swa_sample_item(F, it - 256, ssa); }
        if (rep == 0 && F.bid >= 128 && F.bid < 160) { const int st = F.bid - 128; lru_tile<true, 2, 1>(F, MP + st * 32, st * 4, 0, F.SS + 5 * M); } }
    if (threadIdx.x == 0 && F.bid < 256) {
        unsigned sp = 0u;
        while (__hip_atomic_load(cntl + 64 * (F.bid >> 7), __ATOMIC_RELAXED, __HIP_MEMORY_SCOPE_AGENT) < 128u) { __builtin_amdgcn_s_sleep(2); if (++sp > (1u << 20)) break; }
        __builtin_amdgcn_fence(__ATOMIC_ACQUIRE, "agent");
        asm volatile("s_waitcnt vmcnt(0)" ::: "memory");
    }
    __syncthreads();
    PH(5) REP(5) { RETID(); float* ssl = rep ? ssdummy : F.SS + 5 * M;
        for (int it = F.bid; it < 256; it += F.G) lru_tile<false, 2, 2>(F, (it >> 7) * SEQ + (it & 127) * 64, it >> 7, it & 127, ssl);
    }
    GRID_SYNC();
    PH(6) {
        StaticOrder2 S; S.init(MP, D, F.G, F.bid);
        Gemm g{F.MIX, (const bf16_t*)(ws + WS_WOUT), MP, D, 512, F.MIX + (size_t)M * 512, (const bf16_t*)(ws + WS_WOUT + MiB)};
        EpiMix E{F.XB, ss2, F.SS + 5 * M, F.SS + 6 * M};
        gemm_phase<EpiMix, StaticOrder2, true, true>(F.lds, g, S, E);
        RETID(); const MiniSeg s0{F.MIX + (size_t)MP * 512, (const bf16_t*)(ws + WS_WOUT), 512, F.SS + 5 * M}, s1{F.MIX + (size_t)(M + MP) * 512, (const bf16_t*)(ws + WS_WOUT + MiB), 512, F.SS + 6 * M};
        mini_gemm<0, 2>(F, s0, s1, 1.0f, nullptr, F.XB, ss2, nullptr, nullptr, 0.f);
    }
    GRID_SYNC();
    PH(7) REP(7) {
        Gemm g{F.XB, (const bf16_t*)(ws + WS_WCQ), MP, D, D}; StaticOrder S; S.init(MP, D, F.G, F.bid);
        EpiRowBf16 E{F.QX, D, ss2, C2X};
        gemm_phase<EpiRowBf16, StaticOrder, true, true>(F.lds, g, S, E);
        RETID(); const MiniSeg s0{F.XB + (size_t)MP * D, (const bf16_t*)(ws + WS_WCQ), D, nullptr};
        mini_gemm<1, 1>(F, s0, s0, 1.0f, nullptr, nullptr, nullptr, F.QX, ss2, C2X);
    }
    GRID_SYNC();
    PH(8) REP(8) { RETID();
        if (F.bid < 256) {
            const int itp = F.bid, b = itp >> 7, hp = (itp >> 5) & 3, qb = itp & 31;
            if (!(F.bid & 1)) xattn_item<false>(F, F.out + O_MK + (size_t)b * 262144, F.out + O_MV + (size_t)b * 262144, hp, (size_t)b * SEQ + 256 * qb);
#pragma unroll 1
            for (int sl = 0; sl < 2; ++sl) { const int j = F.bid + 256 * sl, n = j >> 2, h = j & 3;
                xattn_item<true>(F, F.in[3] + (size_t)n * 262144, F.in[4] + (size_t)n * 262144, h, (size_t)MP + 8 * n); }
            if (F.bid & 1) xattn_item<false>(F, F.out + O_MK + (size_t)b * 262144, F.out + O_MV + (size_t)b * 262144, hp, (size_t)b * SEQ + 256 * qb);
        }
    }
    GRID_SYNC();
    PH(9) {
        Gemm g{F.XO, (const bf16_t*)(ws + WS_WCO), MP, D, D}; StaticOrder S; S.init(MP, D, F.G, F.bid);
        EpiRes<false, false> E{nullptr, nullptr, F.XB, ss3, 1.0f, nullptr};
        gemm_phase<EpiRes<false, false>, StaticOrder, true, true>(F.lds, g, S, E);
        RETID(); const MiniSeg s0{F.XO + (size_t)MP * D, (const bf16_t*)(ws + WS_WCO), D, nullptr};
        mini_gemm<0, 1>(F, s0, s0, 1.0f, nullptr, F.XB, ss3, nullptr, nullptr, 0.f);
    }
    GRID_SYNC();
    PH(10) REP(10) {
        Gemm g{F.XB, (const bf16_t*)(ws + WS_W2GU), M, 2 * FF, D}; StaticOrder S; S.init(M, 2 * FF, F.G, F.bid);
        EpiGU E{F.H, ss3};
        gemm_phase<EpiGU, StaticOrder, true, true>(F.lds, g, S, E);
    }
    GRID_SYNC();
    PH(11) {
        unsigned* cntp = barw + 4096; unsigned* cnts = barw + 8192;
        Gemm g{F.H, (const bf16_t*)(ws + WS_W2D), MP, D, FF}; StaticOrder S; S.init(MP, D, F.G, F.bid);
        EpiFinal E{F.XB, ss4, cntp, F.in[36], F.out + O_Y, 0.5f};
        gemm_phase<EpiFinal, StaticOrder, false, true>(F.lds, g, S, E);
        RETID(); const MiniSeg s0{F.H + (size_t)MP * FF, (const bf16_t*)(ws + WS_W2D), FF, nullptr};
        mini_gemm<2, 1>(F, s0, s0, 0.5f, nullptr, F.XB, ss4, nullptr, nullptr, 0.f, cnts, F.in[36], F.out + O_Y);
    }
}

extern "C" void kernel_launch(void* const* d_in, const int* in_sizes, int n_in, void* d_out, int out_size, void* d_ws, size_t ws_size, hipStream_t stream) {
    static int grid = 0;
    if (grid == 0) {
        if (n_in != 37 || (size_t)out_size != O_END || ws_size < WS_END) { fprintf(stderr, "kernel_launch: unexpected shapes: n_in %d out %d (want %zu) ws %zu (want >= %zu)\n", n_in, out_size, (size_t)O_END, ws_size, (size_t)WS_END); grid = -1; return; }
        int dev = 0, cus = 0, per_cu = 0;
        hipGetDevice(&dev); hipDeviceGetAttribute(&cus, hipDeviceAttributeMultiprocessorCount, dev);
        if (hipFuncSetAttribute((const void*)hymba_fwd, hipFuncAttributeMaxDynamicSharedMemorySize, LDS_BYTES) != hipSuccess) { fprintf(stderr, "kernel_launch: hipFuncSetAttribute failed\n"); grid = -1; return; }
        if (hipOccupancyMaxActiveBlocksPerMultiprocessor(&per_cu, (const void*)hymba_fwd, 512, LDS_BYTES) != hipSuccess || per_cu < 1) { fprintf(stderr, "kernel_launch: occupancy query says %d blocks/CU\n", per_cu); (void)hipGetLastError(); per_cu = 1; }
        grid = cus;
        if (grid != 256) fprintf(stderr, "kernel_launch: note: %d CUs\n", grid);
    }
    if (grid < 0) return;
    Args a; memset(&a, 0, sizeof(a));
    for (int i = 0; i < 37; ++i) a.in[i] = (const float*)d_in[i];
    a.out = (float*)d_out; a.ws = (unsigned char*)d_ws;
    for (int i = 0; i < 32; ++i) a.inv_rev[i] = std::pow(10000.0, -(double)i / 32.0) / 6.283185307179586476925;
    a.use_cg = 0;
    if (hipMemsetAsync((char*)d_ws + WS_WAB + 2 * MiB, 0, 40960, stream) != hipSuccess) { fprintf(stderr, "kernel_launch: memset of barrier words failed\n"); return; }
    void* kargs[] = {&a};
    hipError_t e = hipLaunchCooperativeKernel((const void*)hymba_fwd, dim3(grid), dim3(512), kargs, LDS_BYTES, stream);
    if (e != hipSuccess) fprintf(stderr, "kernel_launch: cooperative launch failed: %s (grid %d)\n", hipGetErrorString(e), grid);
}
```

```cpp
#include <hip/hip_runtime.h>
#include <hip/hip_cooperative_groups.h>
#include <cstdio>
#include <cstdint>
#include <cmath>
#include <cstring>
namespace cg = cooperative_groups;
namespace pg8 {
#define PG8_LAS __attribute__((address_space(3)))
typedef unsigned short bf16_t;
typedef short bf16x8 __attribute__((ext_vector_type(8)));
typedef float f32x4 __attribute__((ext_vector_type(4)));
typedef unsigned u32x4 __attribute__((ext_vector_type(4)));
constexpr int BM = 256, BK = 64, HALF = 128, HTB = HALF * BK * 2  , STAGE_BYTES = 8 * HTB, NXCD = 8, WGM = 8;

__host__ __device__ __forceinline__ int lds_byte(int r, int c) { const int st = (r >> 4) * 2 + (c >> 5), rr = r & 15, cc = c & 31, ob = rr * 64 + cc * 2; return st * 1024 + (ob ^ (((ob >> 9) & 1) << 5)); }
__host__ __device__ __forceinline__ void stage_rc(int b, int& R, int& C) { const int st = b / 1024, sb = b % 1024, swz = sb ^ (((sb >> 9) & 1) << 5); R = (st >> 1) * 16 + swz / 64; C = (st & 1) * 32 + (swz % 64) / 2; }
__host__ __device__ __forceinline__ int perm32(int rho) { const int n = rho >> 4, i = rho & 15; return 8 * (i >> 2) + 4 * n + (i & 3); }

struct Unit { int pm, pn, seg; };
struct Gemm { const bf16_t* A; const bf16_t* Bt; int M, N, K; const bf16_t* A2; const bf16_t* Bt2; };

struct StaticOrder {
    int nM, nN, nwg, G, c;
    __host__ __device__ void init(int M, int N, int G_, int c_) { nM = M / BM; nN = N / BM; nwg = nM * nN; G = G_; c = c_; }
    __host__ __device__ bool next(int i, Unit& u) const {
        const long L = (long)i * G + c; if (L >= nwg) return false;
        int wgid = (int)L; { const int q = nwg / NXCD, r = nwg % NXCD, xcd = wgid % NXCD, off = wgid / NXCD; wgid = (xcd < r ? xcd * (q + 1) : r * (q + 1) + (xcd - r) * q) + off; }
        const int nig = WGM * nN, gid = wgid / nig, fm = gid * WGM, gsz = (nM - fm) < WGM ? (nM - fm) : WGM;
        u.pm = fm + ((wgid % nig) % gsz); u.pn = (wgid % nig) / gsz; u.seg = 0; return true;
    }
    __device__ __forceinline__ void a_ready(const Unit&) const {}
    __device__ __forceinline__ void done(const Unit&) const {}
};

__device__ __forceinline__ unsigned cvt_pk_bf16(float lo, float hi) { unsigned r; asm volatile("v_cvt_pk_bf16_f32 %0, %1, %2" : "=v"(r) : "v"(lo), "v"(hi)); return r; }

template <class Epi, class Sched, bool ALIGN_EPI = false, bool SP2 = false>
__device__ __forceinline__ void gemm_phase(PG8_LAS unsigned char* lds, const Gemm g, const Sched& S, const Epi& E) {
    int tid_ = threadIdx.x; asm volatile("" : "+v"(tid_)); const int tid = tid_, wid = __builtin_amdgcn_readfirstlane(tid >> 6), lane = tid & 63, wr = wid >> 2, wc = wid & 3, fr = lane & 15, fq = lane >> 4;
    const int K = g.K, nt = K / BK;
    unsigned voffA[2], voffB[2];
#pragma unroll
    for (int i = 0; i < 2; ++i) { int R, C; stage_rc(tid * 16 + i * 8192, R, C); const int Rb = Epi::PERM ? ((R & ~31) + perm32(R & 31)) : R;
        voffA[i] = (unsigned)(R * K + C) * 2u; voffB[i] = (unsigned)(Rb * K + C) * 2u; }
    const size_t kstep = (size_t)(BK * 2);
    const size_t hstep = (size_t)HALF * K * 2;
    const size_t tstep = 2 * hstep;
    const unsigned ldsw = (unsigned)wid * 1024u;
    const int aoff = lds_byte(wr * 64 + fr, fq * 8), boff = lds_byte(wc * 32 + fr, fq * 8);
#define PG8_SA(b, h) (((b) * 2 + (h)) * HTB)
#define PG8_SB(b, h) ((4 + (b) * 2 + (h)) * HTB)
#define PG8_STAGE(bufoff, gbase, voff) do { _Pragma("unroll") for (int _i = 0; _i < 2; ++_i) \
        __builtin_amdgcn_global_load_lds((const unsigned*)((const char*)(gbase) + (voff)[_i]), (PG8_LAS unsigned*)(lds + (bufoff) + ldsw + _i * 8192), 16, 0, 0); } while (0)
#define PG8_LDA(dst, b, h) do { _Pragma("unroll") for (int m = 0; m < 4; ++m) _Pragma("unroll") for (int k = 0; k < 2; ++k) dst[m][k] = *(const PG8_LAS bf16x8*)(lds + PG8_SA(b, h) + aoff + m * 2048 + k * 1024); } while (0)
#define PG8_LDB(dst, b, h) do { _Pragma("unroll") for (int n = 0; n < 2; ++n) _Pragma("unroll") for (int k = 0; k < 2; ++k) dst[n][k] = *(const PG8_LAS bf16x8*)(lds + PG8_SB(b, h) + boff + n * 2048 + k * 1024); } while (0)
#define PG8_MMA(ai, bj, At, Bt) do { __builtin_amdgcn_s_setprio(1); _Pragma("unroll") for (int m = 0; m < 4; ++m) _Pragma("unroll") for (int n = 0; n < 2; ++n) _Pragma("unroll") for (int k = 0; k < 2; ++k) \
        acc[ai][bj][m][n] = __builtin_amdgcn_mfma_f32_16x16x32_bf16(Bt[n][k], At[m][k], acc[ai][bj][m][n], 0, 0, 0); __builtin_amdgcn_s_setprio(0); } while (0)
#define PG8_WAIT_V(n) asm volatile("s_waitcnt vmcnt(" #n ")" ::: "memory")
#define PG8_WAIT_L(n) asm volatile("s_waitcnt lgkmcnt(" #n ")" ::: "memory")
#define PG8_BAR __builtin_amdgcn_s_barrier()
#define PG8_SCHED __builtin_amdgcn_sched_barrier(0)
    Unit cur, nxt; int ui = 0;
    if (!S.next(0, cur)) return;
    f32x4 acc[2][2][4][2];
#pragma unroll
    for (int a = 0; a < 2; ++a)
#pragma unroll
        for (int b = 0; b < 2; ++b)
#pragma unroll
            for (int m = 0; m < 4; ++m)
#pragma unroll
                for (int n = 0; n < 2; ++n) acc[a][b][m][n] = (f32x4){0.f, 0.f, 0.f, 0.f};
    bf16x8 At[4][2], B0[2][2], B1[2][2];
    const char* cA = (const char*)((Epi::TWOSEG && cur.seg) ? g.A2 : g.A) + (size_t)cur.pm * tstep; const char* cB = (const char*)((Epi::TWOSEG && cur.seg) ? g.Bt2 : g.Bt) + (size_t)cur.pn * tstep;
    S.a_ready(cur);
    if constexpr (SP2) {
        PG8_STAGE(PG8_SB(0, 0), cB, voffB); PG8_STAGE(PG8_SB(0, 1), cB + hstep, voffB); PG8_STAGE(PG8_SA(0, 0), cA, voffA); PG8_STAGE(PG8_SA(0, 1), cA + hstep, voffA);
        if (wr == 1) PG8_BAR;
        PG8_WAIT_V(2); PG8_BAR;
        PG8_STAGE(PG8_SB(1, 0), cB + kstep, voffB); PG8_STAGE(PG8_SA(1, 0), cA + kstep, voffA); PG8_STAGE(PG8_SB(1, 1), cB + hstep + kstep, voffB);
        PG8_WAIT_V(6); PG8_BAR;
    } else {
        PG8_STAGE(PG8_SB(0, 0), cB, voffB); PG8_STAGE(PG8_SA(0, 0), cA, voffA); PG8_STAGE(PG8_SB(0, 1), cB + hstep, voffB); PG8_STAGE(PG8_SA(0, 1), cA + hstep, voffA);
        if (wr == 1) PG8_BAR;
        PG8_WAIT_V(4); PG8_BAR;
        PG8_STAGE(PG8_SB(1, 0), cB + kstep, voffB); PG8_STAGE(PG8_SA(1, 0), cA + kstep, voffA); PG8_STAGE(PG8_SB(1, 1), cB + hstep + kstep, voffB);
        PG8_WAIT_V(6); PG8_BAR;
    }
    for (;;) {
        const bool has_next = S.next(ui + 1, nxt);
        const char* nA = has_next ? (const char*)((Epi::TWOSEG && nxt.seg) ? g.A2 : g.A) + (size_t)nxt.pm * tstep : cA; const char* nB = has_next ? (const char*)((Epi::TWOSEG && nxt.seg) ? g.Bt2 : g.Bt) + (size_t)nxt.pn * tstep : cB;
        for (int t = 0; t < nt; t += 2) {
            const bool last = (t == nt - 2);
            if constexpr (Epi::MIDSCALE) { if (t == nt / 2) E.mid(acc, cur, wr, wc, fr, fq); }
            const char* a1 = cA + (size_t)(t + 1) * kstep;
            const char* a2 = last ? nA : cA + (size_t)(t + 2) * kstep; const char* b2 = last ? nB : cB + (size_t)(t + 2) * kstep;
            const char* a3 = a2 + kstep; const char* b3 = b2 + kstep;
            if (last && has_next) S.a_ready(nxt);
            if constexpr (SP2) {
            PG8_LDB(B0, 0, 0); PG8_LDB(B1, 0, 1); PG8_SCHED; PG8_LDA(At, 0, 0); PG8_STAGE(PG8_SA(1, 1), a1 + hstep, voffA);
            PG8_WAIT_V(8); PG8_WAIT_L(0); PG8_BAR; PG8_MMA(0, 0, At, B0); PG8_MMA(0, 1, At, B1); PG8_BAR; PG8_SCHED;
            PG8_LDA(At, 0, 1); PG8_STAGE(PG8_SB(0, 0), b2, voffB); PG8_STAGE(PG8_SB(0, 1), b2 + hstep, voffB); PG8_STAGE(PG8_SA(0, 0), a2, voffA);
            PG8_WAIT_V(8); PG8_WAIT_L(0); PG8_BAR; PG8_MMA(1, 0, At, B0); PG8_MMA(1, 1, At, B1); PG8_BAR; PG8_SCHED;
            PG8_LDB(B0, 1, 0); PG8_LDB(B1, 1, 1); PG8_SCHED; PG8_LDA(At, 1, 0); PG8_STAGE(PG8_SA(0, 1), a2 + hstep, voffA);
            PG8_WAIT_V(8); PG8_WAIT_L(0); PG8_BAR; PG8_MMA(0, 0, At, B0); PG8_MMA(0, 1, At, B1); PG8_BAR; PG8_SCHED;
            PG8_LDA(At, 1, 1); PG8_STAGE(PG8_SB(1, 0), b3, voffB); PG8_STAGE(PG8_SB(1, 1), b3 + hstep, voffB); PG8_STAGE(PG8_SA(1, 0), a3, voffA);
            PG8_WAIT_V(8); PG8_WAIT_L(0); PG8_BAR; PG8_MMA(1, 0, At, B0); PG8_MMA(1, 1, At, B1); PG8_BAR; PG8_SCHED;
            } else {
            PG8_LDB(B0, 0, 0); PG8_SCHED; PG8_LDA(At, 0, 0); PG8_STAGE(PG8_SA(1, 1), a1 + hstep, voffA);
            PG8_WAIT_L(8); PG8_BAR; PG8_WAIT_L(0); PG8_MMA(0, 0, At, B0); PG8_BAR; PG8_SCHED;
            PG8_LDB(B1, 0, 1); PG8_STAGE(PG8_SB(0, 0), b2, voffB);
            PG8_BAR; PG8_WAIT_L(0); PG8_MMA(0, 1, At, B1); PG8_BAR;
            PG8_LDA(At, 0, 1); PG8_STAGE(PG8_SA(0, 0), a2, voffA);
            PG8_BAR; PG8_WAIT_L(0); PG8_MMA(1, 0, At, B0); PG8_BAR; PG8_SCHED;
            PG8_STAGE(PG8_SB(0, 1), b2 + hstep, voffB);
            PG8_WAIT_V(6); PG8_BAR; PG8_MMA(1, 1, At, B1); PG8_BAR;
            PG8_LDB(B0, 1, 0); PG8_SCHED; PG8_LDA(At, 1, 0); PG8_STAGE(PG8_SA(0, 1), a2 + hstep, voffA);
            PG8_WAIT_L(8); PG8_BAR; PG8_WAIT_L(0); PG8_MMA(0, 0, At, B0); PG8_BAR; PG8_SCHED;
            PG8_LDB(B1, 1, 1); PG8_STAGE(PG8_SB(1, 0), b3, voffB);
            PG8_BAR; PG8_WAIT_L(0); PG8_MMA(0, 1, At, B1); PG8_BAR;
            PG8_LDA(At, 1, 1); PG8_STAGE(PG8_SA(1, 0), a3, voffA);
            PG8_BAR; PG8_WAIT_L(0); PG8_MMA(1, 0, At, B0); PG8_BAR; PG8_SCHED;
            PG8_STAGE(PG8_SB(1, 1), b3 + hstep, voffB);
            PG8_WAIT_V(6); PG8_BAR; PG8_MMA(1, 1, At, B1); PG8_BAR;
            }
        }
        if constexpr (ALIGN_EPI) { if (wr == 0) PG8_BAR; }
        bool keep_acc = false;
        if constexpr (Epi::TWOSEG) { if (cur.seg == 0) { E.mid(acc, cur, wr, wc, fr, fq); keep_acc = true; } else { E(acc, cur, wr, wc, fr, fq); } }
        else if constexpr (!Epi::AFTER_DRAIN) { E(acc, cur, wr, wc, fr, fq); S.done(cur); }
        if (!has_next) break;
        if (!keep_acc) {
#pragma unroll
        for (int a = 0; a < 2; ++a)
#pragma unroll
            for (int b = 0; b < 2; ++b)
#pragma unroll
                for (int m = 0; m < 4; ++m)
#pragma unroll
                    for (int n = 0; n < 2; ++n) acc[a][b][m][n] = (f32x4){0.f, 0.f, 0.f, 0.f};
        }
        cur = nxt; cA = nA; cB = nB; ++ui;
        if constexpr (ALIGN_EPI) { if (wr == 1) PG8_BAR; }
    }
    PG8_WAIT_V(0);
    if constexpr (!ALIGN_EPI) { if (wr == 0) PG8_BAR; }
    PG8_BAR;
    if constexpr (Epi::AFTER_DRAIN) { E.fused(acc, cur, wr, wc, fr, fq, lds, wid, lane); S.done(cur); }
#undef PG8_SA
#undef PG8_SB
#undef PG8_STAGE
#undef PG8_LDA
#undef PG8_LDB
#undef PG8_MMA
#undef PG8_WAIT_V
#undef PG8_WAIT_L
#undef PG8_BAR
#undef PG8_SCHED
}
}
using namespace pg8;
#define LAS __attribute__((address_space(3)))
typedef float f32x16 __attribute__((ext_vector_type(16)));
typedef unsigned u32x2 __attribute__((ext_vector_type(2)));

constexpr int D = 1024, MP = 16384, MS = 1024, M = MP + MS, FF = 2816, NIN = 1792, SEQ = 8192, MEMR = 512;
constexpr float EPS = 1e-6f, LOG2E = 1.4426950408889634f;
constexpr float C2S = 0.125f * LOG2E;
constexpr float C2X = 0.0625f * LOG2E;
constexpr size_t O_Y = 0, O_MK = (size_t)M * D, O_MV = O_MK + 524288, O_SKP = O_MV + 524288, O_SVP = O_SKP + 32768, O_CP = O_SVP + 32768,
                 O_HP = O_CP + 3072, O_SKS = O_HP + 1024, O_SVS = O_SKS + 2097152, O_CS = O_SVS + 2097152, O_HS = O_CS + 196608, O_END = O_HS + 65536;
constexpr size_t MiB = 1u << 20;
constexpr size_t WS_SS = 0, WS_ROPE = MiB / 2, WS_SUM = 3 * MiB, WS_WAB = 4 * MiB, WS_W1GU = 8 * MiB, WS_WCKV = 19 * MiB, WS_W1D = 23 * MiB, WS_WIN = 29 * MiB,
                 WS_WOUT = 33 * MiB, WS_WCQ = 35 * MiB, WS_WCO = 37 * MiB, WS_W2GU = 39 * MiB, WS_W2D = 50 * MiB, WS_XB = 56 * MiB, WS_H = 91 * MiB, WS_X = 185 * MiB,
                 WS_PROJ = 253 * MiB, WS_MIX = 313 * MiB, WS_QX = 347 * MiB, WS_XO = 381 * MiB, WS_END = 415 * MiB;
constexpr int ROPE_POS = 8200;
constexpr int RING_BYTES = 131072, MISC_OFF = RING_BYTES, LDS_BYTES = 147456;

__device__ __forceinline__ float bf2f(unsigned short b) { return __uint_as_float((unsigned)b << 16); }
__device__ __forceinline__ unsigned short f2bf(float f) { unsigned u = __float_as_uint(f); return (unsigned short)((u + 0x7fffu + ((u >> 16) & 1u)) >> 16); }
__device__ __forceinline__ unsigned pk2(float lo, float hi) { return (unsigned)f2bf(lo) | ((unsigned)f2bf(hi) << 16); }
__device__ __forceinline__ float rstd_of(float ss) { return rsqrtf(ss * (1.0f / 1024.0f) + EPS); }
__device__ __forceinline__ float fexp2(float x) { return __builtin_amdgcn_exp2f(x); }
__device__ __forceinline__ float sigmoidf_(float x) { return __builtin_amdgcn_rcpf(1.0f + fexp2(-x * LOG2E)); }
__device__ __forceinline__ float silu_mul(float g, float u) { return g * u * sigmoidf_(g); }
__device__ __forceinline__ float gelu_tanh(float x) { const float z = 0.7978845608028654f * (x + 0.044715f * x * x * x); return x * sigmoidf_(2.0f * z); }

__device__ __forceinline__ void st16(void* p, u32x4 v) { *(u32x4*)p = v; }
__device__ __forceinline__ void st8(void* p, u32x2 v) { *(u32x2*)p = v; }
struct EpiGU {
    static constexpr bool PERM = true, AFTER_DRAIN = false, MIDSCALE = false, TWOSEG = false;
    bf16_t* H; const float* ss;
    __device__ __forceinline__ void operator()(const f32x4 (&acc)[2][2][4][2], const Unit& u, int wr, int wc, int fr, int fq) const {
        const int row0 = u.pm * 256 + wr * 64 + fr, col0 = u.pn * 128 + wc * 32 + 8 * fq;
        float rsv[2][4];
#pragma unroll
        for (int ai = 0; ai < 2; ++ai)
#pragma unroll
            for (int m = 0; m < 4; ++m) rsv[ai][m] = ss[row0 + ai * 128 + m * 16];
#pragma unroll
        for (int ai = 0; ai < 2; ++ai)
#pragma unroll
            for (int m = 0; m < 4; ++m) {
                const int row = row0 + ai * 128 + m * 16; const float rs = rstd_of(rsv[ai][m]);
                const f32x4 g0 = acc[ai][0][m][0] * rs, g1 = acc[ai][0][m][1] * rs, u0 = acc[ai][1][m][0] * rs, u1 = acc[ai][1][m][1] * rs;
                u32x4 w;
                w.x = cvt_pk_bf16(silu_mul(g0[0], u0[0]), silu_mul(g0[1], u0[1])); w.y = cvt_pk_bf16(silu_mul(g0[2], u0[2]), silu_mul(g0[3], u0[3]));
                w.z = cvt_pk_bf16(silu_mul(g1[0], u1[0]), silu_mul(g1[1], u1[1])); w.w = cvt_pk_bf16(silu_mul(g1[2], u1[2]), silu_mul(g1[3], u1[3]));
                st16(H + (size_t)row * FF + col0, w);
            }
    }
};
template <bool ROWSCALE, bool F32BASE>
struct EpiRes {
    static constexpr bool PERM = true, AFTER_DRAIN = false, MIDSCALE = false, TWOSEG = false;
    const float* base_p; const float* base_s; bf16_t* XB; float* ss_out; float scale; const float* rowss;
    __device__ __forceinline__ void operator()(const f32x4 (&acc)[2][2][4][2], const Unit& u, int wr, int wc, int fr, int fq) const {
        const int row0 = u.pm * 256 + wr * 64 + fr, col0 = u.pn * 256 + wc * 32 + 8 * fq;
#pragma unroll
        for (int ai = 0; ai < 2; ++ai) {
            f32x4 bv[4][2][2]; float scv[4];
#pragma unroll
            for (int m = 0; m < 4; ++m) {
                const int row = row0 + ai * 128 + m * 16;
                scv[m] = ROWSCALE ? rowss[row] : 0.f;
                if (F32BASE) {
                    const float* b = row < MP ? base_p + (size_t)row * D : base_s + (size_t)(row - MP) * D;
#pragma unroll
                    for (int bj = 0; bj < 2; ++bj) { bv[m][bj][0] = *(const f32x4*)(b + col0 + bj * 128); bv[m][bj][1] = *(const f32x4*)(b + col0 + bj * 128 + 4); }
                } else {
#pragma unroll
                    for (int bj = 0; bj < 2; ++bj) {
                        const u32x4 w = *(const u32x4*)(XB + (size_t)row * D + col0 + bj * 128);
                        bv[m][bj][0] = (f32x4){__uint_as_float(w.x << 16), __uint_as_float(w.x & 0xffff0000u), __uint_as_float(w.y << 16), __uint_as_float(w.y & 0xffff0000u)};
                        bv[m][bj][1] = (f32x4){__uint_as_float(w.z << 16), __uint_as_float(w.z & 0xffff0000u), __uint_as_float(w.w << 16), __uint_as_float(w.w & 0xffff0000u)};
                    }
                }
            }
#pragma unroll
            for (int m = 0; m < 4; ++m) {
                const int row = row0 + ai * 128 + m * 16;
                const float sc = ROWSCALE ? rsqrtf(scv[m] * (1.0f / 512.0f) + EPS) : scale; float sq = 0.f;
#pragma unroll
                for (int bj = 0; bj < 2; ++bj) {
                    const int c = col0 + bj * 128;
                    const f32x4 v0 = bv[m][bj][0] + acc[ai][bj][m][0] * sc, v1 = bv[m][bj][1] + acc[ai][bj][m][1] * sc;
                    u32x4 w; w.x = cvt_pk_bf16(v0[0], v0[1]); w.y = cvt_pk_bf16(v0[2], v0[3]); w.z = cvt_pk_bf16(v1[0], v1[1]); w.w = cvt_pk_bf16(v1[2], v1[3]);
                    *(u32x4*)(XB + (size_t)row * D + c) = w;
                    sq += (v0[0] * v0[0] + v0[1] * v0[1]) + (v0[2] * v0[2] + v0[3] * v0[3]) + (v1[0] * v1[0] + v1[1] * v1[1]) + (v1[2] * v1[2] + v1[3] * v1[3]);
                }
                if (ss_out) { sq += __shfl_xor(sq, 16); sq += __shfl_xor(sq, 32); if (fq == 0) unsafeAtomicAdd(ss_out + row, sq); }
            }
        }
    }
};
struct EpiMix {
    static constexpr bool PERM = true, AFTER_DRAIN = false, MIDSCALE = false, TWOSEG = true;
    bf16_t* XB; float* ss_out; const float* ssl; const float* ssa;
    __device__ __forceinline__ void mid(f32x4 (&acc)[2][2][4][2], const Unit& u, int wr, int wc, int fr, int fq) const {
        const int row0 = u.pm * 256 + wr * 64 + fr;
        float sl[2][4], sa[2][4];
#pragma unroll
        for (int ai = 0; ai < 2; ++ai)
#pragma unroll
            for (int m = 0; m < 4; ++m) { sl[ai][m] = ssl[row0 + ai * 128 + m * 16]; sa[ai][m] = ssa[row0 + ai * 128 + m * 16]; }
#pragma unroll
        for (int ai = 0; ai < 2; ++ai)
#pragma unroll
            for (int m = 0; m < 4; ++m) {
                const float ratio = rsqrtf(sl[ai][m] * (1.0f / 512.0f) + EPS) * sqrtf(sa[ai][m] * (1.0f / 512.0f) + EPS);
#pragma unroll
                for (int bj = 0; bj < 2; ++bj)
#pragma unroll
                    for (int n = 0; n < 2; ++n) acc[ai][bj][m][n] = acc[ai][bj][m][n] * ratio;
            }
    }
    __device__ __forceinline__ void operator()(const f32x4 (&acc)[2][2][4][2], const Unit& u, int wr, int wc, int fr, int fq) const {
        const EpiRes<true, false> E{nullptr, nullptr, XB, ss_out, 1.0f, ssa};
        E(acc, u, wr, wc, fr, fq);
    }
};
struct StaticOrder2 {
    StaticOrder S;
    __host__ __device__ void init(int M, int N, int G_, int c_) { S.init(M, N, G_, c_); }
    __host__ __device__ bool next(int i, Unit& u) const { const bool ok = S.next(i >> 1, u); u.seg = i & 1; return ok; }
    __device__ __forceinline__ void a_ready(const Unit&) const {}
    __device__ __forceinline__ void done(const Unit&) const {}
};
struct EpiFinal {
    static constexpr bool PERM = true, AFTER_DRAIN = true, MIDSCALE = false, TWOSEG = false;
    const bf16_t* XB; float* ss; unsigned* cnt; const float* gfin; float* Y; float scale;
    __device__ __forceinline__ void fused(f32x4 (&acc)[2][2][4][2], const Unit& u, int wr, int wc, int fr, int fq, PG8_LAS unsigned char* lds, int wid, int lane) const {
        const int row0 = u.pm * 256 + wr * 64 + fr, col0 = u.pn * 256 + wc * 32 + 8 * fq;
#pragma unroll
        for (int ai = 0; ai < 2; ++ai) {
            u32x4 bw[4][2];
#pragma unroll
            for (int m = 0; m < 4; ++m)
#pragma unroll
                for (int bj = 0; bj < 2; ++bj) bw[m][bj] = __builtin_nontemporal_load((const u32x4*)(XB + (size_t)(row0 + ai * 128 + m * 16) * D + col0 + bj * 128));
#pragma unroll
            for (int m = 0; m < 4; ++m) {
                float sq = 0.f;
#pragma unroll
                for (int bj = 0; bj < 2; ++bj) {
                    const u32x4 w = bw[m][bj];
                    const f32x4 b0 = (f32x4){__uint_as_float(w.x << 16), __uint_as_float(w.x & 0xffff0000u), __uint_as_float(w.y << 16), __uint_as_float(w.y & 0xffff0000u)};
                    const f32x4 b1 = (f32x4){__uint_as_float(w.z << 16), __uint_as_float(w.z & 0xffff0000u), __uint_as_float(w.w << 16), __uint_as_float(w.w & 0xffff0000u)};
                    const f32x4 v0 = b0 + acc[ai][bj][m][0] * scale, v1 = b1 + acc[ai][bj][m][1] * scale;
                    acc[ai][bj][m][0] = v0; acc[ai][bj][m][1] = v1;
                    sq += (v0[0] * v0[0] + v0[1] * v0[1]) + (v0[2] * v0[2] + v0[3] * v0[3]) + (v1[0] * v1[0] + v1[1] * v1[1]) + (v1[2] * v1[2] + v1[3] * v1[3]);
                }
                sq += __shfl_xor(sq, 16); sq += __shfl_xor(sq, 32);
                if (fq == 0) unsafeAtomicAdd(ss + row0 + ai * 128 + m * 16, sq);
            }
        }
        asm volatile("s_waitcnt vmcnt(0)" ::: "memory");
        __syncthreads();
        if (threadIdx.x == 0) {
            unsigned* c = cnt + 64 * u.pm;
            __hip_atomic_fetch_add(c, 1u, __ATOMIC_RELAXED, __HIP_MEMORY_SCOPE_AGENT);
            unsigned sp = 0u;
            while (__hip_atomic_load(c, __ATOMIC_RELAXED, __HIP_MEMORY_SCOPE_AGENT) < 4u) { __builtin_amdgcn_s_sleep(2); if (++sp > (1u << 20)) break; }
        }
        __syncthreads();
        PG8_LAS float* S = (PG8_LAS float*)lds;
        if (threadIdx.x < 256) S[threadIdx.x] = rstd_of(unsafeAtomicAdd(ss + u.pm * 256 + (int)threadIdx.x, 0.0f));
        __syncthreads();
#pragma unroll
        for (int ai = 0; ai < 2; ++ai)
#pragma unroll
            for (int m = 0; m < 4; ++m) {
                const int rl = ai * 128 + wr * 64 + m * 16 + fr; const float rs = S[rl];
                float* yrow = Y + (size_t)(u.pm * 256 + rl) * D;
#pragma unroll
                for (int bj = 0; bj < 2; ++bj) {
                    const int c = col0 + bj * 128;
                    const f32x4 g0 = *(const f32x4*)(gfin + c), g1 = *(const f32x4*)(gfin + c + 4);
                    __builtin_nontemporal_store(acc[ai][bj][m][0] * rs * g0, (f32x4*)(yrow + c)); __builtin_nontemporal_store(acc[ai][bj][m][1] * rs * g1, (f32x4*)(yrow + c + 4));
                }
            }
        __syncthreads();
    }
};
struct EpiRowBf16 {
    static constexpr bool PERM = true, AFTER_DRAIN = false, MIDSCALE = false, TWOSEG = false;
    bf16_t* O; int ldc; const float* ss; float cst;
    __device__ __forceinline__ void operator()(const f32x4 (&acc)[2][2][4][2], const Unit& u, int wr, int wc, int fr, int fq) const {
        const int row0 = u.pm * 256 + wr * 64 + fr, col0 = u.pn * 256 + wc * 32 + 8 * fq;
        float rsv[2][4];
#pragma unroll
        for (int ai = 0; ai < 2; ++ai)
#pragma unroll
            for (int m = 0; m < 4; ++m) rsv[ai][m] = ss[row0 + ai * 128 + m * 16];
#pragma unroll
        for (int ai = 0; ai < 2; ++ai)
#pragma unroll
            for (int m = 0; m < 4; ++m) {
                const int row = row0 + ai * 128 + m * 16; const float rs = rstd_of(rsv[ai][m]) * cst;
#pragma unroll
                for (int bj = 0; bj < 2; ++bj) {
                    const f32x4 v0 = acc[ai][bj][m][0] * rs, v1 = acc[ai][bj][m][1] * rs;
                    u32x4 w; w.x = cvt_pk_bf16(v0[0], v0[1]); w.y = cvt_pk_bf16(v0[2], v0[3]); w.z = cvt_pk_bf16(v1[0], v1[1]); w.w = cvt_pk_bf16(v1[2], v1[3]);
                    st16(O + (size_t)row * ldc + col0 + bj * 128, w);
                }
            }
    }
};
struct EpiMemKV {
    static constexpr bool PERM = true, AFTER_DRAIN = false, MIDSCALE = false, TWOSEG = false;
    float* out;
    __device__ __forceinline__ void operator()(const f32x4 (&acc)[2][2][4][2], const Unit& u, int wr, int wc, int fr, int fq) const {
        const int row0 = u.pm * 256 + wr * 64 + fr, col0 = u.pn * 256 + wc * 32 + 8 * fq;
#pragma unroll
        for (int ai = 0; ai < 2; ++ai)
#pragma unroll
            for (int m = 0; m < 4; ++m) {
                const int row = row0 + ai * 128 + m * 16;
#pragma unroll
                for (int bj = 0; bj < 2; ++bj) {
                    const int c = col0 + bj * 128;
                    float* dst = out + (c < 1024 ? O_MK : O_MV) + (size_t)row * 1024 + (c & 1023);
                    *(f32x4*)dst = acc[ai][bj][m][0]; *(f32x4*)(dst + 4) = acc[ai][bj][m][1];
                }
            }
    }
};
struct EpiIn {
    static constexpr bool PERM = true, AFTER_DRAIN = false, MIDSCALE = false, TWOSEG = false;
    bf16_t* P; const float* ss; const float* rope; float* out;
    __device__ __forceinline__ void operator()(const f32x4 (&acc)[2][2][4][2], const Unit& u, int wr, int wc, int fr, int fq) const {
        const int row0 = u.pm * 256 + wr * 64 + fr; const int pn = u.pn;
        const int ip = (wc & 1) * 4 + fq, hl = wc >> 1;
        float rsv[2][4];
#pragma unroll
        for (int ai = 0; ai < 2; ++ai)
#pragma unroll
            for (int m = 0; m < 4; ++m) rsv[ai][m] = ss[row0 + ai * 128 + m * 16];
#pragma unroll
        for (int ai = 0; ai < 2; ++ai) {
            f32x4 csv[4][2];
            if (pn >= 4) {
#pragma unroll
                for (int m = 0; m < 4; ++m) {
                    const int row = row0 + ai * 128 + m * 16;
                    const bool smp = row >= MP; const int pos = smp ? SEQ + ((row - MP) & 7) : (row & (SEQ - 1));
                    const float* rp = rope + ((size_t)pos * 32 + 4 * ip) * 2; csv[m][0] = *(const f32x4*)rp; csv[m][1] = *(const f32x4*)(rp + 4);
                }
            }
#pragma unroll
            for (int m = 0; m < 4; ++m) {
                const int row = row0 + ai * 128 + m * 16; const float rs = rstd_of(rsv[ai][m]);
                const bool smp = row >= MP; const int t = smp ? ((row - MP) & 7) : (row & (SEQ - 1)); const int sq = smp ? ((row - MP) >> 3) : (row >> 13);
                bf16_t* prow = P + (size_t)row * NIN;
                if (pn < 4) {
#pragma unroll
                    for (int bj = 0; bj < 2; ++bj) {
                        const int c = pn * 256 + bj * 128 + wc * 32 + 8 * fq;
                        const f32x4 v0 = acc[ai][bj][m][0] * rs, v1 = acc[ai][bj][m][1] * rs;
                        u32x4 w; w.x = cvt_pk_bf16(v0[0], v0[1]); w.y = cvt_pk_bf16(v0[2], v0[3]); w.z = cvt_pk_bf16(v1[0], v1[1]); w.w = cvt_pk_bf16(v1[2], v1[3]);
                        st16(prow + c, w);
                        if (pn < 2) {
                            float* dst = nullptr;
                            if (!smp && t >= SEQ - 3) dst = out + O_CP + ((size_t)sq * 3 + (t - (SEQ - 3))) * 512 + c;
                            else if (smp && t >= 5) dst = out + O_CS + ((size_t)sq * 3 + (t - 5)) * 512 + c;
                            if (dst) { *(f32x4*)dst = v0; *(f32x4*)(dst + 4) = v1; }
                        }
                    }
                } else {
                    const f32x4 cs0 = csv[m][0], cs1 = csv[m][1];
#pragma unroll
                    for (int bj = 0; bj < 2; ++bj) {
                        const bool isv = (pn == 6 && bj == 1);
                        if (!isv) {
                            const f32x4 z1 = acc[ai][bj][m][0] * rs, z2 = acc[ai][bj][m][1] * rs;
                            f32x4 o1, o2;
                            o1[0] = z1[0] * cs0[0] - z2[0] * cs0[1]; o2[0] = z2[0] * cs0[0] + z1[0] * cs0[1];
                            o1[1] = z1[1] * cs0[2] - z2[1] * cs0[3]; o2[1] = z2[1] * cs0[2] + z1[1] * cs0[3];
                            o1[2] = z1[2] * cs1[0] - z2[2] * cs1[1]; o2[2] = z2[2] * cs1[0] + z1[2] * cs1[1];
                            o1[3] = z1[3] * cs1[2] - z2[3] * cs1[3]; o2[3] = z2[3] * cs1[2] + z1[3] * cs1[3];
                            if (pn < 6) {
                                const int head = (pn - 4) * 4 + bj * 2 + hl; o1 = o1 * C2S; o2 = o2 * C2S;
                                bf16_t* d = prow + 1024 + head * 64 + 4 * ip;
                                u32x2 a; a.x = cvt_pk_bf16(o1[0], o1[1]); a.y = cvt_pk_bf16(o1[2], o1[3]); st8(d, a);
                                u32x2 b; b.x = cvt_pk_bf16(o2[0], o2[1]); b.y = cvt_pk_bf16(o2[2], o2[3]); st8(d + 32, b);
                            } else {
                                const int head = hl;
                                bf16_t* d = prow + 1536 + head * 64 + 4 * ip;
                                u32x2 a; a.x = cvt_pk_bf16(o1[0], o1[1]); a.y = cvt_pk_bf16(o1[2], o1[3]); st8(d, a);
                                u32x2 b; b.x = cvt_pk_bf16(o2[0], o2[1]); b.y = cvt_pk_bf16(o2[2], o2[3]); st8(d + 32, b);
                                float* dst = nullptr;
                                if (!smp && t >= SEQ - 128) dst = out + O_SKP + ((size_t)sq * 128 + (t - (SEQ - 128))) * 128 + head * 64 + 4 * ip;
                                else if (smp) dst = out + O_SKS + ((size_t)sq * 128 + 120 + t) * 128 + head * 64 + 4 * ip;
                                if (dst) { *(f32x4*)dst = o1; *(f32x4*)(dst + 32) = o2; }
                            }
                        } else {
                            const int cv = wc * 32 + 8 * fq;
                            const f32x4 v0 = acc[ai][bj][m][0] * rs, v1 = acc[ai][bj][m][1] * rs;
                            u32x4 w; w.x = cvt_pk_bf16(v0[0], v0[1]); w.y = cvt_pk_bf16(v0[2], v0[3]); w.z = cvt_pk_bf16(v1[0], v1[1]); w.w = cvt_pk_bf16(v1[2], v1[3]);
                            st16(prow + 1664 + cv, w);
                            float* dst = nullptr;
                            if (!smp && t >= SEQ - 128) dst = out + O_SVP + ((size_t)sq * 128 + (t - (SEQ - 128))) * 128 + cv;
                            else if (smp) dst = out + O_SVS + ((size_t)sq * 128 + 120 + t) * 128 + cv;
                            if (dst) { *(f32x4*)dst = v0; *(f32x4*)(dst + 4) = v1; }
                        }
                    }
                }
            }
        }
    }
};

struct Args { const float* in[37]; float* out; unsigned char* ws; double inv_rev[32]; int use_cg; int pad; };
struct Ctx {
    LAS unsigned char* lds; int tid, lane, wave, G, bid;
    const float* const* in; float* out; unsigned char* ws;
    float* SS; float* ROPE; float* SUMA; float* SUMB; bf16_t* WAB; bf16_t* XB; bf16_t* H; float* X; bf16_t* PROJ; bf16_t* MIX; bf16_t* QX; bf16_t* XO;
};
__device__ __forceinline__ float wave_sum(float v) {
#pragma unroll
    for (int o = 1; o < 64; o <<= 1) v += __shfl_xor(v, o);
    return v;
}
__device__ __forceinline__ int dst_row_of(int mode, int row_off, int n) {
    if (mode == 0) return row_off + n;
    if (mode == 1) return (n >> 7) * 256 + row_off + (n & 127);
    if (n < 1024 || n >= 1664) return n;
    const int hb = (n - 1024) >> 6, dd = (n - 1024) & 63, nn = dd >> 5, rem = dd & 31, i = rem >> 2, e = rem & 3;
    return 1024 + hb * 64 + 8 * i + 4 * nn + e;
}
struct P0Item { const float* W; bf16_t* WT; const float* g0; int K, N, mode, row_off, r; };
__device__ __forceinline__ P0Item p0_item(Ctx& F, int it) {
    unsigned char* ws = F.ws;
    constexpr int I_GU = 16 * 88, I_DN = 44 * 32, I_IN = 16 * 56, I_SQ = 16 * 32;
    static_assert(I_GU == I_DN, "");
    int r = it; P0Item d;
    if (r < I_GU) { d = P0Item{F.in[10], (bf16_t*)(ws + WS_W1GU), F.in[9], D, FF, 1, 0, r}; return d; } r -= I_GU;
    if (r < I_GU) { d = P0Item{F.in[11], (bf16_t*)(ws + WS_W1GU), F.in[9], D, FF, 1, 128, r}; return d; } r -= I_GU;
    if (r < I_DN) { d = P0Item{F.in[12], (bf16_t*)(ws + WS_W1D), nullptr, FF, D, 0, 0, r}; return d; } r -= I_DN;
    if (r < I_GU) { d = P0Item{F.in[33], (bf16_t*)(ws + WS_W2GU), F.in[32], D, FF, 1, 0, r}; return d; } r -= I_GU;
    if (r < I_GU) { d = P0Item{F.in[34], (bf16_t*)(ws + WS_W2GU), F.in[32], D, FF, 1, 128, r}; return d; } r -= I_GU;
    if (r < I_DN) { d = P0Item{F.in[35], (bf16_t*)(ws + WS_W2D), nullptr, FF, D, 0, 0, r}; return d; } r -= I_DN;
    if (r < I_IN) { d = P0Item{F.in[14], (bf16_t*)(ws + WS_WIN), F.in[13], D, NIN, 2, 0, r}; return d; } r -= I_IN;
    if (r < I_SQ / 2) { d = P0Item{F.in[25], (bf16_t*)(ws + WS_WOUT), F.in[23], 512, D, 0, 0, r}; return d; } r -= I_SQ / 2;
    if (r < I_SQ / 2) { d = P0Item{F.in[25] + 512 * 1024, (bf16_t*)(ws + WS_WOUT + MiB), F.in[24], 512, D, 0, 0, r}; return d; } r -= I_SQ / 2;
    if (r < I_SQ) { d = P0Item{F.in[28], (bf16_t*)(ws + WS_WCQ), F.in[26], D, D, 0, 0, r}; return d; } r -= I_SQ;
    if (r < I_SQ) { d = P0Item{F.in[29], (bf16_t*)(ws + WS_WCKV), nullptr, D, D, 0, 0, r}; return d; } r -= I_SQ;
    if (r < I_SQ) { d = P0Item{F.in[30], (bf16_t*)(ws + WS_WCKV), nullptr, D, D, 0, 1024, r}; return d; } r -= I_SQ;
    d = P0Item{F.in[31], (bf16_t*)(ws + WS_WCO), nullptr, D, D, 0, 0, r}; return d;
}
__device__ __forceinline__ void p0_load_item(const P0Item& d, float (&v)[32], int lane) {
    const int nblk = d.N / 32, kb = d.r / nblk, nb = d.r % nblk, k0 = 64 * kb, n0 = 32 * nb;
#pragma unroll
    for (int i = 0; i < 32; ++i) { const int k = k0 + 2 * i + (lane >> 5); v[i] = __builtin_nontemporal_load(d.W + (size_t)k * d.N + n0 + (lane & 31)) * (d.g0 ? d.g0[k] : 1.0f); }
}
__device__ __forceinline__ void p0_store_item(const P0Item& d, const float (&v)[32], LAS float* scr, int lane) {
    const int nblk = d.N / 32, kb = d.r / nblk, nb = d.r % nblk, k0 = 64 * kb, n0 = 32 * nb;
#pragma unroll
    for (int i = 0; i < 32; ++i) scr[(2 * i + (lane >> 5)) * 33 + (lane & 31)] = v[i];
    asm volatile("s_waitcnt lgkmcnt(0)" ::: "memory");
    const int c = lane & 7;
#pragma unroll
    for (int j = 0; j < 4; ++j) {
        const int n = (lane >> 3) + 8 * j; const LAS float* s = scr + (8 * c) * 33 + n;
        u32x4 o; o.x = cvt_pk_bf16(s[0 * 33], s[1 * 33]); o.y = cvt_pk_bf16(s[2 * 33], s[3 * 33]); o.z = cvt_pk_bf16(s[4 * 33], s[5 * 33]); o.w = cvt_pk_bf16(s[6 * 33], s[7 * 33]);
        *(u32x4*)(d.WT + (size_t)dst_row_of(d.mode, d.row_off, n0 + n) * d.K + k0 + 8 * c) = o;
    }
    asm volatile("s_waitcnt lgkmcnt(0)" ::: "memory");
}
__device__ __forceinline__ void p0_prologue(Ctx& F, const double* inv_rev) {
    LAS float* scr = (LAS float*)(F.lds + F.wave * 16384);
    const int gw = F.bid * 8 + F.wave, NGW = F.G * 8;
    constexpr int NITEMS = 6 * 1408 + 896 + 5 * 512;
#ifndef DUP_P0A
#define DUP_P0A 0
#endif
#ifndef DUP_P0B
#define DUP_P0B 0
#endif
#ifndef DUP_P0C
#define DUP_P0C 0
#endif
    for (int rp_ = 0; rp_ <= DUP_P0A; ++rp_) {
        float cur[32]; int it = gw;
        if (it < NITEMS) { const P0Item d = p0_item(F, it); p0_load_item(d, cur, F.lane); }
        for (; it < NITEMS; it += NGW) {
            float nxt[32]; const bool more = it + NGW < NITEMS;
            if (more) { const P0Item dn = p0_item(F, it + NGW); p0_load_item(dn, nxt, F.lane); }
            const P0Item d = p0_item(F, it);
            p0_store_item(d, cur, scr, F.lane);
            if (more) {
#pragma unroll
                for (int i = 0; i < 32; ++i) cur[i] = nxt[i];
            }
        }
    }
    for (int rp_ = 0; rp_ <= DUP_P0B; ++rp_)
    for (int mb = gw; mb < M + MEMR; mb += 4 * NGW) {
        f32x4 v[4][4]; float s[4];
#pragma unroll
        for (int r = 0; r < 4; ++r) {
            const int m = mb + r * NGW; s[r] = 0.f;
            if (m < M + MEMR) {
                const float* src = m < MP ? F.in[0] + (size_t)m * D : (m < M ? F.in[1] + (size_t)(m - MP) * D : F.in[2] + (size_t)(m - M) * D);
                const f32x4* xr = (const f32x4*)src + F.lane;
#pragma unroll
                for (int j = 0; j < 4; ++j) v[r][j] = __builtin_nontemporal_load(xr + 64 * j);
            }
        }
#pragma unroll
        for (int r = 0; r < 4; ++r) {
            const int m = mb + r * NGW;
            if (m < M + MEMR) {
#pragma unroll
                for (int j = 0; j < 4; ++j) s[r] += (v[r][j][0] * v[r][j][0] + v[r][j][1] * v[r][j][1]) + (v[r][j][2] * v[r][j][2] + v[r][j][3] * v[r][j][3]);
                s[r] = wave_sum(s[r]);
                if (m < M) { if (F.lane == 0) F.SS[m] = s[r]; }
                else { const float rs = rstd_of(s[r]); const f32x4* gr = (const f32x4*)F.in[27] + F.lane;
#pragma unroll
                    for (int j = 0; j < 4; ++j) v[r][j] = v[r][j] * rs * gr[64 * j]; }
                u32x2* o8 = (u32x2*)(F.XB + (size_t)m * D) + F.lane;
#pragma unroll
                for (int j = 0; j < 4; ++j) { u32x2 w; w.x = pk2(v[r][j][0], v[r][j][1]); w.y = pk2(v[r][j][2], v[r][j][3]); o8[64 * j] = w; }
            }
        }
    }
    const int gt = F.bid * 512 + F.tid, NGT = F.G * 512;
    for (int rp_ = 0; rp_ <= DUP_P0C; ++rp_) {
    for (int i = gt; i < 6 * M; i += NGT) F.SS[M + i] = 0.f;
    for (int i = gt; i < ROPE_POS * 32; i += NGT) {
        const int pos = i >> 5, fi = i & 31; const double rev = (double)pos * inv_rev[fi]; const float fr = (float)(rev - floor(rev));
        F.ROPE[2 * i] = __builtin_amdgcn_cosf(fr); F.ROPE[2 * i + 1] = __builtin_amdgcn_sinf(fr);
    }
    {
        f32x4 ck[4], cv[4];
#pragma unroll
        for (int u = 0; u < 4; ++u) { const int i = gt + u * NGT; if (i < 128 * 3840) { const int n = i / 3840, r = i % 3840;
            ck[u] = __builtin_nontemporal_load((const f32x4*)(F.in[5] + (size_t)n * 16384 + 1024) + r); cv[u] = __builtin_nontemporal_load((const f32x4*)(F.in[6] + (size_t)n * 16384 + 1024) + r); } }
#pragma unroll
        for (int u = 0; u < 4; ++u) { const int i = gt + u * NGT; if (i < 128 * 3840) { const int n = i / 3840, r = i % 3840;
            __builtin_nontemporal_store(ck[u], (f32x4*)(F.out + O_SKS + (size_t)n * 16384) + r); __builtin_nontemporal_store(cv[u], (f32x4*)(F.out + O_SVS + (size_t)n * 16384) + r); } }
    }
    for (int i = gt; i < 2 * 8 * 64 * 64; i += NGT) {
        const int k = i & 63, n = (i >> 6) & 63, g = (i >> 12) & 7, mat = i >> 15;
        F.WAB[i] = f2bf((mat ? F.in[19] : F.in[17])[((size_t)g * 64 + k) * 64 + n]);
    }
    }
}
#define XB_TMO      128
#define XB_XCNT(j)  (256  + 64 * (j))
#define XB_XSUB(j)  (1280 + 64 * (j))
#define XB_XGEN(j)  (2304 + 64 * (j))
#define XB_TOP      3328
#define XB_TOPGEN   3392
#define XCD_BAR_WORDS 3456
#define XB_SPIN_CAP (1u << 18)

__device__ __forceinline__ unsigned xb_ld(unsigned* p)              { return __hip_atomic_load(p, __ATOMIC_RELAXED, __HIP_MEMORY_SCOPE_AGENT); }
__device__ __forceinline__ unsigned xb_add(unsigned* p, unsigned v) { return __hip_atomic_fetch_add(p, v, __ATOMIC_RELAXED, __HIP_MEMORY_SCOPE_AGENT); }
__device__ __forceinline__ unsigned xb_xcc_id() { return (unsigned)__builtin_amdgcn_s_getreg((3 << 11) | 20) & 0xFu; }
#define XB_SPIN(cond, bar) do { unsigned _sp = 0; while (cond) { __builtin_amdgcn_s_sleep(1); \
    if ((++_sp & 255u) == 0u) { if (xb_ld(&(bar)[XB_TMO])) break; if (_sp > XB_SPIN_CAP) { atomicAdd(&(bar)[XB_TMO], 1u); break; } } } } while (0)

struct XcdBarrier {
    unsigned* bar; unsigned x;
    volatile LAS unsigned* st;
};

__device__ __forceinline__ XcdBarrier xcd_barrier_post(unsigned* bar, volatile LAS unsigned* st) {
    XcdBarrier b; b.bar = bar; b.x = xb_xcc_id(); b.st = st;
    if (threadIdx.x == 0) (void)xb_add(&bar[XB_XCNT(b.x)], 1u);
    return b;
}
__device__ __forceinline__ void xcd_barrier_complete(unsigned* bar, unsigned x, unsigned& nloc, unsigned& nx) {
    const unsigned G = gridDim.x * gridDim.y * gridDim.z;
    unsigned sum, cnt, mine, sp = 0u;
    for (;;) {
        sum = 0u; cnt = 0u; mine = 0u;
#pragma unroll
        for (unsigned j = 0; j < 16; ++j) { const unsigned c = xb_ld(&bar[XB_XCNT(j)]); sum += c; cnt += (c > 0u) ? 1u : 0u; mine = (j == x) ? c : mine; }
        if (sum == G) break;
        __builtin_amdgcn_s_sleep(1);
        if ((++sp & 255u) == 0u) { if (xb_ld(&bar[XB_TMO])) break; if (sp > XB_SPIN_CAP) { atomicAdd(&bar[XB_TMO], 1u); break; } }
    }
    nloc = mine > 0u ? mine : 1u; nx = cnt > 0u ? cnt : 1u;
}

__device__ __forceinline__ void xcd_barrier(const XcdBarrier& b) {
    asm volatile("s_waitcnt vmcnt(0)" ::: "memory");
    __syncthreads();
    if (threadIdx.x == 0) {
        unsigned* bar = b.bar;
        __builtin_amdgcn_s_waitcnt(0);
        unsigned nloc = b.st[0], nx = b.st[1];
        if (nloc == 0u) { xcd_barrier_complete(bar, b.x, nloc, nx); b.st[0] = nloc; b.st[1] = nx; }
        const unsigned old = xb_add(&bar[XB_XSUB(b.x)], 1u);
        const unsigned gen = old / nloc;
        if (old + 1u == (gen + 1u) * nloc) {
            __builtin_amdgcn_fence(__ATOMIC_RELEASE, "agent");
            asm volatile("s_waitcnt vmcnt(0)" ::: "memory");
            const unsigned og = xb_add(&bar[XB_TOP], 1u);
            const unsigned tg = og / nx;
            if (og + 1u == (tg + 1u) * nx) xb_add(&bar[XB_TOPGEN], 1u);
            else XB_SPIN(xb_ld(&bar[XB_TOPGEN]) == tg, bar);
            __builtin_amdgcn_fence(__ATOMIC_ACQUIRE, "agent");
            xb_add(&bar[XB_XGEN(b.x)], 1u);
            asm volatile("s_waitcnt vmcnt(0)" ::: "memory");
        } else {
            XB_SPIN(xb_ld(&bar[XB_XGEN(b.x)]) == gen, bar);
            __builtin_amdgcn_fence(__ATOMIC_ACQUIRE, "agent");
            asm volatile("s_waitcnt vmcnt(0)" ::: "memory");
        }
    }
    __syncthreads();
}

template <bool SAMPLE, int PASS, int NH>
__device__ __forceinline__ void lru_tile(Ctx& F, int m0, int bn  , int k  , float* ssl) {
    const int g = F.wave, lane = F.lane, c = g * 64 + lane;
    LAS unsigned char* ldsw = F.lds + g * 16384;
    const float* conv_w = F.in[15]; const float cw0 = conv_w[c], cw1 = conv_w[512 + c], cw2 = conv_w[1024 + c], cw3 = conv_w[1536 + c], cb = F.in[16][c];
    const float ba = F.in[18][c], bi = F.in[20][c], lamv = F.in[21][c];
    const float sp8 = 8.0f * (fmaxf(-lamv, 0.f) + log1pf(__expf(-fabsf(lamv))));
    const bf16_t* Pu = F.PROJ + (size_t)m0 * NIN + c;
    const float* scv = F.in[7] + (size_t)bn * 1536 + c;
    float x0 = 0.f, x1 = 0.f, x2 = 0.f;
    if (!SAMPLE && k > 0) { x0 = bf2f(Pu[-3 * NIN]); x1 = bf2f(Pu[-2 * NIN]); x2 = bf2f(Pu[-NIN]); }
    float h = 0.f, Ap = 1.f;
    if (!SAMPLE && PASS == 2 && k > 0) {
        const float* sa = F.SUMA + (size_t)bn * 128 * 512 + c; const float* sb = F.SUMB + (size_t)bn * 128 * 512 + c;
        const int kq = (k + 3) >> 2;
        float qa[4] = {1.f, 1.f, 1.f, 1.f}, qb[4] = {0.f, 0.f, 0.f, 0.f};
#pragma unroll 4
        for (int j = 0; j < kq; ++j) {
#pragma unroll
            for (int q = 0; q < 4; ++q) { const int jj = q * kq + j; if (jj < k) { const float a = sa[(size_t)jj * 512], b = sb[(size_t)jj * 512]; qa[q] *= a; qb[q] = a * qb[q] + b; } }
        }
#pragma unroll
        for (int q = 0; q < 4; ++q) h = qa[q] * h + qb[q];
    }
    LAS float* pre_r = (LAS float*)ldsw; LAS float* pre_i = pre_r + 2048;
#pragma unroll 1
    for (int half = 0; half < NH; ++half) {
        unsigned short uu[32], gg[32]; float st[4][3], hs[4];
        {
            const bf16_t* rp = F.PROJ + ((size_t)(m0 + 32 * half) * NIN + g * 64) + (size_t)(lane >> 3) * NIN + (lane & 7) * 8;
            u32x4 wu[4], wg[4];
#pragma unroll
            for (int i = 0; i < 4; ++i) { wu[i] = (PASS == 2) ? __builtin_nontemporal_load((const u32x4*)(rp + (size_t)(8 * i) * NIN)) : *(const u32x4*)(rp + (size_t)(8 * i) * NIN); if (PASS == 2) wg[i] = __builtin_nontemporal_load((const u32x4*)(rp + (size_t)(8 * i) * NIN + 512)); }
            LAS bf16_t* ut = (LAS bf16_t*)ldsw; LAS bf16_t* gt = ut + 2048;
#pragma unroll
            for (int i = 0; i < 4; ++i) { *(LAS u32x4*)(ut + ((lane >> 3) + 8 * i) * 64 + (lane & 7) * 8) = wu[i]; if (PASS == 2) *(LAS u32x4*)(gt + ((lane >> 3) + 8 * i) * 64 + (lane & 7) * 8) = wg[i]; }
            asm volatile("s_waitcnt lgkmcnt(0)" ::: "memory");
#pragma unroll
            for (int j = 0; j < 32; ++j) { uu[j] = ut[j * 64 + lane]; gg[j] = (PASS == 2) ? gt[j * 64 + lane] : (unsigned short)0; }
            asm volatile("s_waitcnt lgkmcnt(0)" ::: "memory");
        }
        if (SAMPLE) {
#pragma unroll
            for (int sq = 0; sq < 4; ++sq) { const float* sc = scv + (size_t)(4 * half + sq) * 1536; st[sq][0] = sc[0]; st[sq][1] = sc[512]; st[sq][2] = sc[1024]; hs[sq] = F.in[8][(size_t)(bn + 4 * half + sq) * 512 + c]; }
        }
        {
            LAS bf16_t* convb = (LAS bf16_t*)(ldsw + 8192); float xa = x0, xb = x1, xc = x2;
#pragma unroll
            for (int j = 0; j < 32; ++j) {
                if (SAMPLE && (j & 7) == 0) { xa = st[j >> 3][0]; xb = st[j >> 3][1]; xc = st[j >> 3][2]; }
                const float xi = bf2f(uu[j]);
                const float cv = (((cb + cw0 * xa) + cw1 * xb) + cw2 * xc) + cw3 * xi; xa = xb; xb = xc; xc = xi;
                convb[j * 72 + lane] = (unsigned short)cvt_pk_bf16(cv, cv);
            }
        }
        asm volatile("s_waitcnt lgkmcnt(0)" ::: "memory");
        bf16x8 Af[2][2];
        {
            const LAS bf16_t* convb = (const LAS bf16_t*)(ldsw + 8192);
#pragma unroll
            for (int tt = 0; tt < 2; ++tt)
#pragma unroll
                for (int ks = 0; ks < 2; ++ks) Af[tt][ks] = *(const LAS bf16x8*)(convb + (16 * tt + (lane & 15)) * 72 + 32 * ks + 8 * (lane >> 4));
        }
        asm volatile("s_waitcnt lgkmcnt(0)" ::: "memory");
#pragma unroll
        for (int nt = 0; nt < 4; ++nt) {
            const bf16_t* wa = F.WAB + ((size_t)g * 64 + 16 * nt + (lane & 15)) * 64 + 8 * (lane >> 4); const bf16_t* wi = wa + 8 * 64 * 64;
            const bf16x8 Ba0 = *(const bf16x8*)wa, Ba1 = *(const bf16x8*)(wa + 32), Bi0 = *(const bf16x8*)wi, Bi1 = *(const bf16x8*)(wi + 32);
#pragma unroll
            for (int tt2 = 0; tt2 < 2; ++tt2) {
                f32x4 ar = (f32x4){0.f, 0.f, 0.f, 0.f}, ai = ar;
                ar = __builtin_amdgcn_mfma_f32_16x16x32_bf16(Af[tt2][0], Ba0, ar, 0, 0, 0); ar = __builtin_amdgcn_mfma_f32_16x16x32_bf16(Af[tt2][1], Ba1, ar, 0, 0, 0);
                ai = __builtin_amdgcn_mfma_f32_16x16x32_bf16(Af[tt2][0], Bi0, ai, 0, 0, 0); ai = __builtin_amdgcn_mfma_f32_16x16x32_bf16(Af[tt2][1], Bi1, ai, 0, 0, 0);
                const int nn = (16 * nt + (lane & 15)) ^ (((lane >> 4) & 1) << 4);
#pragma unroll
                for (int j = 0; j < 4; ++j) { const int il = 16 * tt2 + 4 * (lane >> 4) + j; pre_r[il * 64 + nn] = ar[j]; pre_i[il * 64 + nn] = ai[j]; }
            }
        }
        asm volatile("s_waitcnt lgkmcnt(0)" ::: "memory");
#pragma unroll
        for (int il = 0; il < 32; il += 2) {
            typedef float v2f __attribute__((ext_vector_type(2)));
            const int i = 32 * half + il; const int nn = lane ^ (((il >> 2) & 1) << 4);
            if (SAMPLE && (il & 7) == 0) { x0 = st[il >> 3][0]; x1 = st[il >> 3][1]; x2 = st[il >> 3][2]; h = hs[il >> 3]; }
            const float xa = bf2f(uu[il]), xb = bf2f(uu[il + 1]);
            v2f cv = (v2f){cb, cb} + (v2f){x0, x1} * cw0; cv = cv + (v2f){x1, x2} * cw1; cv = cv + (v2f){x2, xa} * cw2; cv = cv + (v2f){xa, xb} * cw3;
            x0 = x2; x1 = xa; x2 = xb;
            const v2f tr = ((v2f){pre_r[il * 64 + nn], pre_r[(il + 1) * 64 + nn]} + ba) * (-LOG2E), ti = ((v2f){pre_i[il * 64 + nn], pre_i[(il + 1) * 64 + nn]} + bi) * (-LOG2E);
            const v2f r = (v2f){__builtin_amdgcn_rcpf(1.0f + fexp2(tr.x)), __builtin_amdgcn_rcpf(1.0f + fexp2(tr.y))};
            const v2f gi = (v2f){__builtin_amdgcn_rcpf(1.0f + fexp2(ti.x)), __builtin_amdgcn_rcpf(1.0f + fexp2(ti.y))};
            const v2f la = r * (-sp8), al = la * LOG2E, xx = la * 2.0f;
            const v2f a = (v2f){fexp2(al.x), fexp2(al.y)};
            const v2f ser = -xx * (1.0f + xx * 0.5f * (1.0f + xx * (1.0f / 3.0f) * (1.0f + xx * 0.25f * (1.0f + xx * 0.2f * (1.0f + xx * (1.0f / 6.0f))))));
            const v2f alt = 1.0f - a * a;
            const float om0 = xx.x > -0.25f ? ser.x : alt.x, om1 = xx.y > -0.25f ? ser.y : alt.y;
            const v2f sq = (v2f){__builtin_amdgcn_sqrtf(fmaxf(om0, 0.f)), __builtin_amdgcn_sqrtf(fmaxf(om1, 0.f))};
            const v2f bb = sq * (gi * cv);
            const float h0 = a.x * h + bb.x, h1 = a.y * h0 + bb.y; h = h1;
            if (PASS == 1) Ap *= a.x * a.y;
            if (PASS == 2) {
                const v2f g2 = (v2f){bf2f(gg[il]), bf2f(gg[il + 1])};
                const v2f z = (g2 + g2 * g2 * g2 * 0.044715f) * (-2.0f * 0.7978845608028654f * LOG2E);
                const v2f sg = (v2f){__builtin_amdgcn_rcpf(1.0f + fexp2(z.x)), __builtin_amdgcn_rcpf(1.0f + fexp2(z.y))};
                const v2f yv = (v2f){h0, h1} * g2 * sg;
                const unsigned yp = cvt_pk_bf16(yv.x, yv.y);
                ((LAS unsigned*)pre_i)[il * 64 + nn] = yp & 0xffffu; ((LAS unsigned*)pre_i)[(il + 1) * 64 + nn] = yp >> 16;
                const float y0 = __uint_as_float(yp << 16), y1 = __uint_as_float(yp & 0xffff0000u);
                pre_r[il * 64 + nn] = y0 * y0; pre_r[(il + 1) * 64 + nn] = y1 * y1;
                if (SAMPLE && (il & 7) == 6) F.out[O_HS + (size_t)(bn + (i >> 3)) * 512 + c] = h1;
            }
            if ((il & 7) == 6) __builtin_amdgcn_sched_barrier(0);
        }
        asm volatile("s_waitcnt lgkmcnt(0)" ::: "memory");
        if (PASS == 2) {
            if (lane < 32) {
                float s = 0.f;
#pragma unroll 8
                for (int j = 0; j < 64; ++j) s += pre_r[lane * 64 + ((j + lane) & 63)];
                unsafeAtomicAdd(ssl + m0 + 32 * half + lane, s);
            }
            {
                const LAS unsigned* yw = (const LAS unsigned*)pre_i;
#pragma unroll
                for (int i = 0; i < 4; ++i) {
                    const int row = (lane >> 3) + 8 * i, ch8 = ((lane & 7) * 8) ^ (((row >> 2) & 1) << 4);
                    const u32x4 lo = *(const LAS u32x4*)(yw + row * 64 + ch8), hi4 = *(const LAS u32x4*)(yw + row * 64 + ch8 + 4);
                    u32x4 w; w.x = (lo.x & 0xffffu) | (lo.y << 16); w.y = (lo.z & 0xffffu) | (lo.w << 16); w.z = (hi4.x & 0xffffu) | (hi4.y << 16); w.w = (hi4.z & 0xffffu) | (hi4.w << 16);
                    st16(F.MIX + (size_t)(m0 + 32 * half + row) * 512 + g * 64 + (lane & 7) * 8, w);
                }
            }
            asm volatile("s_waitcnt lgkmcnt(0)" ::: "memory");
        }
    }
    if (PASS == 1) {
        __hip_atomic_store((unsigned*)(F.SUMA + ((size_t)bn * 128 + k) * 512 + c), __float_as_uint(Ap), __ATOMIC_RELAXED, __HIP_MEMORY_SCOPE_AGENT);
        __hip_atomic_store((unsigned*)(F.SUMB + ((size_t)bn * 128 + k) * 512 + c), __float_as_uint(h), __ATOMIC_RELAXED, __HIP_MEMORY_SCOPE_AGENT);
    }
    if (PASS == 2) { if (!SAMPLE && k == 127) F.out[O_HP + (size_t)bn * 512 + c] = h; }
}

constexpr int SWA_KS = 136, SWA_VS = 204, SWA_VOFF = 192 * SWA_KS * 2;
__device__ __forceinline__ int crow(int r, int hi) { return (r & 3) + 8 * (r >> 2) + 4 * hi; }
__device__ __forceinline__ unsigned short bf_at(const u32x4& v, int e) { return (unsigned short)(v[e >> 1] >> ((e & 1) * 16)); }
template <bool SAMPLE>
__device__ __forceinline__ void swa_qtile(Ctx& F, const bf16_t* qrow  , int kb, int tb  , int h, float sk, bf16_t* orow, float* ssrow) {
    const int lane = F.lane, q = lane & 31, hi = lane >> 5, kvh = h >> 2;
    const LAS bf16_t* Kl = (const LAS bf16_t*)F.lds; const LAS bf16_t* Vt = (const LAS bf16_t*)(F.lds + SWA_VOFF);
    bf16x8 qf[4];
#pragma unroll
    for (int ks = 0; ks < 4; ++ks) qf[ks] = *(const bf16x8*)(qrow + 16 * ks + 8 * hi);
    f32x16 s[5];
#pragma unroll
    for (int kt = 0; kt < 5; ++kt) {
        s[kt] = (f32x16){0.f, 0.f, 0.f, 0.f, 0.f, 0.f, 0.f, 0.f, 0.f, 0.f, 0.f, 0.f, 0.f, 0.f, 0.f, 0.f};
#pragma unroll
        for (int ks = 0; ks < 4; ++ks) {
            const bf16x8 a = *(const LAS bf16x8*)(Kl + (kb + 32 * kt + q) * SWA_KS + kvh * 64 + 16 * ks + 8 * hi);
            s[kt] = __builtin_amdgcn_mfma_f32_32x32x16_bf16(a, qf[ks], s[kt], 0, 0, 0);
        }
    }
    float mx = sk;
#pragma unroll
    for (int kt = 0; kt < 5; ++kt)
#pragma unroll
        for (int r = 0; r < 16; ++r) {
            const int kk = 32 * kt + crow(r, hi); bool valid;
            if (SAMPLE) valid = (kk < 128) ? (kk >= q + 1) : (kk - 128 <= q && kk < 136);
            else valid = (kk >= q + 1) && (kk <= q + 128) && (tb + kk >= 0);
            const float sv = valid ? s[kt][r] : -INFINITY; s[kt][r] = sv; mx = fmaxf(mx, sv);
        }
    mx = fmaxf(mx, __shfl_xor(mx, 32));
    float l = 0.f; bf16x8 pb[10];
#pragma unroll
    for (int kt = 0; kt < 5; ++kt) {
        float p[16];
#pragma unroll
        for (int r = 0; r < 16; ++r) { p[r] = fexp2(s[kt][r] - mx); l += p[r]; }
#pragma unroll
        for (int hf = 0; hf < 2; ++hf) {
            u32x4 w; w.x = cvt_pk_bf16(p[8 * hf + 0], p[8 * hf + 1]); w.y = cvt_pk_bf16(p[8 * hf + 2], p[8 * hf + 3]); w.z = cvt_pk_bf16(p[8 * hf + 4], p[8 * hf + 5]); w.w = cvt_pk_bf16(p[8 * hf + 6], p[8 * hf + 7]);
            pb[2 * kt + hf] = __builtin_bit_cast(bf16x8, w);
        }
    }
    l += __shfl_xor(l, 32); l += fexp2(sk - mx);
    const float inv = 1.0f / l; float sq = 0.f;
    const bool wr_ok = !SAMPLE || q < 8;
#pragma unroll
    for (int dt = 0; dt < 2; ++dt) {
        f32x16 o = (f32x16){0.f, 0.f, 0.f, 0.f, 0.f, 0.f, 0.f, 0.f, 0.f, 0.f, 0.f, 0.f, 0.f, 0.f, 0.f, 0.f};
#pragma unroll
        for (int u = 0; u < 10; ++u) {
            const LAS bf16_t* vp = Vt + (kvh * 64 + 32 * dt + q) * SWA_VS + kb + 16 * u + 4 * hi;
            const u32x2 lo = *(const LAS u32x2*)vp, hi4 = *(const LAS u32x2*)(vp + 8);
            u32x4 w; w.x = lo.x; w.y = lo.y; w.z = hi4.x; w.w = hi4.y;
            o = __builtin_amdgcn_mfma_f32_32x32x16_bf16(__builtin_bit_cast(bf16x8, w), pb[u], o, 0, 0, 0);
        }
#pragma unroll
        for (int r = 0; r < 16; ++r) { o[r] *= inv; sq += o[r] * o[r]; }
        if (wr_ok) {
#pragma unroll
            for (int rg = 0; rg < 4; ++rg) {
                u32x2 w; w.x = cvt_pk_bf16(o[4 * rg], o[4 * rg + 1]); w.y = cvt_pk_bf16(o[4 * rg + 2], o[4 * rg + 3]);
                st8(orow + 32 * dt + 8 * rg + 4 * hi, w);
            }
        }
    }
    sq += __shfl_xor(sq, 32);
    if (wr_ok && hi == 0) unsafeAtomicAdd(ssrow, sq);
}
__device__ __forceinline__ void swa_prompt_item(Ctx& F, int b, int qb, float* ssa) {
    const int tid = F.tid, lane = F.lane, h = F.wave, q = lane & 31;
    LAS bf16_t* Kl = (LAS bf16_t*)F.lds; LAS bf16_t* Vt = (LAS bf16_t*)(F.lds + SWA_VOFF);
    const int tb = 64 * qb - 128; const size_t rowbase = (size_t)b * SEQ;
    const u32x4 z4 = (u32x4){0u, 0u, 0u, 0u};
#pragma unroll
    for (int i = 0; i < 6; ++i) { const int p = tid + 512 * i, key = p >> 4, ch = p & 15, tok = tb + key;
        const u32x4 v = tok >= 0 ? *(const u32x4*)(F.PROJ + (rowbase + tok) * NIN + 1536 + ch * 8) : z4;
        *(LAS u32x4*)(Kl + key * SWA_KS + ch * 8) = v; }
#pragma unroll
    for (int i = 0; i < 3; ++i) { const int p = tid + 512 * i, ch = (p & 3) + 4 * (p / 384), kp = (p % 384) >> 2, tok = tb + 2 * kp;
        const u32x4 v0 = tok >= 0 ? *(const u32x4*)(F.PROJ + (rowbase + tok) * NIN + 1664 + ch * 8) : z4;
        const u32x4 v1 = tok + 1 >= 0 ? *(const u32x4*)(F.PROJ + (rowbase + tok + 1) * NIN + 1664 + ch * 8) : z4;
#pragma unroll
        for (int e = 0; e < 8; ++e) *(LAS unsigned*)(Vt + (ch * 8 + e) * SWA_VS + 2 * kp) = (unsigned)bf_at(v0, e) | ((unsigned)bf_at(v1, e) << 16); }
    __syncthreads();
    const float sk = F.in[22][h] * LOG2E;
    const size_t m0 = rowbase + 64 * qb;
    swa_qtile<false>(F, F.PROJ + (m0 + q) * NIN + 1024 + h * 64, 0, tb, h, sk, (F.MIX + (size_t)M * 512) + (m0 + q) * 512 + h * 64, ssa + m0 + q);
    swa_qtile<false>(F, F.PROJ + (m0 + 32 + q) * NIN + 1024 + h * 64, 32, tb + 32, h, sk, (F.MIX + (size_t)M * 512) + (m0 + 32 + q) * 512 + h * 64, ssa + m0 + 32 + q);
    __syncthreads();
}
__device__ __forceinline__ void swa_sample_item(Ctx& F, int n, float* ssa) {
    const int tid = F.tid, lane = F.lane, h = F.wave, q = lane & 31;
    LAS bf16_t* Kl = (LAS bf16_t*)F.lds; LAS bf16_t* Vt = (LAS bf16_t*)(F.lds + SWA_VOFF);
    const size_t m0 = (size_t)MP + 8 * n;
    const float* ck = F.in[5] + (size_t)n * 16384; const float* cv = F.in[6] + (size_t)n * 16384;
    const u32x4 z4 = (u32x4){0u, 0u, 0u, 0u};
#pragma unroll
    for (int i = 0; i < 5; ++i) { const int p = tid + 512 * i, key = p >> 4, ch = p & 15;
        u32x4 v = z4;
        if (key < 128) { const f32x4 a = __builtin_nontemporal_load((const f32x4*)(ck + key * 128 + ch * 8)), bq = __builtin_nontemporal_load((const f32x4*)(ck + key * 128 + ch * 8 + 4));
            v.x = cvt_pk_bf16(a[0], a[1]); v.y = cvt_pk_bf16(a[2], a[3]); v.z = cvt_pk_bf16(bq[0], bq[1]); v.w = cvt_pk_bf16(bq[2], bq[3]); }
        else if (key < 136) v = *(const u32x4*)(F.PROJ + (m0 + key - 128) * NIN + 1536 + ch * 8);
        *(LAS u32x4*)(Kl + key * SWA_KS + ch * 8) = v; }
#pragma unroll
    for (int i = 0; i < 3; ++i) { const int p = tid + 512 * i;
        if (p < 1280) { const int ch = (p & 3) + 4 * (p / 320), kp = (p % 320) >> 2, key = 2 * kp;
            u32x4 v0 = z4, v1 = z4;
            if (key < 128) {
                const f32x4 a0 = __builtin_nontemporal_load((const f32x4*)(cv + key * 128 + ch * 8)), b0 = __builtin_nontemporal_load((const f32x4*)(cv + key * 128 + ch * 8 + 4)), a1 = __builtin_nontemporal_load((const f32x4*)(cv + (key + 1) * 128 + ch * 8)), b1 = __builtin_nontemporal_load((const f32x4*)(cv + (key + 1) * 128 + ch * 8 + 4));
                v0.x = cvt_pk_bf16(a0[0], a0[1]); v0.y = cvt_pk_bf16(a0[2], a0[3]); v0.z = cvt_pk_bf16(b0[0], b0[1]); v0.w = cvt_pk_bf16(b0[2], b0[3]);
                v1.x = cvt_pk_bf16(a1[0], a1[1]); v1.y = cvt_pk_bf16(a1[2], a1[3]); v1.z = cvt_pk_bf16(b1[0], b1[1]); v1.w = cvt_pk_bf16(b1[2], b1[3]);
            } else if (key < 136) { v0 = *(const u32x4*)(F.PROJ + (m0 + key - 128) * NIN + 1664 + ch * 8); v1 = *(const u32x4*)(F.PROJ + (m0 + key + 1 - 128) * NIN + 1664 + ch * 8); }
#pragma unroll
            for (int e = 0; e < 8; ++e) *(LAS unsigned*)(Vt + (ch * 8 + e) * SWA_VS + 2 * kp) = (unsigned)bf_at(v0, e) | ((unsigned)bf_at(v1, e) << 16); } }
    __syncthreads();
    const float sk = F.in[22][h] * LOG2E;
    const int qc = q < 8 ? q : 7;
    swa_qtile<true>(F, F.PROJ + (m0 + qc) * NIN + 1024 + h * 64, 0, 0, h, sk, (F.MIX + (size_t)M * 512) + (m0 + qc) * 512 + h * 64, ssa + m0 + qc);
    __syncthreads();
}

constexpr int XK_S = 72, XV_S = 260, XV_OFF = 256 * XK_S * 2;
template <bool SAMPLE>
__device__ __forceinline__ void xattn_item(Ctx& F, const float* Ksrc, const float* Vsrc, int h, size_t m0) {
    const int tid = F.tid, lane = F.lane, q = lane & 31, hi = lane >> 5;
    LAS bf16_t* Kc = (LAS bf16_t*)F.lds; LAS bf16_t* Vtc = (LAS bf16_t*)(F.lds + XV_OFF);
    const bool active = SAMPLE ? (F.wave == 0) : true;
    const size_t qr = SAMPLE ? m0 + (q < 8 ? q : 7) : m0 + 32 * F.wave + q;
    const bf16_t* qrow = F.QX + qr * D + h * 256;
    f32x16 S[8];
#pragma unroll
    for (int kt = 0; kt < 8; ++kt) S[kt] = (f32x16){0.f, 0.f, 0.f, 0.f, 0.f, 0.f, 0.f, 0.f, 0.f, 0.f, 0.f, 0.f, 0.f, 0.f, 0.f, 0.f};
#define XLD(ptr) (SAMPLE ? __builtin_nontemporal_load((const f32x4*)(ptr)) : *(const f32x4*)(ptr))
    f32x4 pre[8];
    const float* kbase = Ksrc + (size_t)(tid >> 4) * 1024 + h * 256 + 4 * (tid & 15);
    const float* vbase = Vsrc + (size_t)(2 * (tid >> 2)) * 1024 + h * 256 + 4 * (tid & 3);
#pragma unroll
    for (int i = 0; i < 8; ++i) pre[i] = XLD(kbase + (size_t)i * 32 * 1024);
    for (int ch = 0; ch < 4; ++ch) {
        __syncthreads();
#pragma unroll
        for (int i = 0; i < 8; ++i) { u32x2 w; w.x = cvt_pk_bf16(pre[i][0], pre[i][1]); w.y = cvt_pk_bf16(pre[i][2], pre[i][3]); *(LAS u32x2*)(Kc + ((tid >> 4) + 32 * i) * XK_S + 4 * (tid & 15)) = w; }
        __syncthreads();
        if (ch < 3) {
#pragma unroll
            for (int i = 0; i < 8; ++i) pre[i] = XLD(kbase + (size_t)i * 32 * 1024 + 64 * (ch + 1));
        } else {
#pragma unroll
            for (int i = 0; i < 4; ++i) { pre[2 * i] = XLD(vbase + 16 * i); pre[2 * i + 1] = XLD(vbase + 1024 + 16 * i); }
        }
        if (active) {
#pragma unroll 1
            for (int ks = 0; ks < 4; ++ks) {
                const bf16x8 qf = *(const bf16x8*)(qrow + 64 * ch + 16 * ks + 8 * hi);
#pragma unroll
                for (int kt = 0; kt < 8; ++kt) {
                    const bf16x8 a = *(const LAS bf16x8*)(Kc + (32 * kt + q) * XK_S + 16 * ks + 8 * hi);
                    S[kt] = __builtin_amdgcn_mfma_f32_32x32x16_bf16(a, qf, S[kt], 0, 0, 0);
                }
            }
        }
    }
    float mx = -INFINITY;
#pragma unroll
    for (int kt = 0; kt < 8; ++kt)
#pragma unroll
        for (int r = 0; r < 16; ++r) mx = fmaxf(mx, S[kt][r]);
    mx = fmaxf(mx, __shfl_xor(mx, 32));
    float l = 0.f; bf16x8 pb[16];
#pragma unroll
    for (int kt = 0; kt < 8; ++kt) {
        float p[16];
#pragma unroll
        for (int r = 0; r < 16; ++r) { p[r] = fexp2(S[kt][r] - mx); l += p[r]; }
#pragma unroll
        for (int hf = 0; hf < 2; ++hf) {
            u32x4 w; w.x = cvt_pk_bf16(p[8 * hf + 0], p[8 * hf + 1]); w.y = cvt_pk_bf16(p[8 * hf + 2], p[8 * hf + 3]); w.z = cvt_pk_bf16(p[8 * hf + 4], p[8 * hf + 5]); w.w = cvt_pk_bf16(p[8 * hf + 6], p[8 * hf + 7]);
            pb[2 * kt + hf] = __builtin_bit_cast(bf16x8, w);
        }
    }
    l += __shfl_xor(l, 32);
    const float inv = 1.0f / l;
    bf16_t* orow = F.XO + qr * D + h * 256;
    for (int ch = 0; ch < 4; ++ch) {
        __syncthreads();
#pragma unroll
        for (int i = 0; i < 4; ++i) {
#pragma unroll
            for (int e = 0; e < 4; ++e) *(LAS unsigned*)(Vtc + (4 * ((tid & 3) + 4 * i) + e) * XV_S + 2 * (tid >> 2)) = cvt_pk_bf16(pre[2 * i][e], pre[2 * i + 1][e]); }
        __syncthreads();
        if (ch < 3) {
#pragma unroll
            for (int i = 0; i < 4; ++i) { pre[2 * i] = XLD(vbase + 64 * (ch + 1) + 16 * i); pre[2 * i + 1] = XLD(vbase + 1024 + 64 * (ch + 1) + 16 * i); }
        }
        if (active) {
#pragma unroll
            for (int dt = 0; dt < 2; ++dt) {
                f32x16 o = (f32x16){0.f, 0.f, 0.f, 0.f, 0.f, 0.f, 0.f, 0.f, 0.f, 0.f, 0.f, 0.f, 0.f, 0.f, 0.f, 0.f};
#pragma unroll
                for (int u = 0; u < 16; ++u) {
                    const LAS bf16_t* vp = Vtc + (32 * dt + q) * XV_S + 16 * u + 4 * hi;
                    const u32x2 lo = *(const LAS u32x2*)vp, hi4 = *(const LAS u32x2*)(vp + 8);
                    u32x4 w; w.x = lo.x; w.y = lo.y; w.z = hi4.x; w.w = hi4.y;
                    o = __builtin_amdgcn_mfma_f32_32x32x16_bf16(__builtin_bit_cast(bf16x8, w), pb[u], o, 0, 0, 0);
                }
                if (!SAMPLE || q < 8) {
#pragma unroll
                    for (int rg = 0; rg < 4; ++rg) {
                        u32x2 w; w.x = cvt_pk_bf16(o[4 * rg] * inv, o[4 * rg + 1] * inv); w.y = cvt_pk_bf16(o[4 * rg + 2] * inv, o[4 * rg + 3] * inv);
                        st8(orow + 64 * ch + 32 * dt + 8 * rg + 4 * hi, w);
                    }
                }
            }
        }
    }
    __syncthreads();
}

struct MiniSeg { const bf16_t* A; const bf16_t* Bt; int K; const float* rowss; };
template <int MODE  , int NSEG>
__device__ __forceinline__ void mini_gemm(Ctx& F, const MiniSeg& sg0, const MiniSeg& sg1, float cscale, const float* base_s  , bf16_t* XB, float* ss_out, bf16_t* O, const float* ssin, float cst,
                                          unsigned* cnt_s = nullptr, const float* gfin = nullptr, float* Y = nullptr  ) {
    const int t = F.bid; if (t >= 256) return;
    const int lane = F.lane, w = F.wave, fr = lane & 15, fq = lane >> 4;
    const int R0 = (t >> 4) * 64, C0 = (t & 15) * 64;
    f32x4 acc[4][4];
#pragma unroll
    for (int mt = 0; mt < 4; ++mt)
#pragma unroll
        for (int nt = 0; nt < 4; ++nt) acc[mt][nt] = (f32x4){0.f, 0.f, 0.f, 0.f};
#pragma unroll
    for (int s_ = 0; s_ < NSEG; ++s_) {
        const MiniSeg& sg = s_ ? sg1 : sg0;
        const int K = sg.K, nsteps = K >> 8;
        const bf16_t* pa = sg.A + (size_t)(R0 + fr) * K + (size_t)w * (K >> 3) + 8 * fq; const bf16_t* pb = sg.Bt + (size_t)(C0 + fr) * K + (size_t)w * (K >> 3) + 8 * fq;
        f32x4 sacc[4][4];
        if (NSEG > 1) {
#pragma unroll
            for (int mt = 0; mt < 4; ++mt)
#pragma unroll
                for (int nt = 0; nt < 4; ++nt) sacc[mt][nt] = (f32x4){0.f, 0.f, 0.f, 0.f};
        }
        constexpr int NB = (NSEG > 1) ? 2 : 4;
#pragma unroll 1
        for (int s0 = 0; s0 < nsteps; s0 += NB) {
            bf16x8 a[NB][4], b[NB][4];
#pragma unroll
            for (int s = 0; s < NB; ++s)
                if (s0 + s < nsteps) {
#pragma unroll
                    for (int i = 0; i < 4; ++i) { a[s][i] = *(const bf16x8*)(pa + (size_t)(16 * i) * K + 32 * (s0 + s)); b[s][i] = *(const bf16x8*)(pb + (size_t)(16 * i) * K + 32 * (s0 + s)); }
                }
#pragma unroll
            for (int s = 0; s < NB; ++s)
                if (s0 + s < nsteps) {
#pragma unroll
                    for (int mt = 0; mt < 4; ++mt)
#pragma unroll
                        for (int nt = 0; nt < 4; ++nt) {
                            if (NSEG > 1) sacc[mt][nt] = __builtin_amdgcn_mfma_f32_16x16x32_bf16(b[s][nt], a[s][mt], sacc[mt][nt], 0, 0, 0);
                            else acc[mt][nt] = __builtin_amdgcn_mfma_f32_16x16x32_bf16(b[s][nt], a[s][mt], acc[mt][nt], 0, 0, 0);
                        }
                }
        }
        if (NSEG > 1) {
#pragma unroll
            for (int mt = 0; mt < 4; ++mt) {
                const float sc = rsqrtf(sg.rowss[MP + R0 + 16 * mt + fr] * (1.0f / 512.0f) + EPS);
#pragma unroll
                for (int nt = 0; nt < 4; ++nt) acc[mt][nt] = acc[mt][nt] + sacc[mt][nt] * sc;
            }
        }
    }
    LAS float* part = (LAS float*)(F.lds + w * 16384);
#pragma unroll
    for (int mt = 0; mt < 4; ++mt)
#pragma unroll
        for (int nt = 0; nt < 4; ++nt) { const int row = 16 * mt + fr, chn = (4 * nt + fq) ^ fr; *(LAS f32x4*)(part + row * 64 + 4 * chn) = acc[mt][nt]; }
    __syncthreads();
    const int r = 8 * w + (lane >> 3), j = lane & 7;
    f32x4 t0 = (f32x4){0.f, 0.f, 0.f, 0.f}, t1 = t0;
#pragma unroll
    for (int pw = 0; pw < 8; ++pw) {
        const LAS float* pp = (const LAS float*)(F.lds + pw * 16384) + r * 64;
        t0 = t0 + *(const LAS f32x4*)(pp + 4 * ((2 * j) ^ (r & 15))); t1 = t1 + *(const LAS f32x4*)(pp + 4 * ((2 * j + 1) ^ (r & 15)));
    }
    const int R = MP + R0 + r, C = C0 + 8 * j;
    if (MODE == 0 || MODE == 2) {
        if (NSEG == 1) { t0 = t0 * cscale; t1 = t1 * cscale; }
        f32x4 b0, b1;
        if (base_s) { b0 = *(const f32x4*)(base_s + (size_t)(R - MP) * D + C); b1 = *(const f32x4*)(base_s + (size_t)(R - MP) * D + C + 4); }
        else { const u32x4 wv = *(const u32x4*)(XB + (size_t)R * D + C);
            b0 = (f32x4){__uint_as_float(wv.x << 16), __uint_as_float(wv.x & 0xffff0000u), __uint_as_float(wv.y << 16), __uint_as_float(wv.y & 0xffff0000u)};
            b1 = (f32x4){__uint_as_float(wv.z << 16), __uint_as_float(wv.z & 0xffff0000u), __uint_as_float(wv.w << 16), __uint_as_float(wv.w & 0xffff0000u)}; }
        const f32x4 v0 = b0 + t0, v1 = b1 + t1;
        if (MODE == 0) { u32x4 wo; wo.x = cvt_pk_bf16(v0[0], v0[1]); wo.y = cvt_pk_bf16(v0[2], v0[3]); wo.z = cvt_pk_bf16(v1[0], v1[1]); wo.w = cvt_pk_bf16(v1[2], v1[3]);
            *(u32x4*)(XB + (size_t)R * D + C) = wo; }
        float sq = (v0[0] * v0[0] + v0[1] * v0[1]) + (v0[2] * v0[2] + v0[3] * v0[3]) + (v1[0] * v1[0] + v1[1] * v1[1]) + (v1[2] * v1[2] + v1[3] * v1[3]);
        sq += __shfl_xor(sq, 1); sq += __shfl_xor(sq, 2); sq += __shfl_xor(sq, 4);
        if (j == 0) unsafeAtomicAdd(ss_out + R, sq);
        if (MODE == 2) {
            asm volatile("s_waitcnt vmcnt(0)" ::: "memory");
            __syncthreads();
            if (threadIdx.x == 0) {
                unsigned* c = cnt_s + 64 * (t >> 4);
                __hip_atomic_fetch_add(c, 1u, __ATOMIC_RELAXED, __HIP_MEMORY_SCOPE_AGENT);
                unsigned sp = 0u;
                while (__hip_atomic_load(c, __ATOMIC_RELAXED, __HIP_MEMORY_SCOPE_AGENT) < 16u) { __builtin_amdgcn_s_sleep(2); if (++sp > (1u << 20)) break; }
            }
            __syncthreads();
            float s = 0.f; if (j == 0) s = unsafeAtomicAdd(ss_out + R, 0.0f);
            s = __shfl(s, lane & ~7);
            const float rs = rstd_of(s);
            const f32x4 g0 = *(const f32x4*)(gfin + C), g1 = *(const f32x4*)(gfin + C + 4);
            __builtin_nontemporal_store(v0 * rs * g0, (f32x4*)(Y + (size_t)R * D + C)); __builtin_nontemporal_store(v1 * rs * g1, (f32x4*)(Y + (size_t)R * D + C + 4));
        }
    } else {
        const float rs = rstd_of(ssin[R]) * cst;
        const f32x4 v0 = t0 * rs, v1 = t1 * rs;
        u32x4 wo; wo.x = cvt_pk_bf16(v0[0], v0[1]); wo.y = cvt_pk_bf16(v0[2], v0[3]); wo.z = cvt_pk_bf16(v1[0], v1[1]); wo.w = cvt_pk_bf16(v1[2], v1[3]);
        st16(O + (size_t)R * D + C, wo);
    }
    __syncthreads();
}

__global__ void __launch_bounds__(512, 2) hymba_fwd(Args args) {
    extern __shared__ __attribute__((aligned(16))) unsigned char lds_raw[];
    cg::grid_group grid = cg::this_grid();
    Ctx F;
    F.lds = (LAS unsigned char*)lds_raw; F.tid = threadIdx.x; F.lane = F.tid & 63; F.wave = __builtin_amdgcn_readfirstlane(F.tid >> 6); F.G = gridDim.x; F.bid = blockIdx.x;
    F.in = args.in; F.out = args.out; F.ws = args.ws;
    unsigned char* ws = args.ws;
    F.SS = (float*)(ws + WS_SS); F.ROPE = (float*)(ws + WS_ROPE); F.SUMA = (float*)(ws + WS_SUM); F.SUMB = F.SUMA + 256 * 512; F.WAB = (bf16_t*)(ws + WS_WAB);
    F.XB = (bf16_t*)(ws + WS_XB); F.H = (bf16_t*)(ws + WS_H); F.X = (float*)(ws + WS_X); F.PROJ = (bf16_t*)(ws + WS_PROJ); F.MIX = (bf16_t*)(ws + WS_MIX);
    F.QX = (bf16_t*)(ws + WS_QX); F.XO = (bf16_t*)(ws + WS_XO);
    float* ss0 = F.SS; float* ss1 = F.SS + M; float* ss2 = F.SS + 2 * M; float* ss3 = F.SS + 3 * M; float* ss4 = F.SS + 4 * M;
    constexpr size_t WS_BAR = WS_WAB + 2 * MiB;
    unsigned* const barw = (unsigned*)(ws + WS_BAR);
    volatile LAS unsigned* const barst = (volatile LAS unsigned*)(F.lds + MISC_OFF + 8192);
    if (threadIdx.x < 2) barst[threadIdx.x] = 0u;
    __syncthreads();
    XcdBarrier xbar = xcd_barrier_post(barw, barst);
#define GRID_SYNC() xcd_barrier(xbar)
#define RETID() do { int t_ = threadIdx.x; asm volatile("" : "+v"(t_)); F.tid = t_; F.lane = t_ & 63; F.wave = __builtin_amdgcn_readfirstlane(t_ >> 6); } while (0)
#ifndef PHASE_MASK
#define PHASE_MASK 0xFFFF
#endif
#define PH(k) if constexpr (((PHASE_MASK) >> (k)) & 1)
#ifndef DUP_MASK
#define DUP_MASK 0
#endif
#ifndef EXTRA_SYNCS
#define EXTRA_SYNCS 0
#endif
#define REP(k) for (int rep = 0; rep < 1 + (((DUP_MASK) >> (k)) & 1); ++rep)
    float* const ssdummy = (float*)(ws + WS_WAB + MiB);

    PH(0) REP(0) { RETID(); p0_prologue(F, args.inv_rev); }
    if (args.use_cg) grid.sync();
    GRID_SYNC();
    for (int e = 0; e < EXTRA_SYNCS; ++e) GRID_SYNC();
    PH(1) REP(1) {
        Gemm g{F.XB, (const bf16_t*)(ws + WS_W1GU), M, 2 * FF, D}; StaticOrder S; S.init(M, 2 * FF, F.G, F.bid);
        EpiGU E{F.H, ss0};
        gemm_phase<EpiGU, StaticOrder, true, true>(F.lds, g, S, E);
        Gemm g2{F.XB + (size_t)M * D, (const bf16_t*)(ws + WS_WCKV), MEMR, 2 * D, D}; StaticOrder S2; S2.init(MEMR, 2 * D, F.G, F.G - 1 - F.bid);
        EpiMemKV E2{F.out};
        gemm_phase<EpiMemKV, StaticOrder, true, true>(F.lds, g2, S2, E2);
    }
    GRID_SYNC();
    PH(2) {
        Gemm g{F.H, (const bf16_t*)(ws + WS_W1D), MP, D, FF}; StaticOrder S; S.init(MP, D, F.G, F.bid);
        EpiRes<false, false> E{nullptr, nullptr, F.XB, ss1, 0.5f, nullptr};
        gemm_phase<EpiRes<false, false>, StaticOrder, true, true>(F.lds, g, S, E);
        RETID(); const MiniSeg s0{F.H + (size_t)MP * FF, (const bf16_t*)(ws + WS_W1D), FF, nullptr};
        mini_gemm<0, 1>(F, s0, s0, 0.5f, nullptr, F.XB, ss1, nullptr, nullptr, 0.f);
    }
    GRID_SYNC();
    PH(3) REP(3) {
        Gemm g{F.XB, (const bf16_t*)(ws + WS_WIN), M, NIN, D}; StaticOrder S; S.init(M, NIN, F.G, F.bid);
        EpiIn E{F.PROJ, ss1, F.ROPE, F.out};
        gemm_phase<EpiIn, StaticOrder, true, true>(F.lds, g, S, E);
    }
    GRID_SYNC();
    unsigned* const cntl = barw + 9216;
    PH(4) { RETID(); for (int it = F.bid; it < 256; it += F.G) lru_tile<false, 1, 2>(F, (it >> 7) * SEQ + (it & 127) * 64, it >> 7, it & 127, nullptr); }
    asm volatile("s_waitcnt vmcnt(0)" ::: "memory");
    __syncthreads();
    if (threadIdx.x == 0 && F.bid < 256) __hip_atomic_fetch_add(cntl + 64 * (F.bid >> 7), 1u, __ATOMIC_RELAXED, __HIP_MEMORY_SCOPE_AGENT);
    PH(13) REP(13) { RETID(); float* ssa = rep ? ssdummy : F.SS + 6 * M; for (int it = F.bid; it < 256 + 128; it += F.G) { if (it < 256) swa_prompt_item(F, it >> 7, it & 127, ssa); else swa_sample_item(F, it - 256, ssa); }
        if (rep == 0 && F.bid >= 128 && F.bid < 160) { const int st = F.bid - 128; lru_tile<true, 2, 1>(F, MP + st * 32, st * 4, 0, F.SS + 5 * M); } }
    if (threadIdx.x == 0 && F.bid < 256) {
        unsigned sp = 0u;
        while (__hip_atomic_load(cntl + 64 * (F.bid >> 7), __ATOMIC_RELAXED, __HIP_MEMORY_SCOPE_AGENT) < 128u) { __builtin_amdgcn_s_sleep(2); if (++sp > (1u << 20)) break; }
        __builtin_amdgcn_fence(__ATOMIC_ACQUIRE, "agent");
        asm volatile("s_waitcnt vmcnt(0)" ::: "memory");
    }
    __syncthreads();
    PH(5) REP(5) { RETID(); float* ssl = rep ? ssdummy : F.SS + 5 * M;
        for (int it = F.bid; it < 256; it += F.G) lru_tile<false, 2, 2>(F, (it >> 7) * SEQ + (it & 127) * 64, it >> 7, it & 127, ssl);
    }
    GRID_SYNC();
    PH(6) {
        StaticOrder2 S; S.init(MP, D, F.G, F.bid);
        Gemm g{F.MIX, (const bf16_t*)(ws + WS_WOUT), MP, D, 512, F.MIX + (size_t)M * 512, (const bf16_t*)(ws + WS_WOUT + MiB)};
        EpiMix E{F.XB, ss2, F.SS + 5 * M, F.SS + 6 * M};
        gemm_phase<EpiMix, StaticOrder2, true, true>(F.lds, g, S, E);
        RETID(); const MiniSeg s0{F.MIX + (size_t)MP * 512, (const bf16_t*)(ws + WS_WOUT), 512, F.SS + 5 * M}, s1{F.MIX + (size_t)(M + MP) * 512, (const bf16_t*)(ws + WS_WOUT + MiB), 512, F.SS + 6 * M};
        mini_gemm<0, 2>(F, s0, s1, 1.0f, nullptr, F.XB, ss2, nullptr, nullptr, 0.f);
    }
    GRID_SYNC();
    PH(7) REP(7) {
        Gemm g{F.XB, (const bf16_t*)(ws + WS_WCQ), MP, D, D}; StaticOrder S; S.init(MP, D, F.G, F.bid);
        EpiRowBf16 E{F.QX, D, ss2, C2X};
        gemm_phase<EpiRowBf16, StaticOrder, true, true>(F.lds, g, S, E);
        RETID(); const MiniSeg s0{F.XB + (size_t)MP * D, (const bf16_t*)(ws + WS_WCQ), D, nullptr};
        mini_gemm<1, 1>(F, s0, s0, 1.0f, nullptr, nullptr, nullptr, F.QX, ss2, C2X);
    }
    GRID_SYNC();
    PH(8) REP(8) { RETID();
        if (F.bid < 256) {
            const int itp = F.bid, b = itp >> 7, hp = (itp >> 5) & 3, qb = itp & 31;
            if (!(F.bid & 1)) xattn_item<false>(F, F.out + O_MK + (size_t)b * 262144, F.out + O_MV + (size_t)b * 262144, hp, (size_t)b * SEQ + 256 * qb);
#pragma unroll 1
            for (int sl = 0; sl < 2; ++sl) { const int j = F.bid + 256 * sl, n = j >> 2, h = j & 3;
                xattn_item<true>(F, F.in[3] + (size_t)n * 262144, F.in[4] + (size_t)n * 262144, h, (size_t)MP + 8 * n); }
            if (F.bid & 1) xattn_item<false>(F, F.out + O_MK + (size_t)b * 262144, F.out + O_MV + (size_t)b * 262144, hp, (size_t)b * SEQ + 256 * qb);
        }
    }
    GRID_SYNC();
    PH(9) {
        Gemm g{F.XO, (const bf16_t*)(ws + WS_WCO), MP, D, D}; StaticOrder S; S.init(MP, D, F.G, F.bid);
        EpiRes<false, false> E{nullptr, nullptr, F.XB, ss3, 1.0f, nullptr};
        gemm_phase<EpiRes<false, false>, StaticOrder, true, true>(F.lds, g, S, E);
        RETID(); const MiniSeg s0{F.XO + (size_t)MP * D, (const bf16_t*)(ws + WS_WCO), D, nullptr};
        mini_gemm<0, 1>(F, s0, s0, 1.0f, nullptr, F.XB, ss3, nullptr, nullptr, 0.f);
    }
    GRID_SYNC();
    PH(10) REP(10) {
        Gemm g{F.XB, (const bf16_t*)(ws + WS_W2GU), M, 2 * FF, D}; StaticOrder S; S.init(M, 2 * FF, F.G, F.bid);
        EpiGU E{F.H, ss3};
        gemm_phase<EpiGU, StaticOrder, true, true>(F.lds, g, S, E);
    }
    GRID_SYNC();
    PH(11) {
        unsigned* cntp = barw + 4096; unsigned* cnts = barw + 8192;
        Gemm g{F.H, (const bf16_t*)(ws + WS_W2D), MP, D, FF}; StaticOrder S; S.init(MP, D, F.G, F.bid);
        EpiFinal E{F.XB, ss4, cntp, F.in[36], F.out + O_Y, 0.5f};
        gemm_phase<EpiFinal, StaticOrder, false, true>(F.lds, g, S, E);
        RETID(); const MiniSeg s0{F.H + (size_t)MP * FF, (const bf16_t*)(ws + WS_W2D), FF, nullptr};
        mini_gemm<2, 1>(F, s0, s0, 0.5f, nullptr, F.XB, ss4, nullptr, nullptr, 0.f, cnts, F.in[36], F.out + O_Y);
    }
}

extern "C" void kernel_launch(void* const* d_in, const int* in_sizes, int n_in, void* d_out, int out_size, void* d_ws, size_t ws_size, hipStream_t stream) {
    static int grid = 0;
    if (grid == 0) {
        if (n_in != 37 || (size_t)out_size != O_END || ws_size < WS_END) { fprintf(stderr, "kernel_launch: unexpected shapes: n_in %d out %d (want %zu) ws %zu (want >= %zu)\n", n_in, out_size, (size_t)O_END, ws_size, (size_t)WS_END); grid = -1; return; }
        int dev = 0, cus = 0, per_cu = 0;
        hipGetDevice(&dev); hipDeviceGetAttribute(&cus, hipDeviceAttributeMultiprocessorCount, dev);
        if (hipFuncSetAttribute((const void*)hymba_fwd, hipFuncAttributeMaxDynamicSharedMemorySize, LDS_BYTES) != hipSuccess) { fprintf(stderr, "kernel_launch: hipFuncSetAttribute failed\n"); grid = -1; return; }
        if (hipOccupancyMaxActiveBlocksPerMultiprocessor(&per_cu, (const void*)hymba_fwd, 512, LDS_BYTES) != hipSuccess || per_cu < 1) { fprintf(stderr, "kernel_launch: occupancy query says %d blocks/CU\n", per_cu); (void)hipGetLastError(); per_cu = 1; }
        grid = cus;
        if (grid != 256) fprintf(stderr, "kernel_launch: note: %d CUs\n", grid);
    }
    if (grid < 0) return;
    Args a; memset(&a, 0, sizeof(a));
    for (int i = 0; i < 37; ++i) a.in[i] = (const float*)d_in[i];
    a.out = (float*)d_out; a.ws = (unsigned char*)d_ws;
    for (int i = 0; i < 32; ++i) a.inv_rev[i] = std::pow(10000.0, -(double)i / 32.0) / 6.283185307179586476925;
    a.use_cg = 0;
    if (hipMemsetAsync((char*)d_ws + WS_WAB + 2 * MiB, 0, 40960, stream) != hipSuccess) { fprintf(stderr, "kernel_launch: memset of barrier words failed\n"); return; }
    void* kargs[] = {&a};
    hipError_t e = hipLaunchCooperativeKernel((const void*)hymba_fwd, dim3(grid), dim3(512), kargs, LDS_BYTES, stream);
    if (e != hipSuccess) fprintf(stderr, "kernel_launch: cooperative launch failed: %s (grid %d)\n", hipGetErrorString(e), grid);
}
```

```cpp
#include <hip/hip_runtime.h>
#include <hip/hip_cooperative_groups.h>
#include <cstdio>
#include <cstdint>
#include <cmath>
#include <cstring>
namespace cg = cooperative_groups;
namespace pg8 {
#define PG8_LAS __attribute__((address_space(3)))
typedef unsigned short bf16_t;
typedef short bf16x8 __attribute__((ext_vector_type(8)));
typedef float f32x4 __attribute__((ext_vector_type(4)));
typedef unsigned u32x4 __attribute__((ext_vector_type(4)));
constexpr int BM = 256, BK = 64, HALF = 128, HTB = HALF * BK * 2  , STAGE_BYTES = 8 * HTB, NXCD = 8, WGM = 8;

__host__ __device__ __forceinline__ int lds_byte(int r, int c) { const int st = (r >> 4) * 2 + (c >> 5), rr = r & 15, cc = c & 31, ob = rr * 64 + cc * 2; return st * 1024 + (ob ^ (((ob >> 9) & 1) << 5)); }
__host__ __device__ __forceinline__ void stage_rc(int b, int& R, int& C) { const int st = b / 1024, sb = b % 1024, swz = sb ^ (((sb >> 9) & 1) << 5); R = (st >> 1) * 16 + swz / 64; C = (st & 1) * 32 + (swz % 64) / 2; }
__host__ __device__ __forceinline__ int perm32(int rho) { const int n = rho >> 4, i = rho & 15; return 8 * (i >> 2) + 4 * n + (i & 3); }

struct Unit { int pm, pn, seg; };
struct Gemm { const bf16_t* A; const bf16_t* Bt; int M, N, K; const bf16_t* A2; const bf16_t* Bt2; };

struct StaticOrder {
    int nM, nN, nwg, G, c;
    __host__ __device__ void init(int M, int N, int G_, int c_) { nM = M / BM; nN = N / BM; nwg = nM * nN; G = G_; c = c_; }
    __host__ __device__ bool next(int i, Unit& u) const {
        const long L = (long)i * G + c; if (L >= nwg) return false;
        int wgid = (int)L; { const int q = nwg / NXCD, r = nwg % NXCD, xcd = wgid % NXCD, off = wgid / NXCD; wgid = (xcd < r ? xcd * (q + 1) : r * (q + 1) + (xcd - r) * q) + off; }
        const int nig = WGM * nN, gid = wgid / nig, fm = gid * WGM, gsz = (nM - fm) < WGM ? (nM - fm) : WGM;
        u.pm = fm + ((wgid % nig) % gsz); u.pn = (wgid % nig) / gsz; u.seg = 0; return true;
    }
    __device__ __forceinline__ void a_ready(const Unit&) const {}
    __device__ __forceinline__ void done(const Unit&) const {}
};

__device__ __forceinline__ unsigned cvt_pk_bf16(float lo, float hi) { unsigned r; asm volatile("v_cvt_pk_bf16_f32 %0, %1, %2" : "=v"(r) : "v"(lo), "v"(hi)); return r; }

template <class Epi, class Sched, bool ALIGN_EPI = false, bool SP2 = false>
__device__ __forceinline__ void gemm_phase(PG8_LAS unsigned char* lds, const Gemm g, const Sched& S, const Epi& E) {
    int tid_ = threadIdx.x; asm volatile("" : "+v"(tid_)); const int tid = tid_, wid = __builtin_amdgcn_readfirstlane(tid >> 6), lane = tid & 63, wr = wid >> 2, wc = wid & 3, fr = lane & 15, fq = lane >> 4;
    const int K = g.K, nt = K / BK;
    unsigned voffA[2], voffB[2];
#pragma unroll
    for (int i = 0; i < 2; ++i) { int R, C; stage_rc(tid * 16 + i * 8192, R, C); const int Rb = Epi::PERM ? ((R & ~31) + perm32(R & 31)) : R;
        voffA[i] = (unsigned)(R * K + C) * 2u; voffB[i] = (unsigned)(Rb * K + C) * 2u; }
    const size_t kstep = (size_t)(BK * 2);
    const size_t hstep = (size_t)HALF * K * 2;
    const size_t tstep = 2 * hstep;
    const unsigned ldsw = (unsigned)wid * 1024u;
    const int aoff = lds_byte(wr * 64 + fr, fq * 8), boff = lds_byte(wc * 32 + fr, fq * 8);
#define PG8_SA(b, h) (((b) * 2 + (h)) * HTB)
#define PG8_SB(b, h) ((4 + (b) * 2 + (h)) * HTB)
#define PG8_STAGE(bufoff, gbase, voff) do { _Pragma("unroll") for (int _i = 0; _i < 2; ++_i) \
        __builtin_amdgcn_global_load_lds((const unsigned*)((const char*)(gbase) + (voff)[_i]), (PG8_LAS unsigned*)(lds + (bufoff) + ldsw + _i * 8192), 16, 0, 0); } while (0)
#define PG8_LDA(dst, b, h) do { _Pragma("unroll") for (int m = 0; m < 4; ++m) _Pragma("unroll") for (int k = 0; k < 2; ++k) dst[m][k] = *(const PG8_LAS bf16x8*)(lds + PG8_SA(b, h) + aoff + m * 2048 + k * 1024); } while (0)
#define PG8_LDB(dst, b, h) do { _Pragma("unroll") for (int n = 0; n < 2; ++n) _Pragma("unroll") for (int k = 0; k < 2; ++k) dst[n][k] = *(const PG8_LAS bf16x8*)(lds + PG8_SB(b, h) + boff + n * 2048 + k * 1024); } while (0)
#define PG8_MMA(ai, bj, At, Bt) do { __builtin_amdgcn_s_setprio(1); _Pragma("unroll") for (int m = 0; m < 4; ++m) _Pragma("unroll") for (int n = 0; n < 2; ++n) _Pragma("unroll") for (int k = 0; k < 2; ++k) \
        acc[ai][bj][m][n] = __builtin_amdgcn_mfma_f32_16x16x32_bf16(Bt[n][k], At[m][k], acc[ai][bj][m][n], 0, 0, 0); __builtin_amdgcn_s_setprio(0); } while (0)
#define PG8_WAIT_V(n) asm volatile("s_waitcnt vmcnt(" #n ")" ::: "memory")
#define PG8_WAIT_L(n) asm volatile("s_waitcnt lgkmcnt(" #n ")" ::: "memory")
#define PG8_BAR __builtin_amdgcn_s_barrier()
#define PG8_SCHED __builtin_amdgcn_sched_barrier(0)
    Unit cur, nxt; int ui = 0;
    if (!S.next(0, cur)) return;
    f32x4 acc[2][2][4][2];
#pragma unroll
    for (int a = 0; a < 2; ++a)
#pragma unroll
        for (int b = 0; b < 2; ++b)
#pragma unroll
            for (int m = 0; m < 4; ++m)
#pragma unroll
                for (int n = 0; n < 2; ++n) acc[a][b][m][n] = (f32x4){0.f, 0.f, 0.f, 0.f};
    bf16x8 At[4][2], B0[2][2], B1[2][2];
    const char* cA = (const char*)((Epi::TWOSEG && cur.seg) ? g.A2 : g.A) + (size_t)cur.pm * tstep; const char* cB = (const char*)((Epi::TWOSEG && cur.seg) ? g.Bt2 : g.Bt) + (size_t)cur.pn * tstep;
    S.a_ready(cur);
    if constexpr (SP2) {
        PG8_STAGE(PG8_SB(0, 0), cB, voffB); PG8_STAGE(PG8_SB(0, 1), cB + hstep, voffB); PG8_STAGE(PG8_SA(0, 0), cA, voffA); PG8_STAGE(PG8_SA(0, 1), cA + hstep, voffA);
        if (wr == 1) PG8_BAR;
        PG8_WAIT_V(2); PG8_BAR;
        PG8_STAGE(PG8_SB(1, 0), cB + kstep, voffB); PG8_STAGE(PG8_SA(1, 0), cA + kstep, voffA); PG8_STAGE(PG8_SB(1, 1), cB + hstep + kstep, voffB);
        PG8_WAIT_V(6); PG8_BAR;
    } else {
        PG8_STAGE(PG8_SB(0, 0), cB, voffB); PG8_STAGE(PG8_SA(0, 0), cA, voffA); PG8_STAGE(PG8_SB(0, 1), cB + hstep, voffB); PG8_STAGE(PG8_SA(0, 1), cA + hstep, voffA);
        if (wr == 1) PG8_BAR;
        PG8_WAIT_V(4); PG8_BAR;
        PG8_STAGE(PG8_SB(1, 0), cB + kstep, voffB); PG8_STAGE(PG8_SA(1, 0), cA + kstep, voffA); PG8_STAGE(PG8_SB(1, 1), cB + hstep + kstep, voffB);
        PG8_WAIT_V(6); PG8_BAR;
    }
    for (;;) {
        const bool has_next = S.next(ui + 1, nxt);
        const char* nA = has_next ? (const char*)((Epi::TWOSEG && nxt.seg) ? g.A2 : g.A) + (size_t)nxt.pm * tstep : cA; const char* nB = has_next ? (const char*)((Epi::TWOSEG && nxt.seg) ? g.Bt2 : g.Bt) + (size_t)nxt.pn * tstep : cB;
        for (int t = 0; t < nt; t += 2) {
            const bool last = (t == nt - 2);
            if constexpr (Epi::MIDSCALE) { if (t == nt / 2) E.mid(acc, cur, wr, wc, fr, fq); }
            const char* a1 = cA + (size_t)(t + 1) * kstep;
            const char* a2 = last ? nA : cA + (size_t)(t + 2) * kstep; const char* b2 = last ? nB : cB + (size_t)(t + 2) * kstep;
            const char* a3 = a2 + kstep; const char* b3 = b2 + kstep;
            if (last && has_next) S.a_ready(nxt);
            if constexpr (SP2) {
            PG8_LDB(B0, 0, 0); PG8_LDB(B1, 0, 1); PG8_SCHED; PG8_LDA(At, 0, 0); PG8_STAGE(PG8_SA(1, 1), a1 + hstep, voffA);
            PG8_WAIT_V(8); PG8_WAIT_L(0); PG8_BAR; PG8_MMA(0, 0, At, B0); PG8_MMA(0, 1, At, B1); PG8_BAR; PG8_SCHED;
            PG8_LDA(At, 0, 1); PG8_STAGE(PG8_SB(0, 0), b2, voffB); PG8_STAGE(PG8_SB(0, 1), b2 + hstep, voffB); PG8_STAGE(PG8_SA(0, 0), a2, voffA);
            PG8_WAIT_V(8); PG8_WAIT_L(0); PG8_BAR; PG8_MMA(1, 0, At, B0); PG8_MMA(1, 1, At, B1); PG8_BAR; PG8_SCHED;
            PG8_LDB(B0, 1, 0); PG8_LDB(B1, 1, 1); PG8_SCHED; PG8_LDA(At, 1, 0); PG8_STAGE(PG8_SA(0, 1), a2 + hstep, voffA);
            PG8_WAIT_V(8); PG8_WAIT_L(0); PG8_BAR; PG8_MMA(0, 0, At, B0); PG8_MMA(0, 1, At, B1); PG8_BAR; PG8_SCHED;
            PG8_LDA(At, 1, 1); PG8_STAGE(PG8_SB(1, 0), b3, voffB); PG8_STAGE(PG8_SB(1, 1), b3 + hstep, voffB); PG8_STAGE(PG8_SA(1, 0), a3, voffA);
            PG8_WAIT_V(8); PG8_WAIT_L(0); PG8_BAR; PG8_MMA(1, 0, At, B0); PG8_MMA(1, 1, At, B1); PG8_BAR; PG8_SCHED;
            } else {
            PG8_LDB(B0, 0, 0); PG8_SCHED; PG8_LDA(At, 0, 0); PG8_STAGE(PG8_SA(1, 1), a1 + hstep, voffA);
            PG8_WAIT_L(8); PG8_BAR; PG8_WAIT_L(0); PG8_MMA(0, 0, At, B0); PG8_BAR; PG8_SCHED;
            PG8_LDB(B1, 0, 1); PG8_STAGE(PG8_SB(0, 0), b2, voffB);
            PG8_BAR; PG8_WAIT_L(0); PG8_MMA(0, 1, At, B1); PG8_BAR;
            PG8_LDA(At, 0, 1); PG8_STAGE(PG8_SA(0, 0), a2, voffA);
            PG8_BAR; PG8_WAIT_L(0); PG8_MMA(1, 0, At, B0); PG8_BAR; PG8_SCHED;
            PG8_STAGE(PG8_SB(0, 1), b2 + hstep, voffB);
            PG8_WAIT_V(6); PG8_BAR; PG8_MMA(1, 1, At, B1); PG8_BAR;
            PG8_LDB(B0, 1, 0); PG8_SCHED; PG8_LDA(At, 1, 0); PG8_STAGE(PG8_SA(0, 1), a2 + hstep, voffA);
            PG8_WAIT_L(8); PG8_BAR; PG8_WAIT_L(0); PG8_MMA(0, 0, At, B0); PG8_BAR; PG8_SCHED;
            PG8_LDB(B1, 1, 1); PG8_STAGE(PG8_SB(1, 0), b3, voffB);
            PG8_BAR; PG8_WAIT_L(0); PG8_MMA(0, 1, At, B1); PG8_BAR;
            PG8_LDA(At, 1, 1); PG8_STAGE(PG8_SA(1, 0), a3, voffA);
            PG8_BAR; PG8_WAIT_L(0); PG8_MMA(1, 0, At, B0); PG8_BAR; PG8_SCHED;
            PG8_STAGE(PG8_SB(1, 1), b3 + hstep, voffB);
            PG8_WAIT_V(6); PG8_BAR; PG8_MMA(1, 1, At, B1); PG8_BAR;
            }
        }
        if constexpr (ALIGN_EPI) { if (wr == 0) PG8_BAR; }
        bool keep_acc = false;
        if constexpr (Epi::TWOSEG) { if (cur.seg == 0) { E.mid(acc, cur, wr, wc, fr, fq); keep_acc = true; } else { E(acc, cur, wr, wc, fr, fq); } }
        else if constexpr (!Epi::AFTER_DRAIN) { E(acc, cur, wr, wc, fr, fq); S.done(cur); }
        if (!has_next) break;
        if (!keep_acc) {
#pragma unroll
        for (int a = 0; a < 2; ++a)
#pragma unroll
            for (int b = 0; b < 2; ++b)
#pragma unroll
                for (int m = 0; m < 4; ++m)
#pragma unroll
                    for (int n = 0; n < 2; ++n) acc[a][b][m][n] = (f32x4){0.f, 0.f, 0.f, 0.f};
        }
        cur = nxt; cA = nA; cB = nB; ++ui;
        if constexpr (ALIGN_EPI) { if (wr == 1) PG8_BAR; }
    }
    PG8_WAIT_V(0);
    if constexpr (!ALIGN_EPI) { if (wr == 0) PG8_BAR; }
    PG8_BAR;
    if constexpr (Epi::AFTER_DRAIN) { E.fused(acc, cur, wr, wc, fr, fq, lds, wid, lane); S.done(cur); }
#undef PG8_SA
#undef PG8_SB
#undef PG8_STAGE
#undef PG8_LDA
#undef PG8_LDB
#undef PG8_MMA
#undef PG8_WAIT_V
#undef PG8_WAIT_L
#undef PG8_BAR
#undef PG8_SCHED
}
}
using namespace pg8;
#define LAS __attribute__((address_space(3)))
typedef float f32x16 __attribute__((ext_vector_type(16)));
typedef unsigned u32x2 __attribute__((ext_vector_type(2)));

constexpr int D = 1024, MP = 16384, MS = 1024, M = MP + MS, FF = 2816, NIN = 1792, SEQ = 8192, MEMR = 512;
constexpr float EPS = 1e-6f, LOG2E = 1.4426950408889634f;
constexpr float C2S = 0.125f * LOG2E;
constexpr float C2X = 0.0625f * LOG2E;
constexpr size_t O_Y = 0, O_MK = (size_t)M * D, O_MV = O_MK + 524288, O_SKP = O_MV + 524288, O_SVP = O_SKP + 32768, O_CP = O_SVP + 32768,
                 O_HP = O_CP + 3072, O_SKS = O_HP + 1024, O_SVS = O_SKS + 2097152, O_CS = O_SVS + 2097152, O_HS = O_CS + 196608, O_END = O_HS + 65536;
constexpr size_t MiB = 1u << 20;
constexpr size_t WS_SS = 0, WS_ROPE = MiB / 2, WS_SUM = 3 * MiB, WS_WAB = 4 * MiB, WS_W1GU = 8 * MiB, WS_WCKV = 19 * MiB, WS_W1D = 23 * MiB, WS_WIN = 29 * MiB,
                 WS_WOUT = 33 * MiB, WS_WCQ = 35 * MiB, WS_WCO = 37 * MiB, WS_W2GU = 39 * MiB, WS_W2D = 50 * MiB, WS_XB = 56 * MiB, WS_H = 91 * MiB, WS_X = 185 * MiB,
                 WS_PROJ = 253 * MiB, WS_MIX = 313 * MiB, WS_QX = 347 * MiB, WS_XO = 381 * MiB, WS_END = 415 * MiB;
constexpr int ROPE_POS = 8200;
constexpr int RING_BYTES = 131072, MISC_OFF = RING_BYTES, LDS_BYTES = 147456;

__device__ __forceinline__ float bf2f(unsigned short b) { return __uint_as_float((unsigned)b << 16); }
__device__ __forceinline__ unsigned short f2bf(float f) { unsigned u = __float_as_uint(f); return (unsigned short)((u + 0x7fffu + ((u >> 16) & 1u)) >> 16); }
__device__ __forceinline__ unsigned pk2(float lo, float hi) { return (unsigned)f2bf(lo) | ((unsigned)f2bf(hi) << 16); }
__device__ __forceinline__ float rstd_of(float ss) { return rsqrtf(ss * (1.0f / 1024.0f) + EPS); }
__device__ __forceinline__ float fexp2(float x) { return __builtin_amdgcn_exp2f(x); }
__device__ __forceinline__ float sigmoidf_(float x) { return __builtin_amdgcn_rcpf(1.0f + fexp2(-x * LOG2E)); }
__device__ __forceinline__ float silu_mul(float g, float u) { return g * u * sigmoidf_(g); }
__device__ __forceinline__ float gelu_tanh(float x) { const float z = 0.7978845608028654f * (x + 0.044715f * x * x * x); return x * sigmoidf_(2.0f * z); }

__device__ __forceinline__ void st16(void* p, u32x4 v) { *(u32x4*)p = v; }
__device__ __forceinline__ void st8(void* p, u32x2 v) { *(u32x2*)p = v; }
struct EpiGU {
    static constexpr bool PERM = true, AFTER_DRAIN = false, MIDSCALE = false, TWOSEG = false;
    bf16_t* H; const float* ss;
    __device__ __forceinline__ void operator()(const f32x4 (&acc)[2][2][4][2], const Unit& u, int wr, int wc, int fr, int fq) const {
        const int row0 = u.pm * 256 + wr * 64 + fr, col0 = u.pn * 128 + wc * 32 + 8 * fq;
        float rsv[2][4];
#pragma unroll
        for (int ai = 0; ai < 2; ++ai)
#pragma unroll
            for (int m = 0; m < 4; ++m) rsv[ai][m] = ss[row0 + ai * 128 + m * 16];
#pragma unroll
        for (int ai = 0; ai < 2; ++ai)
#pragma unroll
            for (int m = 0; m < 4; ++m) {
                const int row = row0 + ai * 128 + m * 16; const float rs = rstd_of(rsv[ai][m]);
                const f32x4 g0 = acc[ai][0][m][0] * rs, g1 = acc[ai][0][m][1] * rs, u0 = acc[ai][1][m][0] * rs, u1 = acc[ai][1][m][1] * rs;
                u32x4 w;
                w.x = cvt_pk_bf16(silu_mul(g0[0], u0[0]), silu_mul(g0[1], u0[1])); w.y = cvt_pk_bf16(silu_mul(g0[2], u0[2]), silu_mul(g0[3], u0[3]));
                w.z = cvt_pk_bf16(silu_mul(g1[0], u1[0]), silu_mul(g1[1], u1[1])); w.w = cvt_pk_bf16(silu_mul(g1[2], u1[2]), silu_mul(g1[3], u1[3]));
                st16(H + (size_t)row * FF + col0, w);
            }
    }
};
template <bool ROWSCALE, bool F32BASE>
struct EpiRes {
    static constexpr bool PERM = true, AFTER_DRAIN = false, MIDSCALE = false, TWOSEG = false;
    const float* base_p; const float* base_s; bf16_t* XB; float* ss_out; float scale; const float* rowss;
    __device__ __forceinline__ void operator()(const f32x4 (&acc)[2][2][4][2], const Unit& u, int wr, int wc, int fr, int fq) const {
        const int row0 = u.pm * 256 + wr * 64 + fr, col0 = u.pn * 256 + wc * 32 + 8 * fq;
#pragma unroll
        for (int ai = 0; ai < 2; ++ai) {
            f32x4 bv[4][2][2]; float scv[4];
#pragma unroll
            for (int m = 0; m < 4; ++m) {
                const int row = row0 + ai * 128 + m * 16;
                scv[m] = ROWSCALE ? rowss[row] : 0.f;
                if (F32BASE) {
                    const float* b = row < MP ? base_p + (size_t)row * D : base_s + (size_t)(row - MP) * D;
#pragma unroll
                    for (int bj = 0; bj < 2; ++bj) { bv[m][bj][0] = *(const f32x4*)(b + col0 + bj * 128); bv[m][bj][1] = *(const f32x4*)(b + col0 + bj * 128 + 4); }
                } else {
#pragma unroll
                    for (int bj = 0; bj < 2; ++bj) {
                        const u32x4 w = *(const u32x4*)(XB + (size_t)row * D + col0 + bj * 128);
                        bv[m][bj][0] = (f32x4){__uint_as_float(w.x << 16), __uint_as_float(w.x & 0xffff0000u), __uint_as_float(w.y << 16), __uint_as_float(w.y & 0xffff0000u)};
                        bv[m][bj][1] = (f32x4){__uint_as_float(w.z << 16), __uint_as_float(w.z & 0xffff0000u), __uint_as_float(w.w << 16), __uint_as_float(w.w & 0xffff0000u)};
                    }
                }
            }
#pragma unroll
            for (int m = 0; m < 4; ++m) {
                const int row = row0 + ai * 128 + m * 16;
                const float sc = ROWSCALE ? rsqrtf(scv[m] * (1.0f / 512.0f) + EPS) : scale; float sq = 0.f;
#pragma unroll
                for (int bj = 0; bj < 2; ++bj) {
                    const int c = col0 + bj * 128;
                    const f32x4 v0 = bv[m][bj][0] + acc[ai][bj][m][0] * sc, v1 = bv[m][bj][1] + acc[ai][bj][m][1] * sc;
                    u32x4 w; w.x = cvt_pk_bf16(v0[0], v0[1]); w.y = cvt_pk_bf16(v0[2], v0[3]); w.z = cvt_pk_bf16(v1[0], v1[1]); w.w = cvt_pk_bf16(v1[2], v1[3]);
                    *(u32x4*)(XB + (size_t)row * D + c) = w;
                    sq += (v0[0] * v0[0] + v0[1] * v0[1]) + (v0[2] * v0[2] + v0[3] * v0[3]) + (v1[0] * v1[0] + v1[1] * v1[1]) + (v1[2] * v1[2] + v1[3] * v1[3]);
                }
                if (ss_out) { sq += __shfl_xor(sq, 16); sq += __shfl_xor(sq, 32); if (fq == 0) unsafeAtomicAdd(ss_out + row, sq); }
            }
        }
    }
};
struct EpiMix {
    static constexpr bool PERM = true, AFTER_DRAIN = false, MIDSCALE = false, TWOSEG = true;
    bf16_t* XB; float* ss_out; const float* ssl; const float* ssa;
    __device__ __forceinline__ void mid(f32x4 (&acc)[2][2][4][2], const Unit& u, int wr, int wc, int fr, int fq) const {
        const int row0 = u.pm * 256 + wr * 64 + fr;
        float sl[2][4], sa[2][4];
#pragma unroll
        for (int ai = 0; ai < 2; ++ai)
#pragma unroll
            for (int m = 0; m < 4; ++m) { sl[ai][m] = ssl[row0 + ai * 128 + m * 16]; sa[ai][m] = ssa[row0 + ai * 128 + m * 16]; }
#pragma unroll
        for (int ai = 0; ai < 2; ++ai)
#pragma unroll
            for (int m = 0; m < 4; ++m) {
                const float ratio = rsqrtf(sl[ai][m] * (1.0f / 512.0f) + EPS) * sqrtf(sa[ai][m] * (1.0f / 512.0f) + EPS);
#pragma unroll
                for (int bj = 0; bj < 2; ++bj)
#pragma unroll
                    for (int n = 0; n < 2; ++n) acc[ai][bj][m][n] = acc[ai][bj][m][n] * ratio;
            }
    }
    __device__ __forceinline__ void operator()(const f32x4 (&acc)[2][2][4][2], const Unit& u, int wr, int wc, int fr, int fq) const {
        const EpiRes<true, false> E{nullptr, nullptr, XB, ss_out, 1.0f, ssa};
        E(acc, u, wr, wc, fr, fq);
    }
};
struct StaticOrder2 {
    StaticOrder S;
    __host__ __device__ void init(int M, int N, int G_, int c_) { S.init(M, N, G_, c_); }
    __host__ __device__ bool next(int i, Unit& u) const { const bool ok = S.next(i >> 1, u); u.seg = i & 1; return ok; }
    __device__ __forceinline__ void a_ready(const Unit&) const {}
    __device__ __forceinline__ void done(const Unit&) const {}
};
struct EpiFinal {
    static constexpr bool PERM = true, AFTER_DRAIN = true, MIDSCALE = false, TWOSEG = false;
    const bf16_t* XB; float* ss; unsigned* cnt; const float* gfin; float* Y; float scale;
    __device__ __forceinline__ void fused(f32x4 (&acc)[2][2][4][2], const Unit& u, int wr, int wc, int fr, int fq, PG8_LAS unsigned char* lds, int wid, int lane) const {
        const int row0 = u.pm * 256 + wr * 64 + fr, col0 = u.pn * 256 + wc * 32 + 8 * fq;
#pragma unroll
        for (int ai = 0; ai < 2; ++ai) {
            u32x4 bw[4][2];
#pragma unroll
            for (int m = 0; m < 4; ++m)
#pragma unroll
                for (int bj = 0; bj < 2; ++bj) bw[m][bj] = __builtin_nontemporal_load((const u32x4*)(XB + (size_t)(row0 + ai * 128 + m * 16) * D + col0 + bj * 128));
#pragma unroll
            for (int m = 0; m < 4; ++m) {
                float sq = 0.f;
#pragma unroll
                for (int bj = 0; bj < 2; ++bj) {
                    const u32x4 w = bw[m][bj];
                    const f32x4 b0 = (f32x4){__uint_as_float(w.x << 16), __uint_as_float(w.x & 0xffff0000u), __uint_as_float(w.y << 16), __uint_as_float(w.y & 0xffff0000u)};
                    const f32x4 b1 = (f32x4){__uint_as_float(w.z << 16), __uint_as_float(w.z & 0xffff0000u), __uint_as_float(w.w << 16), __uint_as_float(w.w & 0xffff0000u)};
                    const f32x4 v0 = b0 + acc[ai][bj][m][0] * scale, v1 = b1 + acc[ai][bj][m][1] * scale;
                    acc[ai][bj][m][0] = v0; acc[ai][bj][m][1] = v1;
                    sq += (v0[0] * v0[0] + v0[1] * v0[1]) + (v0[2] * v0[2] + v0[3] * v0[3]) + (v1[0] * v1[0] + v1[1] * v1[1]) + (v1[2] * v1[2] + v1[3] * v1[3]);
                }
                sq += __shfl_xor(sq, 16); sq += __shfl_xor(sq, 32);
                if (fq == 0) unsafeAtomicAdd(ss + row0 + ai * 128 + m * 16, sq);
            }
        }
        asm volatile("s_waitcnt vmcnt(0)" ::: "memory");
        __syncthreads();
        if (threadIdx.x == 0) {
            unsigned* c = cnt + 64 * u.pm;
            __hip_atomic_fetch_add(c, 1u, __ATOMIC_RELAXED, __HIP_MEMORY_SCOPE_AGENT);
            unsigned sp = 0u;
            while (__hip_atomic_load(c, __ATOMIC_RELAXED, __HIP_MEMORY_SCOPE_AGENT) < 4u) { __builtin_amdgcn_s_sleep(2); if (++sp > (1u << 20)) break; }
        }
        __syncthreads();
        PG8_LAS float* S = (PG8_LAS float*)lds;
        if (threadIdx.x < 256) S[threadIdx.x] = rstd_of(unsafeAtomicAdd(ss + u.pm * 256 + (int)threadIdx.x, 0.0f));
        __syncthreads();
#pragma unroll
        for (int ai = 0; ai < 2; ++ai)
#pragma unroll
            for (int m = 0; m < 4; ++m) {
                const int rl = ai * 128 + wr * 64 + m * 16 + fr; const float rs = S[rl];
                float* yrow = Y + (size_t)(u.pm * 256 + rl) * D;
#pragma unroll
                for (int bj = 0; bj < 2; ++bj) {
                    const int c = col0 + bj * 128;
                    const f32x4 g0 = *(const f32x4*)(gfin + c), g1 = *(const f32x4*)(gfin + c + 4);
                    __builtin_nontemporal_store(acc[ai][bj][m][0] * rs * g0, (f32x4*)(yrow + c)); __builtin_nontemporal_store(acc[ai][bj][m][1] * rs * g1, (f32x4*)(yrow + c + 4));
                }
            }
        __syncthreads();
    }
};
struct EpiRowBf16 {
    static constexpr bool PERM = true, AFTER_DRAIN = false, MIDSCALE = false, TWOSEG = false;
    bf16_t* O; int ldc; const float* ss; float cst;
    __device__ __forceinline__ void operator()(const f32x4 (&acc)[2][2][4][2], const Unit& u, int wr, int wc, int fr, int fq) const {
        const int row0 = u.pm * 256 + wr * 64 + fr, col0 = u.pn * 256 + wc * 32 + 8 * fq;
        float rsv[2][4];
#pragma unroll
        for (int ai = 0; ai < 2; ++ai)
#pragma unroll
            for (int m = 0; m < 4; ++m) rsv[ai][m] = ss[row0 + ai * 128 + m * 16];
#pragma unroll
        for (int ai = 0; ai < 2; ++ai)
#pragma unroll
            for (int m = 0; m < 4; ++m) {
                const int row = row0 + ai * 128 + m * 16; const float rs = rstd_of(rsv[ai][m]) * cst;
#pragma unroll
                for (int bj = 0; bj < 2; ++bj) {
                    const f32x4 v0 = acc[ai][bj][m][0] * rs, v1 = acc[ai][bj][m][1] * rs;
                    u32x4 w; w.x = cvt_pk_bf16(v0[0], v0[1]); w.y = cvt_pk_bf16(v0[2], v0[3]); w.z = cvt_pk_bf16(v1[0], v1[1]); w.w = cvt_pk_bf16(v1[2], v1[3]);
                    st16(O + (size_t)row * ldc + col0 + bj * 128, w);
                }
            }
    }
};
struct EpiMemKV {
    static constexpr bool PERM = true, AFTER_DRAIN = false, MIDSCALE = false, TWOSEG = false;
    float* out;
    __device__ __forceinline__ void operator()(const f32x4 (&acc)[2][2][4][2], const Unit& u, int wr, int wc, int fr, int fq) const {
        const int row0 = u.pm * 256 + wr * 64 + fr, col0 = u.pn * 256 + wc * 32 + 8 * fq;
#pragma unroll
        for (int ai = 0; ai < 2; ++ai)
#pragma unroll
            for (int m = 0; m < 4; ++m) {
                const int row = row0 + ai * 128 + m * 16;
#pragma unroll
                for (int bj = 0; bj < 2; ++bj) {
                    const int c = col0 + bj * 128;
                    float* dst = out + (c < 1024 ? O_MK : O_MV) + (size_t)row * 1024 + (c & 1023);
                    *(f32x4*)dst = acc[ai][bj][m][0]; *(f32x4*)(dst + 4) = acc[ai][bj][m][1];
                }
            }
    }
};
struct EpiIn {
    static constexpr bool PERM = true, AFTER_DRAIN = false, MIDSCALE = false, TWOSEG = false;
    bf16_t* P; const float* ss; const float* rope; float* out;
    __device__ __forceinline__ void operator()(const f32x4 (&acc)[2][2][4][2], const Unit& u, int wr, int wc, int fr, int fq) const {
        const int row0 = u.pm * 256 + wr * 64 + fr; const int pn = u.pn;
        const int ip = (wc & 1) * 4 + fq, hl = wc >> 1;
        float rsv[2][4];
#pragma unroll
        for (int ai = 0; ai < 2; ++ai)
#pragma unroll
            for (int m = 0; m < 4; ++m) rsv[ai][m] = ss[row0 + ai * 128 + m * 16];
#pragma unroll
        for (int ai = 0; ai < 2; ++ai) {
            f32x4 csv[4][2];
            if (pn >= 4) {
#pragma unroll
                for (int m = 0; m < 4; ++m) {
                    const int row = row0 + ai * 128 + m * 16;
                    const bool smp = row >= MP; const int pos = smp ? SEQ + ((row - MP) & 7) : (row & (SEQ - 1));
                    const float* rp = rope + ((size_t)pos * 32 + 4 * ip) * 2; csv[m][0] = *(const f32x4*)rp; csv[m][1] = *(const f32x4*)(rp + 4);
                }
            }
#pragma unroll
            for (int m = 0; m < 4; ++m) {
                const int row = row0 + ai * 128 + m * 16; const float rs = rstd_of(rsv[ai][m]);
                const bool smp = row >= MP; const int t = smp ? ((row - MP) & 7) : (row & (SEQ - 1)); const int sq = smp ? ((row - MP) >> 3) : (row >> 13);
                bf16_t* prow = P + (size_t)row * NIN;
                if (pn < 4) {
#pragma unroll
                    for (int bj = 0; bj < 2; ++bj) {
                        const int c = pn * 256 + bj * 128 + wc * 32 + 8 * fq;
                        const f32x4 v0 = acc[ai][bj][m][0] * rs, v1 = acc[ai][bj][m][1] * rs;
                        u32x4 w; w.x = cvt_pk_bf16(v0[0], v0[1]); w.y = cvt_pk_bf16(v0[2], v0[3]); w.z = cvt_pk_bf16(v1[0], v1[1]); w.w = cvt_pk_bf16(v1[2], v1[3]);
                        st16(prow + c, w);
                        if (pn < 2) {
                            float* dst = nullptr;
                            if (!smp && t >= SEQ - 3) dst = out + O_CP + ((size_t)sq * 3 + (t - (SEQ - 3))) * 512 + c;
                            else if (smp && t >= 5) dst = out + O_CS + ((size_t)sq * 3 + (t - 5)) * 512 + c;
                            if (dst) { *(f32x4*)dst = v0; *(f32x4*)(dst + 4) = v1; }
                        }
                    }
                } else {
                    const f32x4 cs0 = csv[m][0], cs1 = csv[m][1];
#pragma unroll
                    for (int bj = 0; bj < 2; ++bj) {
                        const bool isv = (pn == 6 && bj == 1);
                        if (!isv) {
                            const f32x4 z1 = acc[ai][bj][m][0] * rs, z2 = acc[ai][bj][m][1] * rs;
                            f32x4 o1, o2;
                            o1[0] = z1[0] * cs0[0] - z2[0] * cs0[1]; o2[0] = z2[0] * cs0[0] + z1[0] * cs0[1];
                            o1[1] = z1[1] * cs0[2] - z2[1] * cs0[3]; o2[1] = z2[1] * cs0[2] + z1[1] * cs0[3];
                            o1[2] = z1[2] * cs1[0] - z2[2] * cs1[1]; o2[2] = z2[2] * cs1[0] + z1[2] * cs1[1];
                            o1[3] = z1[3] * cs1[2] - z2[3] * cs1[3]; o2[3] = z2[3] * cs1[2] + z1[3] * cs1[3];
                            if (pn < 6) {
                                const int head = (pn - 4) * 4 + bj * 2 + hl; o1 = o1 * C2S; o2 = o2 * C2S;
                                bf16_t* d = prow + 1024 + head * 64 + 4 * ip;
                                u32x2 a; a.x = cvt_pk_bf16(o1[0], o1[1]); a.y = cvt_pk_bf16(o1[2], o1[3]); st8(d, a);
                                u32x2 b; b.x = cvt_pk_bf16(o2[0], o2[1]); b.y = cvt_pk_bf16(o2[2], o2[3]); st8(d + 32, b);
                            } else {
                                const int head = hl;
                                bf16_t* d = prow + 1536 + head * 64 + 4 * ip;
                                u32x2 a; a.x = cvt_pk_bf16(o1[0], o1[1]); a.y = cvt_pk_bf16(o1[2], o1[3]); st8(d, a);
                                u32x2 b; b.x = cvt_pk_bf16(o2[0], o2[1]); b.y = cvt_pk_bf16(o2[2], o2[3]); st8(d + 32, b);
                                float* dst = nullptr;
                                if (!smp && t >= SEQ - 128) dst = out + O_SKP + ((size_t)sq * 128 + (t - (SEQ - 128))) * 128 + head * 64 + 4 * ip;
                                else if (smp) dst = out + O_SKS + ((size_t)sq * 128 + 120 + t) * 128 + head * 64 + 4 * ip;
                                if (dst) { *(f32x4*)dst = o1; *(f32x4*)(dst + 32) = o2; }
                            }
                        } else {
                            const int cv = wc * 32 + 8 * fq;
                            const f32x4 v0 = acc[ai][bj][m][0] * rs, v1 = acc[ai][bj][m][1] * rs;
                            u32x4 w; w.x = cvt_pk_bf16(v0[0], v0[1]); w.y = cvt_pk_bf16(v0[2], v0[3]); w.z = cvt_pk_bf16(v1[0], v1[1]); w.w = cvt_pk_bf16(v1[2], v1[3]);
                            st16(prow + 1664 + cv, w);
                            float* dst = nullptr;
                            if (!smp && t >= SEQ - 128) dst = out + O_SVP + ((size_t)sq * 128 + (t - (SEQ - 128))) * 128 + cv;
                            else if (smp) dst = out + O_SVS + ((size_t)sq * 128 + 120 + t) * 128 + cv;
                            if (dst) { *(f32x4*)dst = v0; *(f32x4*)(dst + 4) = v1; }
                        }
                    }
                }
            }
        }
    }
};

struct Args { const float* in[37]; float* out; unsigned char* ws; double inv_rev[32]; int use_cg; int pad; };
struct Ctx {
    LAS unsigned char* lds; int tid, lane, wave, G, bid;
    const float* const* in; float* out; unsigned char* ws;
    float* SS; float* ROPE; float* SUMA; float* SUMB; bf16_t* WAB; bf16_t* XB; bf16_t* H; float* X; bf16_t* PROJ; bf16_t* MIX; bf16_t* QX; bf16_t* XO;
};
__device__ __forceinline__ float wave_sum(float v) {
#pragma unroll
    for (int o = 1; o < 64; o <<= 1) v += __shfl_xor(v, o);
    return v;
}
__device__ __forceinline__ int dst_row_of(int mode, int row_off, int n) {
    if (mode == 0) return row_off + n;
    if (mode == 1) return (n >> 7) * 256 + row_off + (n & 127);
    if (n < 1024 || n >= 1664) return n;
    const int hb = (n - 1024) >> 6, dd = (n - 1024) & 63, nn = dd >> 5, rem = dd & 31, i = rem >> 2, e = rem & 3;
    return 1024 + hb * 64 + 8 * i + 4 * nn + e;
}
struct P0Item { const float* W; bf16_t* WT; const float* g0; int K, N, mode, row_off, r; };
__device__ __forceinline__ P0Item p0_item(Ctx& F, int it) {
    unsigned char* ws = F.ws;
    constexpr int I_GU = 16 * 88, I_DN = 44 * 32, I_IN = 16 * 56, I_SQ = 16 * 32;
    static_assert(I_GU == I_DN, "");
    int r = it; P0Item d;
    if (r < I_GU) { d = P0Item{F.in[10], (bf16_t*)(ws + WS_W1GU), F.in[9], D, FF, 1, 0, r}; return d; } r -= I_GU;
    if (r < I_GU) { d = P0Item{F.in[11], (bf16_t*)(ws + WS_W1GU), F.in[9], D, FF, 1, 128, r}; return d; } r -= I_GU;
    if (r < I_DN) { d = P0Item{F.in[12], (bf16_t*)(ws + WS_W1D), nullptr, FF, D, 0, 0, r}; return d; } r -= I_DN;
    if (r < I_GU) { d = P0Item{F.in[33], (bf16_t*)(ws + WS_W2GU), F.in[32], D, FF, 1, 0, r}; return d; } r -= I_GU;
    if (r < I_GU) { d = P0Item{F.in[34], (bf16_t*)(ws + WS_W2GU), F.in[32], D, FF, 1, 128, r}; return d; } r -= I_GU;
    if (r < I_DN) { d = P0Item{F.in[35], (bf16_t*)(ws + WS_W2D), nullptr, FF, D, 0, 0, r}; return d; } r -= I_DN;
    if (r < I_IN) { d = P0Item{F.in[14], (bf16_t*)(ws + WS_WIN), F.in[13], D, NIN, 2, 0, r}; return d; } r -= I_IN;
    if (r < I_SQ / 2) { d = P0Item{F.in[25], (bf16_t*)(ws + WS_WOUT), F.in[23], 512, D, 0, 0, r}; return d; } r -= I_SQ / 2;
    if (r < I_SQ / 2) { d = P0Item{F.in[25] + 512 * 1024, (bf16_t*)(ws + WS_WOUT + MiB), F.in[24], 512, D, 0, 0, r}; return d; } r -= I_SQ / 2;
    if (r < I_SQ) { d = P0Item{F.in[28], (bf16_t*)(ws + WS_WCQ), F.in[26], D, D, 0, 0, r}; return d; } r -= I_SQ;
    if (r < I_SQ) { d = P0Item{F.in[29], (bf16_t*)(ws + WS_WCKV), nullptr, D, D, 0, 0, r}; return d; } r -= I_SQ;
    if (r < I_SQ) { d = P0Item{F.in[30], (bf16_t*)(ws + WS_WCKV), nullptr, D, D, 0, 1024, r}; return d; } r -= I_SQ;
    d = P0Item{F.in[31], (bf16_t*)(ws + WS_WCO), nullptr, D, D, 0, 0, r}; return d;
}
__device__ __forceinline__ void p0_load_item(const P0Item& d, float (&v)[32], int lane) {
    const int nblk = d.N / 32, kb = d.r / nblk, nb = d.r % nblk, k0 = 64 * kb, n0 = 32 * nb;
#pragma unroll
    for (int i = 0; i < 32; ++i) { const int k = k0 + 2 * i + (lane >> 5); v[i] = __builtin_nontemporal_load(d.W + (size_t)k * d.N + n0 + (lane & 31)) * (d.g0 ? d.g0[k] : 1.0f); }
}
__device__ __forceinline__ void p0_store_item(const P0Item& d, const float (&v)[32], LAS float* scr, int lane) {
    const int nblk = d.N / 32, kb = d.r / nblk, nb = d.r % nblk, k0 = 64 * kb, n0 = 32 * nb;
#pragma unroll
    for (int i = 0; i < 32; ++i) scr[(2 * i + (lane >> 5)) * 33 + (lane & 31)] = v[i];
    asm volatile("s_waitcnt lgkmcnt(0)" ::: "memory");
    const int c = lane & 7;
#pragma unroll
    for (int j = 0; j < 4; ++j) {
        const int n = (lane >> 3) + 8 * j; const LAS float* s = scr + (8 * c) * 33 + n;
        u32x4 o; o.x = cvt_pk_bf16(s[0 * 33], s[1 * 33]); o.y = cvt_pk_bf16(s[2 * 33], s[3 * 33]); o.z = cvt_pk_bf16(s[4 * 33], s[5 * 33]); o.w = cvt_pk_bf16(s[6 * 33], s[7 * 33]);
        *(u32x4*)(d.WT + (size_t)dst_row_of(d.mode, d.row_off, n0 + n) * d.K + k0 + 8 * c) = o;
    }
    asm volatile("s_waitcnt lgkmcnt(0)" ::: "memory");
}
__device__ __forceinline__ void p0_prologue(Ctx& F, const double* inv_rev) {
    LAS float* scr = (LAS float*)(F.lds + F.wave * 16384);
    const int gw = F.bid * 8 + F.wave, NGW = F.G * 8;
    constexpr int NITEMS = 6 * 1408 + 896 + 5 * 512;
#ifndef DUP_P0A
#define DUP_P0A 0
#endif
#ifndef DUP_P0B
#define DUP_P0B 0
#endif
#ifndef DUP_P0C
#define DUP_P0C 0
#endif
    for (int rp_ = 0; rp_ <= DUP_P0A; ++rp_) {
        float cur[32]; int it = gw;
        if (it < NITEMS) { const P0Item d = p0_item(F, it); p0_load_item(d, cur, F.lane); }
        for (; it < NITEMS; it += NGW) {
            float nxt[32]; const bool more = it + NGW < NITEMS;
            if (more) { const P0Item dn = p0_item(F, it + NGW); p0_load_item(dn, nxt, F.lane); }
            const P0Item d = p0_item(F, it);
            p0_store_item(d, cur, scr, F.lane);
            if (more) {
#pragma unroll
                for (int i = 0; i < 32; ++i) cur[i] = nxt[i];
            }
        }
    }
    for (int rp_ = 0; rp_ <= DUP_P0B; ++rp_)
    for (int mb = gw; mb < M + MEMR; mb += 4 * NGW) {
        f32x4 v[4][4]; float s[4];
#pragma unroll
        for (int r = 0; r < 4; ++r) {
            const int m = mb + r * NGW; s[r] = 0.f;
            if (m < M + MEMR) {
                const float* src = m < MP ? F.in[0] + (size_t)m * D : (m < M ? F.in[1] + (size_t)(m - MP) * D : F.in[2] + (size_t)(m - M) * D);
                const f32x4* xr = (const f32x4*)src + F.lane;
#pragma unroll
                for (int j = 0; j < 4; ++j) v[r][j] = __builtin_nontemporal_load(xr + 64 * j);
            }
        }
#pragma unroll
        for (int r = 0; r < 4; ++r) {
            const int m = mb + r * NGW;
            if (m < M + MEMR) {
#pragma unroll
                for (int j = 0; j < 4; ++j) s[r] += (v[r][j][0] * v[r][j][0] + v[r][j][1] * v[r][j][1]) + (v[r][j][2] * v[r][j][2] + v[r][j][3] * v[r][j][3]);
                s[r] = wave_sum(s[r]);
                if (m < M) { if (F.lane == 0) F.SS[m] = s[r]; }
                else { const float rs = rstd_of(s[r]); const f32x4* gr = (const f32x4*)F.in[27] + F.lane;
#pragma unroll
                    for (int j = 0; j < 4; ++j) v[r][j] = v[r][j] * rs * gr[64 * j]; }
                u32x2* o8 = (u32x2*)(F.XB + (size_t)m * D) + F.lane;
#pragma unroll
                for (int j = 0; j < 4; ++j) { u32x2 w; w.x = pk2(v[r][j][0], v[r][j][1]); w.y = pk2(v[r][j][2], v[r][j][3]); o8[64 * j] = w; }
            }
        }
    }
    const int gt = F.bid * 512 + F.tid, NGT = F.G * 512;
    for (int rp_ = 0; rp_ <= DUP_P0C; ++rp_) {
    for (int i = gt; i < 6 * M; i += NGT) F.SS[M + i] = 0.f;
    for (int i = gt; i < ROPE_POS * 32; i += NGT) {
        const int pos = i >> 5, fi = i & 31; const double rev = (double)pos * inv_rev[fi]; const float fr = (float)(rev - floor(rev));
        F.ROPE[2 * i] = __builtin_amdgcn_cosf(fr); F.ROPE[2 * i + 1] = __builtin_amdgcn_sinf(fr);
    }
    {
        f32x4 ck[4], cv[4];
#pragma unroll
        for (int u = 0; u < 4; ++u) { const int i = gt + u * NGT; if (i < 128 * 3840) { const int n = i / 3840, r = i % 3840;
            ck[u] = __builtin_nontemporal_load((const f32x4*)(F.in[5] + (size_t)n * 16384 + 1024) + r); cv[u] = __builtin_nontemporal_load((const f32x4*)(F.in[6] + (size_t)n * 16384 + 1024) + r); } }
#pragma unroll
        for (int u = 0; u < 4; ++u) { const int i = gt + u * NGT; if (i < 128 * 3840) { const int n = i / 3840, r = i % 3840;
            __builtin_nontemporal_store(ck[u], (f32x4*)(F.out + O_SKS + (size_t)n * 16384) + r); __builtin_nontemporal_store(cv[u], (f32x4*)(F.out + O_SVS + (size_t)n * 16384) + r); } }
    }
    for (int i = gt; i < 2 * 8 * 64 * 64; i += NGT) {
        const int k = i & 63, n = (i >> 6) & 63, g = (i >> 12) & 7, mat = i >> 15;
        F.WAB[i] = f2bf((mat ? F.in[19] : F.in[17])[((size_t)g * 64 + k) * 64 + n]);
    }
    }
}
#define XB_TMO      128
#define XB_XCNT(j)  (256  + 64 * (j))
#define XB_XSUB(j)  (1280 + 64 * (j))
#define XB_XGEN(j)  (2304 + 64 * (j))
#define XB_TOP      3328
#define XB_TOPGEN   3392
#define XCD_BAR_WORDS 3456
#define XB_SPIN_CAP (1u << 18)

__device__ __forceinline__ unsigned xb_ld(unsigned* p)              { return __hip_atomic_load(p, __ATOMIC_RELAXED, __HIP_MEMORY_SCOPE_AGENT); }
__device__ __forceinline__ unsigned xb_add(unsigned* p, unsigned v) { return __hip_atomic_fetch_add(p, v, __ATOMIC_RELAXED, __HIP_MEMORY_SCOPE_AGENT); }
__device__ __forceinline__ unsigned xb_xcc_id() { return (unsigned)__builtin_amdgcn_s_getreg((3 << 11) | 20) & 0xFu; }
#define XB_SPIN(cond, bar) do { unsigned _sp = 0; while (cond) { __builtin_amdgcn_s_sleep(1); \
    if ((++_sp & 255u) == 0u) { if (xb_ld(&(bar)[XB_TMO])) break; if (_sp > XB_SPIN_CAP) { atomicAdd(&(bar)[XB_TMO], 1u); break; } } } } while (0)

struct XcdBarrier {
    unsigned* bar; unsigned x;
    volatile LAS unsigned* st;
};

__device__ __forceinline__ XcdBarrier xcd_barrier_post(unsigned* bar, volatile LAS unsigned* st) {
    XcdBarrier b; b.bar = bar; b.x = xb_xcc_id(); b.st = st;
    if (threadIdx.x == 0) (void)xb_add(&bar[XB_XCNT(b.x)], 1u);
    return b;
}
__device__ __forceinline__ void xcd_barrier_complete(unsigned* bar, unsigned x, unsigned& nloc, unsigned& nx) {
    const unsigned G = gridDim.x * gridDim.y * gridDim.z;
    unsigned sum, cnt, mine, sp = 0u;
    for (;;) {
        sum = 0u; cnt = 0u; mine = 0u;
#pragma unroll
        for (unsigned j = 0; j < 16; ++j) { const unsigned c = xb_ld(&bar[XB_XCNT(j)]); sum += c; cnt += (c > 0u) ? 1u : 0u; mine = (j == x) ? c : mine; }
        if (sum == G) break;
        __builtin_amdgcn_s_sleep(1);
        if ((++sp & 255u) == 0u) { if (xb_ld(&bar[XB_TMO])) break; if (sp > XB_SPIN_CAP) { atomicAdd(&bar[XB_TMO], 1u); break; } }
    }
    nloc = mine > 0u ? mine : 1u; nx = cnt > 0u ? cnt : 1u;
}

__device__ __forceinline__ void xcd_barrier(const XcdBarrier& b) {
    asm volatile("s_waitcnt vmcnt(0)" ::: "memory");
    __syncthreads();
    if (threadIdx.x == 0) {
        unsigned* bar = b.bar;
        __builtin_amdgcn_s_waitcnt(0);
        unsigned nloc = b.st[0], nx = b.st[1];
        if (nloc == 0u) { xcd_barrier_complete(bar, b.x, nloc, nx); b.st[0] = nloc; b.st[1] = nx; }
        const unsigned old = xb_add(&bar[XB_XSUB(b.x)], 1u);
        const unsigned gen = old / nloc;
        if (old + 1u == (gen + 1u) * nloc) {
            __builtin_amdgcn_fence(__ATOMIC_RELEASE, "agent");
            asm volatile("s_waitcnt vmcnt(0)" ::: "memory");
            const unsigned og = xb_add(&bar[XB_TOP], 1u);
            const unsigned tg = og / nx;
            if (og + 1u == (tg + 1u) * nx) xb_add(&bar[XB_TOPGEN], 1u);
            else XB_SPIN(xb_ld(&bar[XB_TOPGEN]) == tg, bar);
            __builtin_amdgcn_fence(__ATOMIC_ACQUIRE, "agent");
            xb_add(&bar[XB_XGEN(b.x)], 1u);
            asm volatile("s_waitcnt vmcnt(0)" ::: "memory");
        } else {
            XB_SPIN(xb_ld(&bar[XB_XGEN(b.x)]) == gen, bar);
            __builtin_amdgcn_fence(__ATOMIC_ACQUIRE, "agent");
            asm volatile("s_waitcnt vmcnt(0)" ::: "memory");
        }
    }
    __syncthreads();
}

template <bool SAMPLE, int PASS, int NH>
__device__ __forceinline__ void lru_tile(Ctx& F, int m0, int bn  , int k  , float* ssl) {
    const int g = F.wave, lane = F.lane, c = g * 64 + lane;
    LAS unsigned char* ldsw = F.lds + g * 16384;
    const float* conv_w = F.in[15]; const float cw0 = conv_w[c], cw1 = conv_w[512 + c], cw2 = conv_w[1024 + c], cw3 = conv_w[1536 + c], cb = F.in[16][c];
    const float ba = F.in[18][c], bi = F.in[20][c], lamv = F.in[21][c];
    const float sp8 = 8.0f * (fmaxf(-lamv, 0.f) + log1pf(__expf(-fabsf(lamv))));
    const bf16_t* Pu = F.PROJ + (size_t)m0 * NIN + c;
    const float* scv = F.in[7] + (size_t)bn * 1536 + c;
    float x0 = 0.f, x1 = 0.f, x2 = 0.f;
    if (!SAMPLE && k > 0) { x0 = bf2f(Pu[-3 * NIN]); x1 = bf2f(Pu[-2 * NIN]); x2 = bf2f(Pu[-NIN]); }
    float h = 0.f, Ap = 1.f;
    if (!SAMPLE && PASS == 2 && k > 0) {
        const float* sa = F.SUMA + (size_t)bn * 128 * 512 + c; const float* sb = F.SUMB + (size_t)bn * 128 * 512 + c;
        const int kq = (k + 3) >> 2;
        float qa[4] = {1.f, 1.f, 1.f, 1.f}, qb[4] = {0.f, 0.f, 0.f, 0.f};
#pragma unroll 4
        for (int j = 0; j < kq; ++j) {
#pragma unroll
            for (int q = 0; q < 4; ++q) { const int jj = q * kq + j; if (jj < k) { const float a = sa[(size_t)jj * 512], b = sb[(size_t)jj * 512]; qa[q] *= a; qb[q] = a * qb[q] + b; } }
        }
#pragma unroll
        for (int q = 0; q < 4; ++q) h = qa[q] * h + qb[q];
    }
    LAS float* pre_r = (LAS float*)ldsw; LAS float* pre_i = pre_r + 2048;
#pragma unroll 1
    for (int half = 0; half < NH; ++half) {
        unsigned short uu[32], gg[32]; float st[4][3], hs[4];
        {
            const bf16_t* rp = F.PROJ + ((size_t)(m0 + 32 * half) * NIN + g * 64) + (size_t)(lane >> 3) * NIN + (lane & 7) * 8;
            u32x4 wu[4], wg[4];
#pragma unroll
            for (int i = 0; i < 4; ++i) { wu[i] = (PASS == 2) ? __builtin_nontemporal_load((const u32x4*)(rp + (size_t)(8 * i) * NIN)) : *(const u32x4*)(rp + (size_t)(8 * i) * NIN); if (PASS == 2) wg[i] = __builtin_nontemporal_load((const u32x4*)(rp + (size_t)(8 * i) * NIN + 512)); }
            LAS bf16_t* ut = (LAS bf16_t*)ldsw; LAS bf16_t* gt = ut + 2048;
#pragma unroll
            for (int i = 0; i < 4; ++i) { *(LAS u32x4*)(ut + ((lane >> 3) + 8 * i) * 64 + (lane & 7) * 8) = wu[i]; if (PASS == 2) *(LAS u32x4*)(gt + ((lane >> 3) + 8 * i) * 64 + (lane & 7) * 8) = wg[i]; }
            asm volatile("s_waitcnt lgkmcnt(0)" ::: "memory");
#pragma unroll
            for (int j = 0; j < 32; ++j) { uu[j] = ut[j * 64 + lane]; gg[j] = (PASS == 2) ? gt[j * 64 + lane] : (unsigned short)0; }
            asm volatile("s_waitcnt lgkmcnt(0)" ::: "memory");
        }
        if (SAMPLE) {
#pragma unroll
            for (int sq = 0; sq < 4; ++sq) { const float* sc = scv + (size_t)(4 * half + sq) * 1536; st[sq][0] = sc[0]; st[sq][1] = sc[512]; st[sq][2] = sc[1024]; hs[sq] = F.in[8][(size_t)(bn + 4 * half + sq) * 512 + c]; }
        }
        {
            LAS bf16_t* convb = (LAS bf16_t*)(ldsw + 8192); float xa = x0, xb = x1, xc = x2;
#pragma unroll
            for (int j = 0; j < 32; ++j) {
                if (SAMPLE && (j & 7) == 0) { xa = st[j >> 3][0]; xb = st[j >> 3][1]; xc = st[j >> 3][2]; }
                const float xi = bf2f(uu[j]);
                const float cv = (((cb + cw0 * xa) + cw1 * xb) + cw2 * xc) + cw3 * xi; xa = xb; xb = xc; xc = xi;
                convb[j * 72 + lane] = (unsigned short)cvt_pk_bf16(cv, cv);
            }
        }
        asm volatile("s_waitcnt lgkmcnt(0)" ::: "memory");
        bf16x8 Af[2][2];
        {
            const LAS bf16_t* convb = (const LAS bf16_t*)(ldsw + 8192);
#pragma unroll
            for (int tt = 0; tt < 2; ++tt)
#pragma unroll
                for (int ks = 0; ks < 2; ++ks) Af[tt][ks] = *(const LAS bf16x8*)(convb + (16 * tt + (lane & 15)) * 72 + 32 * ks + 8 * (lane >> 4));
        }
        asm volatile("s_waitcnt lgkmcnt(0)" ::: "memory");
#pragma unroll
        for (int nt = 0; nt < 4; ++nt) {
            const bf16_t* wa = F.WAB + ((size_t)g * 64 + 16 * nt + (lane & 15)) * 64 + 8 * (lane >> 4); const bf16_t* wi = wa + 8 * 64 * 64;
            const bf16x8 Ba0 = *(const bf16x8*)wa, Ba1 = *(const bf16x8*)(wa + 32), Bi0 = *(const bf16x8*)wi, Bi1 = *(const bf16x8*)(wi + 32);
#pragma unroll
            for (int tt2 = 0; tt2 < 2; ++tt2) {
                f32x4 ar = (f32x4){0.f, 0.f, 0.f, 0.f}, ai = ar;
                ar = __builtin_amdgcn_mfma_f32_16x16x32_bf16(Af[tt2][0], Ba0, ar, 0, 0, 0); ar = __builtin_amdgcn_mfma_f32_16x16x32_bf16(Af[tt2][1], Ba1, ar, 0, 0, 0);
                ai = __builtin_amdgcn_mfma_f32_16x16x32_bf16(Af[tt2][0], Bi0, ai, 0, 0, 0); ai = __builtin_amdgcn_mfma_f32_16x16x32_bf16(Af[tt2][1], Bi1, ai, 0, 0, 0);
                const int nn = (16 * nt + (lane & 15)) ^ (((lane >> 4) & 1) << 4);
#pragma unroll
                for (int j = 0; j < 4; ++j) { const int il = 16 * tt2 + 4 * (lane >> 4) + j; pre_r[il * 64 + nn] = ar[j]; pre_i[il * 64 + nn] = ai[j]; }
            }
        }
        asm volatile("s_waitcnt lgkmcnt(0)" ::: "memory");
#pragma unroll
        for (int il = 0; il < 32; il += 2) {
            typedef float v2f __attribute__((ext_vector_type(2)));
            const int i = 32 * half + il; const int nn = lane ^ (((il >> 2) & 1) << 4);
            if (SAMPLE && (il & 7) == 0) { x0 = st[il >> 3][0]; x1 = st[il >> 3][1]; x2 = st[il >> 3][2]; h = hs[il >> 3]; }
            const float xa = bf2f(uu[il]), xb = bf2f(uu[il + 1]);
            v2f cv = (v2f){cb, cb} + (v2f){x0, x1} * cw0; cv = cv + (v2f){x1, x2} * cw1; cv = cv + (v2f){x2, xa} * cw2; cv = cv + (v2f){xa, xb} * cw3;
            x0 = x2; x1 = xa; x2 = xb;
            const v2f tr = ((v2f){pre_r[il * 64 + nn], pre_r[(il + 1) * 64 + nn]} + ba) * (-LOG2E), ti = ((v2f){pre_i[il * 64 + nn], pre_i[(il + 1) * 64 + nn]} + bi) * (-LOG2E);
            const v2f r = (v2f){__builtin_amdgcn_rcpf(1.0f + fexp2(tr.x)), __builtin_amdgcn_rcpf(1.0f + fexp2(tr.y))};
            const v2f gi = (v2f){__builtin_amdgcn_rcpf(1.0f + fexp2(ti.x)), __builtin_amdgcn_rcpf(1.0f + fexp2(ti.y))};
            const v2f la = r * (-sp8), al = la * LOG2E, xx = la * 2.0f;
            const v2f a = (v2f){fexp2(al.x), fexp2(al.y)};
            const v2f ser = -xx * (1.0f + xx * 0.5f * (1.0f + xx * (1.0f / 3.0f) * (1.0f + xx * 0.25f * (1.0f + xx * 0.2f * (1.0f + xx * (1.0f / 6.0f))))));
            const v2f alt = 1.0f - a * a;
            const float om0 = xx.x > -0.25f ? ser.x : alt.x, om1 = xx.y > -0.25f ? ser.y : alt.y;
            const v2f sq = (v2f){__builtin_amdgcn_sqrtf(fmaxf(om0, 0.f)), __builtin_amdgcn_sqrtf(fmaxf(om1, 0.f))};
            const v2f bb = sq * (gi * cv);
            const float h0 = a.x * h + bb.x, h1 = a.y * h0 + bb.y; h = h1;
            if (PASS == 1) Ap *= a.x * a.y;
            if (PASS == 2) {
                const v2f g2 = (v2f){bf2f(gg[il]), bf2f(gg[il + 1])};
                const v2f z = (g2 + g2 * g2 * g2 * 0.044715f) * (-2.0f * 0.7978845608028654f * LOG2E);
                const v2f sg = (v2f){__builtin_amdgcn_rcpf(1.0f + fexp2(z.x)), __builtin_amdgcn_rcpf(1.0f + fexp2(z.y))};
                const v2f yv = (v2f){h0, h1} * g2 * sg;
                const unsigned yp = cvt_pk_bf16(yv.x, yv.y);
                ((LAS unsigned*)pre_i)[il * 64 + nn] = yp & 0xffffu; ((LAS unsigned*)pre_i)[(il + 1) * 64 + nn] = yp >> 16;
                const float y0 = __uint_as_float(yp << 16), y1 = __uint_as_float(yp & 0xffff0000u);
                pre_r[il * 64 + nn] = y0 * y0; pre_r[(il + 1) * 64 + nn] = y1 * y1;
                if (SAMPLE && (il & 7) == 6) F.out[O_HS + (size_t)(bn + (i >> 3)) * 512 + c] = h1;
            }
            if ((il & 7) == 6) __builtin_amdgcn_sched_barrier(0);
        }
        asm volatile("s_waitcnt lgkmcnt(0)" ::: "memory");
        if (PASS == 2) {
            if (lane < 32) {
                float s = 0.f;
#pragma unroll 8
                for (int j = 0; j < 64; ++j) s += pre_r[lane * 64 + ((j + lane) & 63)];
                unsafeAtomicAdd(ssl + m0 + 32 * half + lane, s);
            }
            {
                const LAS unsigned* yw = (const LAS unsigned*)pre_i;
#pragma unroll
                for (int i = 0; i < 4; ++i) {
                    const int row = (lane >> 3) + 8 * i, ch8 = ((lane & 7) * 8) ^ (((row >> 2) & 1) << 4);
                    const u32x4 lo = *(const LAS u32x4*)(yw + row * 64 + ch8), hi4 = *(const LAS u32x4*)(yw + row * 64 + ch8 + 4);
                    u32x4 w; w.x = (lo.x & 0xffffu) | (lo.y << 16); w.y = (lo.z & 0xffffu) | (lo.w << 16); w.z = (hi4.x & 0xffffu) | (hi4.y << 16); w.w = (hi4.z & 0xffffu) | (hi4.w << 16);
                    st16(F.MIX + (size_t)(m0 + 32 * half + row) * 512 + g * 64 + (lane & 7) * 8, w);
                }
            }
            asm volatile("s_waitcnt lgkmcnt(0)" ::: "memory");
        }
    }
    if (PASS == 1) {
        __hip_atomic_store((unsigned*)(F.SUMA + ((size_t)bn * 128 + k) * 512 + c), __float_as_uint(Ap), __ATOMIC_RELAXED, __HIP_MEMORY_SCOPE_AGENT);
        __hip_atomic_store((unsigned*)(F.SUMB + ((size_t)bn * 128 + k) * 512 + c), __float_as_uint(h), __ATOMIC_RELAXED, __HIP_MEMORY_SCOPE_AGENT);
    }
    if (PASS == 2) { if (!SAMPLE && k == 127) F.out[O_HP + (size_t)bn * 512 + c] = h; }
}

constexpr int SWA_KS = 136, SWA_VS = 204, SWA_VOFF = 192 * SWA_KS * 2;
__device__ __forceinline__ int crow(int r, int hi) { return (r & 3) + 8 * (r >> 2) + 4 * hi; }
__device__ __forceinline__ unsigned short bf_at(const u32x4& v, int e) { return (unsigned short)(v[e >> 1] >> ((e & 1) * 16)); }
template <bool SAMPLE>
__device__ __forceinline__ void swa_qtile(Ctx& F, const bf16_t* qrow  , int kb, int tb  , int h, float sk, bf16_t* orow, float* ssrow) {
    const int lane = F.lane, q = lane & 31, hi = lane >> 5, kvh = h >> 2;
    const LAS bf16_t* Kl = (const LAS bf16_t*)F.lds; const LAS bf16_t* Vt = (const LAS bf16_t*)(F.lds + SWA_VOFF);
    bf16x8 qf[4];
#pragma unroll
    for (int ks = 0; ks < 4; ++ks) qf[ks] = *(const bf16x8*)(qrow + 16 * ks + 8 * hi);
    f32x16 s[5];
#pragma unroll
    for (int kt = 0; kt < 5; ++kt) {
        s[kt] = (f32x16){0.f, 0.f, 0.f, 0.f, 0.f, 0.f, 0.f, 0.f, 0.f, 0.f, 0.f, 0.f, 0.f, 0.f, 0.f, 0.f};
#pragma unroll
        for (int ks = 0; ks < 4; ++ks) {
            const bf16x8 a = *(const LAS bf16x8*)(Kl + (kb + 32 * kt + q) * SWA_KS + kvh * 64 + 16 * ks + 8 * hi);
            s[kt] = __builtin_amdgcn_mfma_f32_32x32x16_bf16(a, qf[ks], s[kt], 0, 0, 0);
        }
    }
    float mx = sk;
#pragma unroll
    for (int kt = 0; kt < 5; ++kt)
#pragma unroll
        for (int r = 0; r < 16; ++r) {
            const int kk = 32 * kt + crow(r, hi); bool valid;
            if (SAMPLE) valid = (kk < 128) ? (kk >= q + 1) : (kk - 128 <= q && kk < 136);
            else valid = (kk >= q + 1) && (kk <= q + 128) && (tb + kk >= 0);
            const float sv = valid ? s[kt][r] : -INFINITY; s[kt][r] = sv; mx = fmaxf(mx, sv);
        }
    mx = fmaxf(mx, __shfl_xor(mx, 32));
    float l = 0.f; bf16x8 pb[10];
#pragma unroll
    for (int kt = 0; kt < 5; ++kt) {
        float p[16];
#pragma unroll
        for (int r = 0; r < 16; ++r) { p[r] = fexp2(s[kt][r] - mx); l += p[r]; }
#pragma unroll
        for (int hf = 0; hf < 2; ++hf) {
            u32x4 w; w.x = cvt_pk_bf16(p[8 * hf + 0], p[8 * hf + 1]); w.y = cvt_pk_bf16(p[8 * hf + 2], p[8 * hf + 3]); w.z = cvt_pk_bf16(p[8 * hf + 4], p[8 * hf + 5]); w.w = cvt_pk_bf16(p[8 * hf + 6], p[8 * hf + 7]);
            pb[2 * kt + hf] = __builtin_bit_cast(bf16x8, w);
        }
    }
    l += __shfl_xor(l, 32); l += fexp2(sk - mx);
    const float inv = 1.0f / l; float sq = 0.f;
    const bool wr_ok = !SAMPLE || q < 8;
#pragma unroll
    for (int dt = 0; dt < 2; ++dt) {
        f32x16 o = (f32x16){0.f, 0.f, 0.f, 0.f, 0.f, 0.f, 0.f, 0.f, 0.f, 0.f, 0.f, 0.f, 0.f, 0.f, 0.f, 0.f};
#pragma unroll
        for (int u = 0; u < 10; ++u) {
            const LAS bf16_t* vp = Vt + (kvh * 64 + 32 * dt + q) * SWA_VS + kb + 16 * u + 4 * hi;
            const u32x2 lo = *(const LAS u32x2*)vp, hi4 = *(const LAS u32x2*)(vp + 8);
            u32x4 w; w.x = lo.x; w.y = lo.y; w.z = hi4.x; w.w = hi4.y;
            o = __builtin_amdgcn_mfma_f32_32x32x16_bf16(__builtin_bit_cast(bf16x8, w), pb[u], o, 0, 0, 0);
        }
#pragma unroll
        for (int r = 0; r < 16; ++r) { o[r] *= inv; sq += o[r] * o[r]; }
        if (wr_ok) {
#pragma unroll
            for (int rg = 0; rg < 4; ++rg) {
                u32x2 w; w.x = cvt_pk_bf16(o[4 * rg], o[4 * rg + 1]); w.y = cvt_pk_bf16(o[4 * rg + 2], o[4 * rg + 3]);
                st8(orow + 32 * dt + 8 * rg + 4 * hi, w);
            }
        }
    }
    sq += __shfl_xor(sq, 32);
    if (wr_ok && hi == 0) unsafeAtomicAdd(ssrow, sq);
}
__device__ __forceinline__ void swa_prompt_item(Ctx& F, int b, int qb, float* ssa) {
    const int tid = F.tid, lane = F.lane, h = F.wave, q = lane & 31;
    LAS bf16_t* Kl = (LAS bf16_t*)F.lds; LAS bf16_t* Vt = (LAS bf16_t*)(F.lds + SWA_VOFF);
    const int tb = 64 * qb - 128; const size_t rowbase = (size_t)b * SEQ;
    const u32x4 z4 = (u32x4){0u, 0u, 0u, 0u};
#pragma unroll
    for (int i = 0; i < 6; ++i) { const int p = tid + 512 * i, key = p >> 4, ch = p & 15, tok = tb + key;
        const u32x4 v = tok >= 0 ? *(const u32x4*)(F.PROJ + (rowbase + tok) * NIN + 1536 + ch * 8) : z4;
        *(LAS u32x4*)(Kl + key * SWA_KS + ch * 8) = v; }
#pragma unroll
    for (int i = 0; i < 3; ++i) { const int p = tid + 512 * i, ch = (p & 3) + 4 * (p / 384), kp = (p % 384) >> 2, tok = tb + 2 * kp;
        const u32x4 v0 = tok >= 0 ? *(const u32x4*)(F.PROJ + (rowbase + tok) * NIN + 1664 + ch * 8) : z4;
        const u32x4 v1 = tok + 1 >= 0 ? *(const u32x4*)(F.PROJ + (rowbase + tok + 1) * NIN + 1664 + ch * 8) : z4;
#pragma unroll
        for (int e = 0; e < 8; ++e) *(LAS unsigned*)(Vt + (ch * 8 + e) * SWA_VS + 2 * kp) = (unsigned)bf_at(v0, e) | ((unsigned)bf_at(v1, e) << 16); }
    __syncthreads();
    const float sk = F.in[22][h] * LOG2E;
    const size_t m0 = rowbase + 64 * qb;
    swa_qtile<false>(F, F.PROJ + (m0 + q) * NIN + 1024 + h * 64, 0, tb, h, sk, (F.MIX + (size_t)M * 512) + (m0 + q) * 512 + h * 64, ssa + m0 + q);
    swa_qtile<false>(F, F.PROJ + (m0 + 32 + q) * NIN + 1024 + h * 64, 32, tb + 32, h, sk, (F.MIX + (size_t)M * 512) + (m0 + 32 + q) * 512 + h * 64, ssa + m0 + 32 + q);
    __syncthreads();
}
__device__ __forceinline__ void swa_sample_item(Ctx& F, int n, float* ssa) {
    const int tid = F.tid, lane = F.lane, h = F.wave, q = lane & 31;
    LAS bf16_t* Kl = (LAS bf16_t*)F.lds; LAS bf16_t* Vt = (LAS bf16_t*)(F.lds + SWA_VOFF);
    const size_t m0 = (size_t)MP + 8 * n;
    const float* ck = F.in[5] + (size_t)n * 16384; const float* cv = F.in[6] + (size_t)n * 16384;
    const u32x4 z4 = (u32x4){0u, 0u, 0u, 0u};
#pragma unroll
    for (int i = 0; i < 5; ++i) { const int p = tid + 512 * i, key = p >> 4, ch = p & 15;
        u32x4 v = z4;
        if (key < 128) { const f32x4 a = __builtin_nontemporal_load((const f32x4*)(ck + key * 128 + ch * 8)), bq = __builtin_nontemporal_load((const f32x4*)(ck + key * 128 + ch * 8 + 4));
            v.x = cvt_pk_bf16(a[0], a[1]); v.y = cvt_pk_bf16(a[2], a[3]); v.z = cvt_pk_bf16(bq[0], bq[1]); v.w = cvt_pk_bf16(bq[2], bq[3]); }
        else if (key < 136) v = *(const u32x4*)(F.PROJ + (m0 + key - 128) * NIN + 1536 + ch * 8);
        *(LAS u32x4*)(Kl + key * SWA_KS + ch * 8) = v; }
#pragma unroll
    for (int i = 0; i < 3; ++i) { const int p = tid + 512 * i;
        if (p < 1280) { const int ch = (p & 3) + 4 * (p / 320), kp = (p % 320) >> 2, key = 2 * kp;
            u32x4 v0 = z4, v1 = z4;
            if (key < 128) {
                const f32x4 a0 = __builtin_nontemporal_load((const f32x4*)(cv + key * 128 + ch * 8)), b0 = __builtin_nontemporal_load((const f32x4*)(cv + key * 128 + ch * 8 + 4)), a1 = __builtin_nontemporal_load((const f32x4*)(cv + (key + 1) * 128 + ch * 8)), b1 = __builtin_nontemporal_load((const f32x4*)(cv + (key + 1) * 128 + ch * 8 + 4));
                v0.x = cvt_pk_bf16(a0[0], a0[1]); v0.y = cvt_pk_bf16(a0[2], a0[3]); v0.z = cvt_pk_bf16(b0[0], b0[1]); v0.w = cvt_pk_bf16(b0[2], b0[3]);
                v1.x = cvt_pk_bf16(a1[0], a1[1]); v1.y = cvt_pk_bf16(a1[2], a1[3]); v1.z = cvt_pk_bf16(b1[0], b1[1]); v1.w = cvt_pk_bf16(b1[2], b1[3]);
            } else if (key < 136) { v0 = *(const u32x4*)(F.PROJ + (m0 + key - 128) * NIN + 1664 + ch * 8); v1 = *(const u32x4*)(F.PROJ + (m0 + key + 1 - 128) * NIN + 1664 + ch * 8); }
#pragma unroll
            for (int e = 0; e < 8; ++e) *(LAS unsigned*)(Vt + (ch * 8 + e) * SWA_VS + 2 * kp) = (unsigned)bf_at(v0, e) | ((unsigned)bf_at(v1, e) << 16); } }
    __syncthreads();
    const float sk = F.in[22][h] * LOG2E;
    const int qc = q < 8 ? q : 7;
    swa_qtile<true>(F, F.PROJ + (m0 + qc) * NIN + 1024 + h * 64, 0, 0, h, sk, (F.MIX + (size_t)M * 512) + (m0 + qc) * 512 + h * 64, ssa + m0 + qc);
    __syncthreads();
}

constexpr int XK_S = 72, XV_S = 260, XV_OFF = 256 * XK_S * 2;
template <bool SAMPLE>
__device__ __forceinline__ void xattn_item(Ctx& F, const float* Ksrc, const float* Vsrc, int h, size_t m0) {
    const int tid = F.tid, lane = F.lane, q = lane & 31, hi = lane >> 5;
    LAS bf16_t* Kc = (LAS bf16_t*)F.lds; LAS bf16_t* Vtc = (LAS bf16_t*)(F.lds + XV_OFF);
    const bool active = SAMPLE ? (F.wave == 0) : true;
    const size_t qr = SAMPLE ? m0 + (q < 8 ? q : 7) : m0 + 32 * F.wave + q;
    const bf16_t* qrow = F.QX + qr * D + h * 256;
    f32x16 S[8];
#pragma unroll
    for (int kt = 0; kt < 8; ++kt) S[kt] = (f32x16){0.f, 0.f, 0.f, 0.f, 0.f, 0.f, 0.f, 0.f, 0.f, 0.f, 0.f, 0.f, 0.f, 0.f, 0.f, 0.f};
#define XLD(ptr) (SAMPLE ? __builtin_nontemporal_load((const f32x4*)(ptr)) : *(const f32x4*)(ptr))
    f32x4 pre[8];
    const float* kbase = Ksrc + (size_t)(tid >> 4) * 1024 + h * 256 + 4 * (tid & 15);
    const float* vbase = Vsrc + (size_t)(2 * (tid >> 2)) * 1024 + h * 256 + 4 * (tid & 3);
#pragma unroll
    for (int i = 0; i < 8; ++i) pre[i] = XLD(kbase + (size_t)i * 32 * 1024);
    for (int ch = 0; ch < 4; ++ch) {
        __syncthreads();
#pragma unroll
        for (int i = 0; i < 8; ++i) { u32x2 w; w.x = cvt_pk_bf16(pre[i][0], pre[i][1]); w.y = cvt_pk_bf16(pre[i][2], pre[i][3]); *(LAS u32x2*)(Kc + ((tid >> 4) + 32 * i) * XK_S + 4 * (tid & 15)) = w; }
        __syncthreads();
        if (ch < 3) {
#pragma unroll
            for (int i = 0; i < 8; ++i) pre[i] = XLD(kbase + (size_t)i * 32 * 1024 + 64 * (ch + 1));
        } else {
#pragma unroll
            for (int i = 0; i < 4; ++i) { pre[2 * i] = XLD(vbase + 16 * i); pre[2 * i + 1] = XLD(vbase + 1024 + 16 * i); }
        }
        if (active) {
#pragma unroll 1
            for (int ks = 0; ks < 4; ++ks) {
                const bf16x8 qf = *(const bf16x8*)(qrow + 64 * ch + 16 * ks + 8 * hi);
#pragma unroll
                for (int kt = 0; kt < 8; ++kt) {
                    const bf16x8 a = *(const LAS bf16x8*)(Kc + (32 * kt + q) * XK_S + 16 * ks + 8 * hi);
                    S[kt] = __builtin_amdgcn_mfma_f32_32x32x16_bf16(a, qf, S[kt], 0, 0, 0);
                }
            }
        }
    }
    float mx = -INFINITY;
#pragma unroll
    for (int kt = 0; kt < 8; ++kt)
#pragma unroll
        for (int r = 0; r < 16; ++r) mx = fmaxf(mx, S[kt][r]);
    mx = fmaxf(mx, __shfl_xor(mx, 32));
    float l = 0.f; bf16x8 pb[16];
#pragma unroll
    for (int kt = 0; kt < 8; ++kt) {
        float p[16];
#pragma unroll
        for (int r = 0; r < 16; ++r) { p[r] = fexp2(S[kt][r] - mx); l += p[r]; }
#pragma unroll
        for (int hf = 0; hf < 2; ++hf) {
            u32x4 w; w.x = cvt_pk_bf16(p[8 * hf + 0], p[8 * hf + 1]); w.y = cvt_pk_bf16(p[8 * hf + 2], p[8 * hf + 3]); w.z = cvt_pk_bf16(p[8 * hf + 4], p[8 * hf + 5]); w.w = cvt_pk_bf16(p[8 * hf + 6], p[8 * hf + 7]);
            pb[2 * kt + hf] = __builtin_bit_cast(bf16x8, w);
        }
    }
    l += __shfl_xor(l, 32);
    const float inv = 1.0f / l;
    bf16_t* orow = F.XO + qr * D + h * 256;
    for (int ch = 0; ch < 4; ++ch) {
        __syncthreads();
#pragma unroll
        for (int i = 0; i < 4; ++i) {
#pragma unroll
            for (int e = 0; e < 4; ++e) *(LAS unsigned*)(Vtc + (4 * ((tid & 3) + 4 * i) + e) * XV_S + 2 * (tid >> 2)) = cvt_pk_bf16(pre[2 * i][e], pre[2 * i + 1][e]); }
        __syncthreads();
        if (ch < 3) {
#pragma unroll
            for (int i = 0; i < 4; ++i) { pre[2 * i] = XLD(vbase + 64 * (ch + 1) + 16 * i); pre[2 * i + 1] = XLD(vbase + 1024 + 64 * (ch + 1) + 16 * i); }
        }
        if (active) {
#pragma unroll
            for (int dt = 0; dt < 2; ++dt) {
                f32x16 o = (f32x16){0.f, 0.f, 0.f, 0.f, 0.f, 0.f, 0.f, 0.f, 0.f, 0.f, 0.f, 0.f, 0.f, 0.f, 0.f, 0.f};
#pragma unroll
                for (int u = 0; u < 16; ++u) {
                    const LAS bf16_t* vp = Vtc + (32 * dt + q) * XV_S + 16 * u + 4 * hi;
                    const u32x2 lo = *(const LAS u32x2*)vp, hi4 = *(const LAS u32x2*)(vp + 8);
                    u32x4 w; w.x = lo.x; w.y = lo.y; w.z = hi4.x; w.w = hi4.y;
                    o = __builtin_amdgcn_mfma_f32_32x32x16_bf16(__builtin_bit_cast(bf16x8, w), pb[u], o, 0, 0, 0);
                }
                if (!SAMPLE || q < 8) {
#pragma unroll
                    for (int rg = 0; rg < 4; ++rg) {
                        u32x2 w; w.x = cvt_pk_bf16(o[4 * rg] * inv, o[4 * rg + 1] * inv); w.y = cvt_pk_bf16(o[4 * rg + 2] * inv, o[4 * rg + 3] * inv);
                        st8(orow + 64 * ch + 32 * dt + 8 * rg + 4 * hi, w);
                    }
                }
            }
        }
    }
    __syncthreads();
}

struct MiniSeg { const bf16_t* A; const bf16_t* Bt; int K; const float* rowss; };
template <int MODE  , int NSEG>
__device__ __forceinline__ void mini_gemm(Ctx& F, const MiniSeg& sg0, const MiniSeg& sg1, float cscale, const float* base_s  , bf16_t* XB, float* ss_out, bf16_t* O, const float* ssin, float cst,
                                          unsigned* cnt_s = nullptr, const float* gfin = nullptr, float* Y = nullptr  ) {
    const int t = F.bid; if (t >= 256) return;
    const int lane = F.lane, w = F.wave, fr = lane & 15, fq = lane >> 4;
    const int R0 = (t >> 4) * 64, C0 = (t & 15) * 64;
    f32x4 acc[4][4];
#pragma unroll
    for (int mt = 0; mt < 4; ++mt)
#pragma unroll
        for (int nt = 0; nt < 4; ++nt) acc[mt][nt] = (f32x4){0.f, 0.f, 0.f, 0.f};
#pragma unroll
    for (int s_ = 0; s_ < NSEG; ++s_) {
        const MiniSeg& sg = s_ ? sg1 : sg0;
        const int K = sg.K, nsteps = K >> 8;
        const bf16_t* pa = sg.A + (size_t)(R0 + fr) * K + (size_t)w * (K >> 3) + 8 * fq; const bf16_t* pb = sg.Bt + (size_t)(C0 + fr) * K + (size_t)w * (K >> 3) + 8 * fq;
        f32x4 sacc[4][4];
        if (NSEG > 1) {
#pragma unroll
            for (int mt = 0; mt < 4; ++mt)
#pragma unroll
                for (int nt = 0; nt < 4; ++nt) sacc[mt][nt] = (f32x4){0.f, 0.f, 0.f, 0.f};
        }
        constexpr int NB = (NSEG > 1) ? 2 : 4;
#pragma unroll 1
        for (int s0 = 0; s0 < nsteps; s0 += NB) {
            bf16x8 a[NB][4], b[NB][4];
#pragma unroll
            for (int s = 0; s < NB; ++s)
                if (s0 + s < nsteps) {
#pragma unroll
                    for (int i = 0; i < 4; ++i) { a[s][i] = *(const bf16x8*)(pa + (size_t)(16 * i) * K + 32 * (s0 + s)); b[s][i] = *(const bf16x8*)(pb + (size_t)(16 * i) * K + 32 * (s0 + s)); }
                }
#pragma unroll
            for (int s = 0; s < NB; ++s)
                if (s0 + s < nsteps) {
#pragma unroll
                    for (int mt = 0; mt < 4; ++mt)
#pragma unroll
                        for (int nt = 0; nt < 4; ++nt) {
                            if (NSEG > 1) sacc[mt][nt] = __builtin_amdgcn_mfma_f32_16x16x32_bf16(b[s][nt], a[s][mt], sacc[mt][nt], 0, 0, 0);
                            else acc[mt][nt] = __builtin_amdgcn_mfma_f32_16x16x32_bf16(b[s][nt], a[s][mt], acc[mt][nt], 0, 0, 0);
                        }
                }
        }
        if (NSEG > 1) {
#pragma unroll
            for (int mt = 0; mt < 4; ++mt) {
                const float sc = rsqrtf(sg.rowss[MP + R0 + 16 * mt + fr] * (1.0f / 512.0f) + EPS);
#pragma unroll
                for (int nt = 0; nt < 4; ++nt) acc[mt][nt] = acc[mt][nt] + sacc[mt][nt] * sc;
            }
        }
    }
    LAS float* part = (LAS float*)(F.lds + w * 16384);
#pragma unroll
    for (int mt = 0; mt < 4; ++mt)
#pragma unroll
        for (int nt = 0; nt < 4; ++nt) { const int row = 16 * mt + fr, chn = (4 * nt + fq) ^ fr; *(LAS f32x4*)(part + row * 64 + 4 * chn) = acc[mt][nt]; }
    __syncthreads();
    const int r = 8 * w + (lane >> 3), j = lane & 7;
    f32x4 t0 = (f32x4){0.f, 0.f, 0.f, 0.f}, t1 = t0;
#pragma unroll
    for (int pw = 0; pw < 8; ++pw) {
        const LAS float* pp = (const LAS float*)(F.lds + pw * 16384) + r * 64;
        t0 = t0 + *(const LAS f32x4*)(pp + 4 * ((2 * j) ^ (r & 15))); t1 = t1 + *(const LAS f32x4*)(pp + 4 * ((2 * j + 1) ^ (r & 15)));
    }
    const int R = MP + R0 + r, C = C0 + 8 * j;
    if (MODE == 0 || MODE == 2) {
        if (NSEG == 1) { t0 = t0 * cscale; t1 = t1 * cscale; }
        f32x4 b0, b1;
        if (base_s) { b0 = *(const f32x4*)(base_s + (size_t)(R - MP) * D + C); b1 = *(const f32x4*)(base_s + (size_t)(R - MP) * D + C + 4); }
        else { const u32x4 wv = *(const u32x4*)(XB + (size_t)R * D + C);
            b0 = (f32x4){__uint_as_float(wv.x << 16), __uint_as_float(wv.x & 0xffff0000u), __uint_as_float(wv.y << 16), __uint_as_float(wv.y & 0xffff0000u)};
            b1 = (f32x4){__uint_as_float(wv.z << 16), __uint_as_float(wv.z & 0xffff0000u), __uint_as_float(wv.w << 16), __uint_as_float(wv.w & 0xffff0000u)}; }
        const f32x4 v0 = b0 + t0, v1 = b1 + t1;
        if (MODE == 0) { u32x4 wo; wo.x = cvt_pk_bf16(v0[0], v0[1]); wo.y = cvt_pk_bf16(v0[2], v0[3]); wo.z = cvt_pk_bf16(v1[0], v1[1]); wo.w = cvt_pk_bf16(v1[2], v1[3]);
            *(u32x4*)(XB + (size_t)R * D + C) = wo; }
        float sq = (v0[0] * v0[0] + v0[1] * v0[1]) + (v0[2] * v0[2] + v0[3] * v0[3]) + (v1[0] * v1[0] + v1[1] * v1[1]) + (v1[2] * v1[2] + v1[3] * v1[3]);
        sq += __shfl_xor(sq, 1); sq += __shfl_xor(sq, 2); sq += __shfl_xor(sq, 4);
        if (j == 0) unsafeAtomicAdd(ss_out + R, sq);
        if (MODE == 2) {
            asm volatile("s_waitcnt vmcnt(0)" ::: "memory");
            __syncthreads();
            if (threadIdx.x == 0) {
                unsigned* c = cnt_s + 64 * (t >> 4);
                __hip_atomic_fetch_add(c, 1u, __ATOMIC_RELAXED, __HIP_MEMORY_SCOPE_AGENT);
                unsigned sp = 0u;
                while (__hip_atomic_load(c, __ATOMIC_RELAXED, __HIP_MEMORY_SCOPE_AGENT) < 16u) { __builtin_amdgcn_s_sleep(2); if (++sp > (1u << 20)) break; }
            }
            __syncthreads();
            float s = 0.f; if (j == 0) s = unsafeAtomicAdd(ss_out + R, 0.0f);
            s = __shfl(s, lane & ~7);
            const float rs = rstd_of(s);
            const f32x4 g0 = *(const f32x4*)(gfin + C), g1 = *(const f32x4*)(gfin + C + 4);
            __builtin_nontemporal_store(v0 * rs * g0, (f32x4*)(Y + (size_t)R * D + C)); __builtin_nontemporal_store(v1 * rs * g1, (f32x4*)(Y + (size_t)R * D + C + 4));
        }
    } else {
        const float rs = rstd_of(ssin[R]) * cst;
        const f32x4 v0 = t0 * rs, v1 = t1 * rs;
        u32x4 wo; wo.x = cvt_pk_bf16(v0[0], v0[1]); wo.y = cvt_pk_bf16(v0[2], v0[3]); wo.z = cvt_pk_bf16(v1[0], v1[1]); wo.w = cvt_pk_bf16(v1[2], v1[3]);
        st16(O + (size_t)R * D + C, wo);
    }
    __syncthreads();
}

__global__ void __launch_bounds__(512, 2) hymba_fwd(Args args) {
    extern __shared__ __attribute__((aligned(16))) unsigned char lds_raw[];
    cg::grid_group grid = cg::this_grid();
    Ctx F;
    F.lds = (LAS unsigned char*)lds_raw; F.tid = threadIdx.x; F.lane = F.tid & 63; F.wave = __builtin_amdgcn_readfirstlane(F.tid >> 6); F.G = gridDim.x; F.bid = blockIdx.x;
    F.in = args.in; F.out = args.out; F.ws = args.ws;
    unsigned char* ws = args.ws;
    F.SS = (float*)(ws + WS_SS); F.ROPE = (float*)(ws + WS_ROPE); F.SUMA = (float*)(ws + WS_SUM); F.SUMB = F.SUMA + 256 * 512; F.WAB = (bf16_t*)(ws + WS_WAB);
    F.XB = (bf16_t*)(ws + WS_XB); F.H = (bf16_t*)(ws + WS_H); F.X = (float*)(ws + WS_X); F.PROJ = (bf16_t*)(ws + WS_PROJ); F.MIX = (bf16_t*)(ws + WS_MIX);
    F.QX = (bf16_t*)(ws + WS_QX); F.XO = (bf16_t*)(ws + WS_XO);
    float* ss0 = F.SS; float* ss1 = F.SS + M; float* ss2 = F.SS + 2 * M; float* ss3 = F.SS + 3 * M; float* ss4 = F.SS + 4 * M;
    constexpr size_t WS_BAR = WS_WAB + 2 * MiB;
    unsigned* const barw = (unsigned*)(ws + WS_BAR);
    volatile LAS unsigned* const barst = (volatile LAS unsigned*)(F.lds + MISC_OFF + 8192);
    if (threadIdx.x < 2) barst[threadIdx.x] = 0u;
    __syncthreads();
    XcdBarrier xbar = xcd_barrier_post(barw, barst);
#define GRID_SYNC() xcd_barrier(xbar)
#define RETID() do { int t_ = threadIdx.x; asm volatile("" : "+v"(t_)); F.tid = t_; F.lane = t_ & 63; F.wave = __builtin_amdgcn_readfirstlane(t_ >> 6); } while (0)
#ifndef PHASE_MASK
#define PHASE_MASK 0xFFFF
#endif
#define PH(k) if constexpr (((PHASE_MASK) >> (k)) & 1)
#ifndef DUP_MASK
#define DUP_MASK 0
#endif
#ifndef EXTRA_SYNCS
#define EXTRA_SYNCS 0
#endif
#define REP(k) for (int rep = 0; rep < 1 + (((DUP_MASK) >> (k)) & 1); ++rep)
    float* const ssdummy = (float*)(ws + WS_WAB + MiB);

    PH(0) REP(0) { RETID(); p0_prologue(F, args.inv_rev); }
    if (args.use_cg) grid.sync();
    GRID_SYNC();
    for (int e = 0; e < EXTRA_SYNCS; ++e) GRID_SYNC();
    PH(1) REP(1) {
        Gemm g{F.XB, (const bf16_t*)(ws + WS_W1GU), M, 2 * FF, D}; StaticOrder S; S.init(M, 2 * FF, F.G, F.bid);
        EpiGU E{F.H, ss0};
        gemm_phase<EpiGU, StaticOrder, true, true>(F.lds, g, S, E);
        Gemm g2{F.XB + (size_t)M * D, (const bf16_t*)(ws + WS_WCKV), MEMR, 2 * D, D}; StaticOrder S2; S2.init(MEMR, 2 * D, F.G, F.G - 1 - F.bid);
        EpiMemKV E2{F.out};
        gemm_phase<EpiMemKV, StaticOrder, true, true>(F.lds, g2, S2, E2);
    }
    GRID_SYNC();
    PH(2) {
        Gemm g{F.H, (const bf16_t*)(ws + WS_W1D), MP, D, FF}; StaticOrder S; S.init(MP, D, F.G, F.bid);
        EpiRes<false, false> E{nullptr, nullptr, F.XB, ss1, 0.5f, nullptr};
        gemm_phase<EpiRes<false, false>, StaticOrder, true, true>(F.lds, g, S, E);
        RETID(); const MiniSeg s0{F.H + (size_t)MP * FF, (const bf16_t*)(ws + WS_W1D), FF, nullptr};
        mini_gemm<0, 1>(F, s0, s0, 0.5f, nullptr, F.XB, ss1, nullptr, nullptr, 0.f);
    }
    GRID_SYNC();
    PH(3) REP(3) {
        Gemm g{F.XB, (const bf16_t*)(ws + WS_WIN), M, NIN, D}; StaticOrder S; S.init(M, NIN, F.G, F.bid);
        EpiIn E{F.PROJ, ss1, F.ROPE, F.out};
        gemm_phase<EpiIn, StaticOrder, true, true>(F.lds, g, S, E);
    }
    GRID_SYNC();
    unsigned* const cntl = barw + 9216;
    const int pmx = 8 * (F.bid & 7) + ((F.bid >> 3) >> 2), itm = (pmx >> 5) * 128 + (pmx & 31) * 4 + ((F.bid >> 3) & 3);
    PH(4) { RETID(); if (F.bid < 256) lru_tile<false, 1, 2>(F, (itm >> 7) * SEQ + (itm & 127) * 64, itm >> 7, itm & 127, nullptr); }
    asm volatile("s_waitcnt vmcnt(0)" ::: "memory");
    __syncthreads();
    if (threadIdx.x == 0 && F.bid < 256) __hip_atomic_fetch_add(cntl + 64 * (itm >> 7), 1u, __ATOMIC_RELAXED, __HIP_MEMORY_SCOPE_AGENT);
    PH(13) REP(13) { RETID(); float* ssa = rep ? ssdummy : F.SS + 6 * M; if (F.bid < 256) { swa_prompt_item(F, itm >> 7, itm & 127, ssa); if (F.bid < 128) swa_sample_item(F, F.bid, ssa); }
        if (rep == 0 && F.bid >= 128 && F.bid < 160) { const int st = F.bid - 128; lru_tile<true, 2, 1>(F, MP + st * 32, st * 4, 0, F.SS + 5 * M); } }
    if (threadIdx.x == 0 && F.bid < 256) {
        unsigned sp = 0u;
        while (__hip_atomic_load(cntl + 64 * (itm >> 7), __ATOMIC_RELAXED, __HIP_MEMORY_SCOPE_AGENT) < 128u) { __builtin_amdgcn_s_sleep(2); if (++sp > (1u << 20)) break; }
        __builtin_amdgcn_fence(__ATOMIC_ACQUIRE, "agent");
        asm volatile("s_waitcnt vmcnt(0)" ::: "memory");
    }
    __syncthreads();
    PH(5) REP(5) { RETID(); float* ssl = rep ? ssdummy : F.SS + 5 * M;
        if (F.bid < 256) lru_tile<false, 2, 2>(F, (itm >> 7) * SEQ + (itm & 127) * 64, itm >> 7, itm & 127, ssl);
    }
    GRID_SYNC();
    PH(6) {
        StaticOrder2 S; S.init(MP, D, F.G, F.bid);
        Gemm g{F.MIX, (const bf16_t*)(ws + WS_WOUT), MP, D, 512, F.MIX + (size_t)M * 512, (const bf16_t*)(ws + WS_WOUT + MiB)};
        EpiMix E{F.XB, ss2, F.SS + 5 * M, F.SS + 6 * M};
        gemm_phase<EpiMix, StaticOrder2, true, true>(F.lds, g, S, E);
        RETID(); const MiniSeg s0{F.MIX + (size_t)MP * 512, (const bf16_t*)(ws + WS_WOUT), 512, F.SS + 5 * M}, s1{F.MIX + (size_t)(M + MP) * 512, (const bf16_t*)(ws + WS_WOUT + MiB), 512, F.SS + 6 * M};
        mini_gemm<0, 2>(F, s0, s1, 1.0f, nullptr, F.XB, ss2, nullptr, nullptr, 0.f);
    }
    GRID_SYNC();
    PH(7) REP(7) {
        Gemm g{F.XB, (const bf16_t*)(ws + WS_WCQ), MP, D, D}; StaticOrder S; S.init(MP, D, F.G, F.bid);
        EpiRowBf16 E{F.QX, D, ss2, C2X};
        gemm_phase<EpiRowBf16, StaticOrder, true, true>(F.lds, g, S, E);
        RETID(); const MiniSeg s0{F.XB + (size_t)MP * D, (const bf16_t*)(ws + WS_WCQ), D, nullptr};
        mini_gemm<1, 1>(F, s0, s0, 1.0f, nullptr, nullptr, nullptr, F.QX, ss2, C2X);
    }
    GRID_SYNC();
    PH(8) REP(8) { RETID();
        if (F.bid < 256) {
            const int itp = F.bid, b = itp >> 7, hp = (itp >> 5) & 3, qb = itp & 31;
            if (!(F.bid & 1)) xattn_item<false>(F, F.out + O_MK + (size_t)b * 262144, F.out + O_MV + (size_t)b * 262144, hp, (size_t)b * SEQ + 256 * qb);
#pragma unroll 1
            for (int sl = 0; sl < 2; ++sl) { const int j = F.bid + 256 * sl, n = j >> 2, h = j & 3;
                xattn_item<true>(F, F.in[3] + (size_t)n * 262144, F.in[4] + (size_t)n * 262144, h, (size_t)MP + 8 * n); }
            if (F.bid & 1) xattn_item<false>(F, F.out + O_MK + (size_t)b * 262144, F.out + O_MV + (size_t)b * 262144, hp, (size_t)b * SEQ + 256 * qb);
        }
    }
    GRID_SYNC();
    PH(9) {
        Gemm g{F.XO, (const bf16_t*)(ws + WS_WCO), MP, D, D}; StaticOrder S; S.init(MP, D, F.G, F.bid);
        EpiRes<false, false> E{nullptr, nullptr, F.XB, ss3, 1.0f, nullptr};
        gemm_phase<EpiRes<false, false>, StaticOrder, true, true>(F.lds, g, S, E);
        RETID(); const MiniSeg s0{F.XO + (size_t)MP * D, (const bf16_t*)(ws + WS_WCO), D, nullptr};
        mini_gemm<0, 1>(F, s0, s0, 1.0f, nullptr, F.XB, ss3, nullptr, nullptr, 0.f);
    }
    GRID_SYNC();
    PH(10) REP(10) {
        Gemm g{F.XB, (const bf16_t*)(ws + WS_W2GU), M, 2 * FF, D}; StaticOrder S; S.init(M, 2 * FF, F.G, F.bid);
        EpiGU E{F.H, ss3};
        gemm_phase<EpiGU, StaticOrder, true, true>(F.lds, g, S, E);
    }
    GRID_SYNC();
    PH(11) {
        unsigned* cntp = barw + 4096; unsigned* cnts = barw + 8192;
        Gemm g{F.H, (const bf16_t*)(ws + WS_W2D), MP, D, FF}; StaticOrder S; S.init(MP, D, F.G, F.bid);
        EpiFinal E{F.XB, ss4, cntp, F.in[36], F.out + O_Y, 0.5f};
        gemm_phase<EpiFinal, StaticOrder, false, true>(F.lds, g, S, E);
        RETID(); const MiniSeg s0{F.H + (size_t)MP * FF, (const bf16_t*)(ws + WS_W2D), FF, nullptr};
        mini_gemm<2, 1>(F, s0, s0, 0.5f, nullptr, F.XB, ss4, nullptr, nullptr, 0.f, cnts, F.in[36], F.out + O_Y);
    }
}

extern "C" void kernel_launch(void* const* d_in, const int* in_sizes, int n_in, void* d_out, int out_size, void* d_ws, size_t ws_size, hipStream_t stream) {
    static int grid = 0;
    if (grid == 0) {
        if (n_in != 37 || (size_t)out_size != O_END || ws_size < WS_END) { fprintf(stderr, "kernel_launch: unexpected shapes: n_in %d out %d (want %zu) ws %zu (want >= %zu)\n", n_in, out_size, (size_t)O_END, ws_size, (size_t)WS_END); grid = -1; return; }
        int dev = 0, cus = 0, per_cu = 0;
        hipGetDevice(&dev); hipDeviceGetAttribute(&cus, hipDeviceAttributeMultiprocessorCount, dev);
        if (hipFuncSetAttribute((const void*)hymba_fwd, hipFuncAttributeMaxDynamicSharedMemorySize, LDS_BYTES) != hipSuccess) { fprintf(stderr, "kernel_launch: hipFuncSetAttribute failed\n"); grid = -1; return; }
        if (hipOccupancyMaxActiveBlocksPerMultiprocessor(&per_cu, (const void*)hymba_fwd, 512, LDS_BYTES) != hipSuccess || per_cu < 1) { fprintf(stderr, "kernel_launch: occupancy query says %d blocks/CU\n", per_cu); (void)hipGetLastError(); per_cu = 1; }
        grid = cus;
        if (grid != 256) fprintf(stderr, "kernel_launch: note: %d CUs\n", grid);
    }
    if (grid < 0) return;
    Args a; memset(&a, 0, sizeof(a));
    for (int i = 0; i < 37; ++i) a.in[i] = (const float*)d_in[i];
    a.out = (float*)d_out; a.ws = (unsigned char*)d_ws;
    for (int i = 0; i < 32; ++i) a.inv_rev[i] = std::pow(10000.0, -(double)i / 32.0) / 6.283185307179586476925;
    a.use_cg = 0;
    if (hipMemsetAsync((char*)d_ws + WS_WAB + 2 * MiB, 0, 40960, stream) != hipSuccess) { fprintf(stderr, "kernel_launch: memset of barrier words failed\n"); return; }
    void* kargs[] = {&a};
    hipError_t e = hipLaunchCooperativeKernel((const void*)hymba_fwd, dim3(grid), dim3(512), kargs, LDS_BYTES, stream);
    if (e != hipSuccess) fprintf(stderr, "kernel_launch: cooperative launch failed: %s (grid %d)\n", hipGetErrorString(e), grid);
}
```

```cpp
#include <hip/hip_runtime.h>
#include <hip/hip_cooperative_groups.h>
#include <cstdio>
#include <cstdint>
#include <cmath>
#include <cstring>
namespace cg = cooperative_groups;
namespace pg8 {
#define PG8_LAS __attribute__((address_space(3)))
typedef unsigned short bf16_t;
typedef short bf16x8 __attribute__((ext_vector_type(8)));
typedef float f32x4 __attribute__((ext_vector_type(4)));
typedef unsigned u32x4 __attribute__((ext_vector_type(4)));
constexpr int BM = 256, BK = 64, HALF = 128, HTB = HALF * BK * 2  , STAGE_BYTES = 8 * HTB, NXCD = 8, WGM = 8;

__host__ __device__ __forceinline__ int lds_byte(int r, int c) { const int st = (r >> 4) * 2 + (c >> 5), rr = r & 15, cc = c & 31, ob = rr * 64 + cc * 2; return st * 1024 + (ob ^ (((ob >> 9) & 1) << 5)); }
__host__ __device__ __forceinline__ void stage_rc(int b, int& R, int& C) { const int st = b / 1024, sb = b % 1024, swz = sb ^ (((sb >> 9) & 1) << 5); R = (st >> 1) * 16 + swz / 64; C = (st & 1) * 32 + (swz % 64) / 2; }
__host__ __device__ __forceinline__ int perm32(int rho) { const int n = rho >> 4, i = rho & 15; return 8 * (i >> 2) + 4 * n + (i & 3); }

struct Unit { int pm, pn, seg; };
struct Gemm { const bf16_t* A; const bf16_t* Bt; int M, N, K; const bf16_t* A2; const bf16_t* Bt2; };

struct StaticOrder {
    int nM, nN, nwg, G, c;
    __host__ __device__ void init(int M, int N, int G_, int c_) { nM = M / BM; nN = N / BM; nwg = nM * nN; G = G_; c = c_; }
    __host__ __device__ bool next(int i, Unit& u) const {
        const long L = (long)i * G + c; if (L >= nwg) return false;
        int wgid = (int)L; { const int q = nwg / NXCD, r = nwg % NXCD, xcd = wgid % NXCD, off = wgid / NXCD; wgid = (xcd < r ? xcd * (q + 1) : r * (q + 1) + (xcd - r) * q) + off; }
        const int nig = WGM * nN, gid = wgid / nig, fm = gid * WGM, gsz = (nM - fm) < WGM ? (nM - fm) : WGM;
        u.pm = fm + ((wgid % nig) % gsz); u.pn = (wgid % nig) / gsz; u.seg = 0; return true;
    }
    __device__ __forceinline__ void a_ready(const Unit&) const {}
    __device__ __forceinline__ void done(const Unit&) const {}
};

__device__ __forceinline__ unsigned cvt_pk_bf16(float lo, float hi) { unsigned r; asm volatile("v_cvt_pk_bf16_f32 %0, %1, %2" : "=v"(r) : "v"(lo), "v"(hi)); return r; }

template <class Epi, class Sched, bool ALIGN_EPI = false, bool SP2 = false>
__device__ __forceinline__ void gemm_phase(PG8_LAS unsigned char* lds, const Gemm g, const Sched& S, const Epi& E) {
    int tid_ = threadIdx.x; asm volatile("" : "+v"(tid_)); const int tid = tid_, wid = __builtin_amdgcn_readfirstlane(tid >> 6), lane = tid & 63, wr = wid >> 2, wc = wid & 3, fr = lane & 15, fq = lane >> 4;
    const int K = g.K, nt = K / BK;
    unsigned voffA[2], voffB[2];
#pragma unroll
    for (int i = 0; i < 2; ++i) { int R, C; stage_rc(tid * 16 + i * 8192, R, C); const int Rb = Epi::PERM ? ((R & ~31) + perm32(R & 31)) : R;
        voffA[i] = (unsigned)(R * K + C) * 2u; voffB[i] = (unsigned)(Rb * K + C) * 2u; }
    const size_t kstep = (size_t)(BK * 2);
    const size_t hstep = (size_t)HALF * K * 2;
    const size_t tstep = 2 * hstep;
    const unsigned ldsw = (unsigned)wid * 1024u;
    const int aoff = lds_byte(wr * 64 + fr, fq * 8), boff = lds_byte(wc * 32 + fr, fq * 8);
#define PG8_SA(b, h) (((b) * 2 + (h)) * HTB)
#define PG8_SB(b, h) ((4 + (b) * 2 + (h)) * HTB)
#define PG8_STAGE(bufoff, gbase, voff) do { _Pragma("unroll") for (int _i = 0; _i < 2; ++_i) \
        __builtin_amdgcn_global_load_lds((const unsigned*)((const char*)(gbase) + (voff)[_i]), (PG8_LAS unsigned*)(lds + (bufoff) + ldsw + _i * 8192), 16, 0, 0); } while (0)
#define PG8_LDA(dst, b, h) do { _Pragma("unroll") for (int m = 0; m < 4; ++m) _Pragma("unroll") for (int k = 0; k < 2; ++k) dst[m][k] = *(const PG8_LAS bf16x8*)(lds + PG8_SA(b, h) + aoff + m * 2048 + k * 1024); } while (0)
#define PG8_LDB(dst, b, h) do { _Pragma("unroll") for (int n = 0; n < 2; ++n) _Pragma("unroll") for (int k = 0; k < 2; ++k) dst[n][k] = *(const PG8_LAS bf16x8*)(lds + PG8_SB(b, h) + boff + n * 2048 + k * 1024); } while (0)
#define PG8_MMA(ai, bj, At, Bt) do { __builtin_amdgcn_s_setprio(1); _Pragma("unroll") for (int m = 0; m < 4; ++m) _Pragma("unroll") for (int n = 0; n < 2; ++n) _Pragma("unroll") for (int k = 0; k < 2; ++k) \
        acc[ai][bj][m][n] = __builtin_amdgcn_mfma_f32_16x16x32_bf16(Bt[n][k], At[m][k], acc[ai][bj][m][n], 0, 0, 0); __builtin_amdgcn_s_setprio(0); } while (0)
#define PG8_WAIT_V(n) asm volatile("s_waitcnt vmcnt(" #n ")" ::: "memory")
#define PG8_WAIT_L(n) asm volatile("s_waitcnt lgkmcnt(" #n ")" ::: "memory")
#define PG8_BAR __builtin_amdgcn_s_barrier()
#define PG8_SCHED __builtin_amdgcn_sched_barrier(0)
    Unit cur, nxt; int ui = 0;
    if (!S.next(0, cur)) return;
    f32x4 acc[2][2][4][2];
#pragma unroll
    for (int a = 0; a < 2; ++a)
#pragma unroll
        for (int b = 0; b < 2; ++b)
#pragma unroll
            for (int m = 0; m < 4; ++m)
#pragma unroll
                for (int n = 0; n < 2; ++n) acc[a][b][m][n] = (f32x4){0.f, 0.f, 0.f, 0.f};
    bf16x8 At[4][2], B0[2][2], B1[2][2];
    const char* cA = (const char*)((Epi::TWOSEG && cur.seg) ? g.A2 : g.A) + (size_t)cur.pm * tstep; const char* cB = (const char*)((Epi::TWOSEG && cur.seg) ? g.Bt2 : g.Bt) + (size_t)cur.pn * tstep;
    S.a_ready(cur);
    if constexpr (SP2) {
        PG8_STAGE(PG8_SB(0, 0), cB, voffB); PG8_STAGE(PG8_SB(0, 1), cB + hstep, voffB); PG8_STAGE(PG8_SA(0, 0), cA, voffA); PG8_STAGE(PG8_SA(0, 1), cA + hstep, voffA);
        if (wr == 1) PG8_BAR;
        PG8_WAIT_V(2); PG8_BAR;
        PG8_STAGE(PG8_SB(1, 0), cB + kstep, voffB); PG8_STAGE(PG8_SA(1, 0), cA + kstep, voffA); PG8_STAGE(PG8_SB(1, 1), cB + hstep + kstep, voffB);
        PG8_WAIT_V(6); PG8_BAR;
    } else {
        PG8_STAGE(PG8_SB(0, 0), cB, voffB); PG8_STAGE(PG8_SA(0, 0), cA, voffA); PG8_STAGE(PG8_SB(0, 1), cB + hstep, voffB); PG8_STAGE(PG8_SA(0, 1), cA + hstep, voffA);
        if (wr == 1) PG8_BAR;
        PG8_WAIT_V(4); PG8_BAR;
        PG8_STAGE(PG8_SB(1, 0), cB + kstep, voffB); PG8_STAGE(PG8_SA(1, 0), cA + kstep, voffA); PG8_STAGE(PG8_SB(1, 1), cB + hstep + kstep, voffB);
        PG8_WAIT_V(6); PG8_BAR;
    }
    for (;;) {
        const bool has_next = S.next(ui + 1, nxt);
        const char* nA = has_next ? (const char*)((Epi::TWOSEG && nxt.seg) ? g.A2 : g.A) + (size_t)nxt.pm * tstep : cA; const char* nB = has_next ? (const char*)((Epi::TWOSEG && nxt.seg) ? g.Bt2 : g.Bt) + (size_t)nxt.pn * tstep : cB;
        for (int t = 0; t < nt; t += 2) {
            const bool last = (t == nt - 2);
            if constexpr (Epi::MIDSCALE) { if (t == nt / 2) E.mid(acc, cur, wr, wc, fr, fq); }
            const char* a1 = cA + (size_t)(t + 1) * kstep;
            const char* a2 = last ? nA : cA + (size_t)(t + 2) * kstep; const char* b2 = last ? nB : cB + (size_t)(t + 2) * kstep;
            const char* a3 = a2 + kstep; const char* b3 = b2 + kstep;
            if (last && has_next) S.a_ready(nxt);
            if constexpr (SP2) {
            PG8_LDB(B0, 0, 0); PG8_LDB(B1, 0, 1); PG8_SCHED; PG8_LDA(At, 0, 0); PG8_STAGE(PG8_SA(1, 1), a1 + hstep, voffA);
            PG8_WAIT_V(8); PG8_WAIT_L(0); PG8_BAR; PG8_MMA(0, 0, At, B0); PG8_MMA(0, 1, At, B1); PG8_BAR; PG8_SCHED;
            PG8_LDA(At, 0, 1); PG8_STAGE(PG8_SB(0, 0), b2, voffB); PG8_STAGE(PG8_SB(0, 1), b2 + hstep, voffB); PG8_STAGE(PG8_SA(0, 0), a2, voffA);
            PG8_WAIT_V(8); PG8_WAIT_L(0); PG8_BAR; PG8_MMA(1, 0, At, B0); PG8_MMA(1, 1, At, B1); PG8_BAR; PG8_SCHED;
            PG8_LDB(B0, 1, 0); PG8_LDB(B1, 1, 1); PG8_SCHED; PG8_LDA(At, 1, 0); PG8_STAGE(PG8_SA(0, 1), a2 + hstep, voffA);
            PG8_WAIT_V(8); PG8_WAIT_L(0); PG8_BAR; PG8_MMA(0, 0, At, B0); PG8_MMA(0, 1, At, B1); PG8_BAR; PG8_SCHED;
            PG8_LDA(At, 1, 1); PG8_STAGE(PG8_SB(1, 0), b3, voffB); PG8_STAGE(PG8_SB(1, 1), b3 + hstep, voffB); PG8_STAGE(PG8_SA(1, 0), a3, voffA);
            PG8_WAIT_V(8); PG8_WAIT_L(0); PG8_BAR; PG8_MMA(1, 0, At, B0); PG8_MMA(1, 1, At, B1); PG8_BAR; PG8_SCHED;
            } else {
            PG8_LDB(B0, 0, 0); PG8_SCHED; PG8_LDA(At, 0, 0); PG8_STAGE(PG8_SA(1, 1), a1 + hstep, voffA);
            PG8_WAIT_L(8); PG8_BAR; PG8_WAIT_L(0); PG8_MMA(0, 0, At, B0); PG8_BAR; PG8_SCHED;
            PG8_LDB(B1, 0, 1); PG8_STAGE(PG8_SB(0, 0), b2, voffB);
            PG8_BAR; PG8_WAIT_L(0); PG8_MMA(0, 1, At, B1); PG8_BAR;
            PG8_LDA(At, 0, 1); PG8_STAGE(PG8_SA(0, 0), a2, voffA);
            PG8_BAR; PG8_WAIT_L(0); PG8_MMA(1, 0, At, B0); PG8_BAR; PG8_SCHED;
            PG8_STAGE(PG8_SB(0, 1), b2 + hstep, voffB);
            PG8_WAIT_V(6); PG8_BAR; PG8_MMA(1, 1, At, B1); PG8_BAR;
            PG8_LDB(B0, 1, 0); PG8_SCHED; PG8_LDA(At, 1, 0); PG8_STAGE(PG8_SA(0, 1), a2 + hstep, voffA);
            PG8_WAIT_L(8); PG8_BAR; PG8_WAIT_L(0); PG8_MMA(0, 0, At, B0); PG8_BAR; PG8_SCHED;
            PG8_LDB(B1, 1, 1); PG8_STAGE(PG8_SB(1, 0), b3, voffB);
            PG8_BAR; PG8_WAIT_L(0); PG8_MMA(0, 1, At, B1); PG8_BAR;
            PG8_LDA(At, 1, 1); PG8_STAGE(PG8_SA(1, 0), a3, voffA);
            PG8_BAR; PG8_WAIT_L(0); PG8_MMA(1, 0, At, B0); PG8_BAR; PG8_SCHED;
            PG8_STAGE(PG8_SB(1, 1), b3 + hstep, voffB);
            PG8_WAIT_V(6); PG8_BAR; PG8_MMA(1, 1, At, B1); PG8_BAR;
            }
        }
        if constexpr (ALIGN_EPI) { if (wr == 0) PG8_BAR; }
        bool keep_acc = false;
        if constexpr (Epi::TWOSEG) { if (cur.seg == 0) { E.mid(acc, cur, wr, wc, fr, fq); keep_acc = true; } else { E(acc, cur, wr, wc, fr, fq); } }
        else if constexpr (!Epi::AFTER_DRAIN) { E(acc, cur, wr, wc, fr, fq); S.done(cur); }
        if (!has_next) break;
        if (!keep_acc) {
#pragma unroll
        for (int a = 0; a < 2; ++a)
#pragma unroll
            for (int b = 0; b < 2; ++b)
#pragma unroll
                for (int m = 0; m < 4; ++m)
#pragma unroll
                    for (int n = 0; n < 2; ++n) acc[a][b][m][n] = (f32x4){0.f, 0.f, 0.f, 0.f};
        }
        cur = nxt; cA = nA; cB = nB; ++ui;
        if constexpr (ALIGN_EPI) { if (wr == 1) PG8_BAR; }
    }
    PG8_WAIT_V(0);
    if constexpr (!ALIGN_EPI) { if (wr == 0) PG8_BAR; }
    PG8_BAR;
    if constexpr (Epi::AFTER_DRAIN) { E.fused(acc, cur, wr, wc, fr, fq, lds, wid, lane); S.done(cur); }
#undef PG8_SA
#undef PG8_SB
#undef PG8_STAGE
#undef PG8_LDA
#undef PG8_LDB
#undef PG8_MMA
#undef PG8_WAIT_V
#undef PG8_WAIT_L
#undef PG8_BAR
#undef PG8_SCHED
}
}
using namespace pg8;
#define LAS __attribute__((address_space(3)))
typedef float f32x16 __attribute__((ext_vector_type(16)));
typedef unsigned u32x2 __attribute__((ext_vector_type(2)));

constexpr int D = 1024, MP = 16384, MS = 1024, M = MP + MS, FF = 2816, NIN = 1792, SEQ = 8192, MEMR = 512;
constexpr float EPS = 1e-6f, LOG2E = 1.4426950408889634f;
constexpr float C2S = 0.125f * LOG2E;
constexpr float C2X = 0.0625f * LOG2E;
constexpr size_t O_Y = 0, O_MK = (size_t)M * D, O_MV = O_MK + 524288, O_SKP = O_MV + 524288, O_SVP = O_SKP + 32768, O_CP = O_SVP + 32768,
                 O_HP = O_CP + 3072, O_SKS = O_HP + 1024, O_SVS = O_SKS + 2097152, O_CS = O_SVS + 2097152, O_HS = O_CS + 196608, O_END = O_HS + 65536;
constexpr size_t MiB = 1u << 20;
constexpr size_t WS_SS = 0, WS_ROPE = MiB / 2, WS_SUM = 3 * MiB, WS_WAB = 4 * MiB, WS_W1GU = 8 * MiB, WS_WCKV = 19 * MiB, WS_W1D = 23 * MiB, WS_WIN = 29 * MiB,
                 WS_WOUT = 33 * MiB, WS_WCQ = 35 * MiB, WS_WCO = 37 * MiB, WS_W2GU = 39 * MiB, WS_W2D = 50 * MiB, WS_XB = 56 * MiB, WS_H = 91 * MiB, WS_X = 185 * MiB,
                 WS_PROJ = 253 * MiB, WS_MIX = 313 * MiB, WS_QX = 347 * MiB, WS_XO = 381 * MiB, WS_END = 415 * MiB;
constexpr int ROPE_POS = 8200;
constexpr int RING_BYTES = 131072, MISC_OFF = RING_BYTES, LDS_BYTES = 147456;

__device__ __forceinline__ float bf2f(unsigned short b) { return __uint_as_float((unsigned)b << 16); }
__device__ __forceinline__ unsigned short f2bf(float f) { unsigned u = __float_as_uint(f); return (unsigned short)((u + 0x7fffu + ((u >> 16) & 1u)) >> 16); }
__device__ __forceinline__ unsigned pk2(float lo, float hi) { return (unsigned)f2bf(lo) | ((unsigned)f2bf(hi) << 16); }
__device__ __forceinline__ float rstd_of(float ss) { return rsqrtf(ss * (1.0f / 1024.0f) + EPS); }
__device__ __forceinline__ float fexp2(float x) { return __builtin_amdgcn_exp2f(x); }
__device__ __forceinline__ float sigmoidf_(float x) { return __builtin_amdgcn_rcpf(1.0f + fexp2(-x * LOG2E)); }
__device__ __forceinline__ float silu_mul(float g, float u) { return g * u * sigmoidf_(g); }
__device__ __forceinline__ float gelu_tanh(float x) { const float z = 0.7978845608028654f * (x + 0.044715f * x * x * x); return x * sigmoidf_(2.0f * z); }

__device__ __forceinline__ void st16(void* p, u32x4 v) { *(u32x4*)p = v; }
__device__ __forceinline__ void st8(void* p, u32x2 v) { *(u32x2*)p = v; }
struct EpiGU {
    static constexpr bool PERM = true, AFTER_DRAIN = false, MIDSCALE = false, TWOSEG = false;
    bf16_t* H; const float* ss;
    __device__ __forceinline__ void operator()(const f32x4 (&acc)[2][2][4][2], const Unit& u, int wr, int wc, int fr, int fq) const {
        const int row0 = u.pm * 256 + wr * 64 + fr, col0 = u.pn * 128 + wc * 32 + 8 * fq;
        float rsv[2][4];
#pragma unroll
        for (int ai = 0; ai < 2; ++ai)
#pragma unroll
            for (int m = 0; m < 4; ++m) rsv[ai][m] = ss[row0 + ai * 128 + m * 16];
#pragma unroll
        for (int ai = 0; ai < 2; ++ai)
#pragma unroll
            for (int m = 0; m < 4; ++m) {
                const int row = row0 + ai * 128 + m * 16; const float rs = rstd_of(rsv[ai][m]);
                const f32x4 g0 = acc[ai][0][m][0] * rs, g1 = acc[ai][0][m][1] * rs, u0 = acc[ai][1][m][0] * rs, u1 = acc[ai][1][m][1] * rs;
                u32x4 w;
                w.x = cvt_pk_bf16(silu_mul(g0[0], u0[0]), silu_mul(g0[1], u0[1])); w.y = cvt_pk_bf16(silu_mul(g0[2], u0[2]), silu_mul(g0[3], u0[3]));
                w.z = cvt_pk_bf16(silu_mul(g1[0], u1[0]), silu_mul(g1[1], u1[1])); w.w = cvt_pk_bf16(silu_mul(g1[2], u1[2]), silu_mul(g1[3], u1[3]));
                st16(H + (size_t)row * FF + col0, w);
            }
    }
};
template <bool ROWSCALE, bool F32BASE>
struct EpiRes {
    static constexpr bool PERM = true, AFTER_DRAIN = false, MIDSCALE = false, TWOSEG = false;
    const float* base_p; const float* base_s; bf16_t* XB; float* ss_out; float scale; const float* rowss;
    __device__ __forceinline__ void operator()(const f32x4 (&acc)[2][2][4][2], const Unit& u, int wr, int wc, int fr, int fq) const {
        const int row0 = u.pm * 256 + wr * 64 + fr, col0 = u.pn * 256 + wc * 32 + 8 * fq;
#pragma unroll
        for (int ai = 0; ai < 2; ++ai) {
            f32x4 bv[4][2][2]; float scv[4];
#pragma unroll
            for (int m = 0; m < 4; ++m) {
                const int row = row0 + ai * 128 + m * 16;
                scv[m] = ROWSCALE ? rowss[row] : 0.f;
                if (F32BASE) {
                    const float* b = row < MP ? base_p + (size_t)row * D : base_s + (size_t)(row - MP) * D;
#pragma unroll
                    for (int bj = 0; bj < 2; ++bj) { bv[m][bj][0] = *(const f32x4*)(b + col0 + bj * 128); bv[m][bj][1] = *(const f32x4*)(b + col0 + bj * 128 + 4); }
                } else {
#pragma unroll
                    for (int bj = 0; bj < 2; ++bj) {
                        const u32x4 w = *(const u32x4*)(XB + (size_t)row * D + col0 + bj * 128);
                        bv[m][bj][0] = (f32x4){__uint_as_float(w.x << 16), __uint_as_float(w.x & 0xffff0000u), __uint_as_float(w.y << 16), __uint_as_float(w.y & 0xffff0000u)};
                        bv[m][bj][1] = (f32x4){__uint_as_float(w.z << 16), __uint_as_float(w.z & 0xffff0000u), __uint_as_float(w.w << 16), __uint_as_float(w.w & 0xffff0000u)};
                    }
                }
            }
#pragma unroll
            for (int m = 0; m < 4; ++m) {
                const int row = row0 + ai * 128 + m * 16;
                const float sc = ROWSCALE ? rsqrtf(scv[m] * (1.0f / 512.0f) + EPS) : scale; float sq = 0.f;
#pragma unroll
                for (int bj = 0; bj < 2; ++bj) {
                    const int c = col0 + bj * 128;
                    const f32x4 v0 = bv[m][bj][0] + acc[ai][bj][m][0] * sc, v1 = bv[m][bj][1] + acc[ai][bj][m][1] * sc;
                    u32x4 w; w.x = cvt_pk_bf16(v0[0], v0[1]); w.y = cvt_pk_bf16(v0[2], v0[3]); w.z = cvt_pk_bf16(v1[0], v1[1]); w.w = cvt_pk_bf16(v1[2], v1[3]);
                    *(u32x4*)(XB + (size_t)row * D + c) = w;
                    sq += (v0[0] * v0[0] + v0[1] * v0[1]) + (v0[2] * v0[2] + v0[3] * v0[3]) + (v1[0] * v1[0] + v1[1] * v1[1]) + (v1[2] * v1[2] + v1[3] * v1[3]);
                }
                if (ss_out) { sq += __shfl_xor(sq, 16); sq += __shfl_xor(sq, 32); if (fq == 0) unsafeAtomicAdd(ss_out + row, sq); }
            }
        }
    }
};
struct EpiMix {
    static constexpr bool PERM = true, AFTER_DRAIN = false, MIDSCALE = false, TWOSEG = true;
    bf16_t* XB; float* ss_out; const float* ssl; const float* ssa;
    __device__ __forceinline__ void mid(f32x4 (&acc)[2][2][4][2], const Unit& u, int wr, int wc, int fr, int fq) const {
        const int row0 = u.pm * 256 + wr * 64 + fr;
        float sl[2][4], sa[2][4];
#pragma unroll
        for (int ai = 0; ai < 2; ++ai)
#pragma unroll
            for (int m = 0; m < 4; ++m) { sl[ai][m] = ssl[row0 + ai * 128 + m * 16]; sa[ai][m] = ssa[row0 + ai * 128 + m * 16]; }
#pragma unroll
        for (int ai = 0; ai < 2; ++ai)
#pragma unroll
            for (int m = 0; m < 4; ++m) {
                const float ratio = rsqrtf(sl[ai][m] * (1.0f / 512.0f) + EPS) * sqrtf(sa[ai][m] * (1.0f / 512.0f) + EPS);
#pragma unroll
                for (int bj = 0; bj < 2; ++bj)
#pragma unroll
                    for (int n = 0; n < 2; ++n) acc[ai][bj][m][n] = acc[ai][bj][m][n] * ratio;
            }
    }
    __device__ __forceinline__ void operator()(const f32x4 (&acc)[2][2][4][2], const Unit& u, int wr, int wc, int fr, int fq) const {
        const EpiRes<true, false> E{nullptr, nullptr, XB, ss_out, 1.0f, ssa};
        E(acc, u, wr, wc, fr, fq);
    }
};
struct StaticOrder2 {
    StaticOrder S;
    __host__ __device__ void init(int M, int N, int G_, int c_) { S.init(M, N, G_, c_); }
    __host__ __device__ bool next(int i, Unit& u) const { const bool ok = S.next(i >> 1, u); u.seg = i & 1; return ok; }
    __device__ __forceinline__ void a_ready(const Unit&) const {}
    __device__ __forceinline__ void done(const Unit&) const {}
};
struct EpiFinal {
    static constexpr bool PERM = true, AFTER_DRAIN = true, MIDSCALE = false, TWOSEG = false;
    const bf16_t* XB; float* ss; unsigned* cnt; const float* gfin; float* Y; float scale;
    __device__ __forceinline__ void fused(f32x4 (&acc)[2][2][4][2], const Unit& u, int wr, int wc, int fr, int fq, PG8_LAS unsigned char* lds, int wid, int lane) const {
        const int row0 = u.pm * 256 + wr * 64 + fr, col0 = u.pn * 256 + wc * 32 + 8 * fq;
#pragma unroll
        for (int ai = 0; ai < 2; ++ai) {
            u32x4 bw[4][2];
#pragma unroll
            for (int m = 0; m < 4; ++m)
#pragma unroll
                for (int bj = 0; bj < 2; ++bj) bw[m][bj] = __builtin_nontemporal_load((const u32x4*)(XB + (size_t)(row0 + ai * 128 + m * 16) * D + col0 + bj * 128));
#pragma unroll
            for (int m = 0; m < 4; ++m) {
                float sq = 0.f;
#pragma unroll
                for (int bj = 0; bj < 2; ++bj) {
                    const u32x4 w = bw[m][bj];
                    const f32x4 b0 = (f32x4){__uint_as_float(w.x << 16), __uint_as_float(w.x & 0xffff0000u), __uint_as_float(w.y << 16), __uint_as_float(w.y & 0xffff0000u)};
                    const f32x4 b1 = (f32x4){__uint_as_float(w.z << 16), __uint_as_float(w.z & 0xffff0000u), __uint_as_float(w.w << 16), __uint_as_float(w.w & 0xffff0000u)};
                    const f32x4 v0 = b0 + acc[ai][bj][m][0] * scale, v1 = b1 + acc[ai][bj][m][1] * scale;
                    acc[ai][bj][m][0] = v0; acc[ai][bj][m][1] = v1;
                    sq += (v0[0] * v0[0] + v0[1] * v0[1]) + (v0[2] * v0[2] + v0[3] * v0[3]) + (v1[0] * v1[0] + v1[1] * v1[1]) + (v1[2] * v1[2] + v1[3] * v1[3]);
                }
                sq += __shfl_xor(sq, 16); sq += __shfl_xor(sq, 32);
                if (fq == 0) unsafeAtomicAdd(ss + row0 + ai * 128 + m * 16, sq);
            }
        }
        asm volatile("s_waitcnt vmcnt(0)" ::: "memory");
        __syncthreads();
        if (threadIdx.x == 0) {
            unsigned* c = cnt + 64 * u.pm;
            __hip_atomic_fetch_add(c, 1u, __ATOMIC_RELAXED, __HIP_MEMORY_SCOPE_AGENT);
            unsigned sp = 0u;
            while (__hip_atomic_load(c, __ATOMIC_RELAXED, __HIP_MEMORY_SCOPE_AGENT) < 4u) { __builtin_amdgcn_s_sleep(2); if (++sp > (1u << 20)) break; }
        }
        __syncthreads();
        PG8_LAS float* S = (PG8_LAS float*)lds;
        if (threadIdx.x < 256) S[threadIdx.x] = rstd_of(unsafeAtomicAdd(ss + u.pm * 256 + (int)threadIdx.x, 0.0f));
        __syncthreads();
#pragma unroll
        for (int ai = 0; ai < 2; ++ai)
#pragma unroll
            for (int m = 0; m < 4; ++m) {
                const int rl = ai * 128 + wr * 64 + m * 16 + fr; const float rs = S[rl];
                float* yrow = Y + (size_t)(u.pm * 256 + rl) * D;
#pragma unroll
                for (int bj = 0; bj < 2; ++bj) {
                    const int c = col0 + bj * 128;
                    const f32x4 g0 = *(const f32x4*)(gfin + c), g1 = *(const f32x4*)(gfin + c + 4);
                    __builtin_nontemporal_store(acc[ai][bj][m][0] * rs * g0, (f32x4*)(yrow + c)); __builtin_nontemporal_store(acc[ai][bj][m][1] * rs * g1, (f32x4*)(yrow + c + 4));
                }
            }
        __syncthreads();
    }
};
struct EpiRowBf16 {
    static constexpr bool PERM = true, AFTER_DRAIN = false, MIDSCALE = false, TWOSEG = false;
    bf16_t* O; int ldc; const float* ss; float cst;
    __device__ __forceinline__ void operator()(const f32x4 (&acc)[2][2][4][2], const Unit& u, int wr, int wc, int fr, int fq) const {
        const int row0 = u.pm * 256 + wr * 64 + fr, col0 = u.pn * 256 + wc * 32 + 8 * fq;
        float rsv[2][4];
#pragma unroll
        for (int ai = 0; ai < 2; ++ai)
#pragma unroll
            for (int m = 0; m < 4; ++m) rsv[ai][m] = ss[row0 + ai * 128 + m * 16];
#pragma unroll
        for (int ai = 0; ai < 2; ++ai)
#pragma unroll
            for (int m = 0; m < 4; ++m) {
                const int row = row0 + ai * 128 + m * 16; const float rs = rstd_of(rsv[ai][m]) * cst;
#pragma unroll
                for (int bj = 0; bj < 2; ++bj) {
                    const f32x4 v0 = acc[ai][bj][m][0] * rs, v1 = acc[ai][bj][m][1] * rs;
                    u32x4 w; w.x = cvt_pk_bf16(v0[0], v0[1]); w.y = cvt_pk_bf16(v0[2], v0[3]); w.z = cvt_pk_bf16(v1[0], v1[1]); w.w = cvt_pk_bf16(v1[2], v1[3]);
                    st16(O + (size_t)row * ldc + col0 + bj * 128, w);
                }
            }
    }
};
struct EpiMemKV {
    static constexpr bool PERM = true, AFTER_DRAIN = false, MIDSCALE = false, TWOSEG = false;
    float* out;
    __device__ __forceinline__ void operator()(const f32x4 (&acc)[2][2][4][2], const Unit& u, int wr, int wc, int fr, int fq) const {
        const int row0 = u.pm * 256 + wr * 64 + fr, col0 = u.pn * 256 + wc * 32 + 8 * fq;
#pragma unroll
        for (int ai = 0; ai < 2; ++ai)
#pragma unroll
            for (int m = 0; m < 4; ++m) {
                const int row = row0 + ai * 128 + m * 16;
#pragma unroll
                for (int bj = 0; bj < 2; ++bj) {
                    const int c = col0 + bj * 128;
                    float* dst = out + (c < 1024 ? O_MK : O_MV) + (size_t)row * 1024 + (c & 1023);
                    *(f32x4*)dst = acc[ai][bj][m][0]; *(f32x4*)(dst + 4) = acc[ai][bj][m][1];
                }
            }
    }
};
struct EpiIn {
    static constexpr bool PERM = true, AFTER_DRAIN = false, MIDSCALE = false, TWOSEG = false;
    bf16_t* P; const float* ss; const float* rope; float* out;
    __device__ __forceinline__ void operator()(const f32x4 (&acc)[2][2][4][2], const Unit& u, int wr, int wc, int fr, int fq) const {
        const int row0 = u.pm * 256 + wr * 64 + fr; const int pn = u.pn;
        const int ip = (wc & 1) * 4 + fq, hl = wc >> 1;
        float rsv[2][4];
#pragma unroll
        for (int ai = 0; ai < 2; ++ai)
#pragma unroll
            for (int m = 0; m < 4; ++m) rsv[ai][m] = ss[row0 + ai * 128 + m * 16];
#pragma unroll
        for (int ai = 0; ai < 2; ++ai) {
            f32x4 csv[4][2];
            if (pn >= 4) {
#pragma unroll
                for (int m = 0; m < 4; ++m) {
                    const int row = row0 + ai * 128 + m * 16;
                    const bool smp = row >= MP; const int pos = smp ? SEQ + ((row - MP) & 7) : (row & (SEQ - 1));
                    const float* rp = rope + ((size_t)pos * 32 + 4 * ip) * 2; csv[m][0] = *(const f32x4*)rp; csv[m][1] = *(const f32x4*)(rp + 4);
                }
            }
#pragma unroll
            for (int m = 0; m < 4; ++m) {
                const int row = row0 + ai * 128 + m * 16; const float rs = rstd_of(rsv[ai][m]);
                const bool smp = row >= MP; const int t = smp ? ((row - MP) & 7) : (row & (SEQ - 1)); const int sq = smp ? ((row - MP) >> 3) : (row >> 13);
                bf16_t* prow = P + (size_t)row * NIN;
                if (pn < 4) {
#pragma unroll
                    for (int bj = 0; bj < 2; ++bj) {
                        const int c = pn * 256 + bj * 128 + wc * 32 + 8 * fq;
                        const f32x4 v0 = acc[ai][bj][m][0] * rs, v1 = acc[ai][bj][m][1] * rs;
                        u32x4 w; w.x = cvt_pk_bf16(v0[0], v0[1]); w.y = cvt_pk_bf16(v0[2], v0[3]); w.z = cvt_pk_bf16(v1[0], v1[1]); w.w = cvt_pk_bf16(v1[2], v1[3]);
                        st16(prow + c, w);
                        if (pn < 2) {
                            float* dst = nullptr;
                            if (!smp && t >= SEQ - 3) dst = out + O_CP + ((size_t)sq * 3 + (t - (SEQ - 3))) * 512 + c;
                            else if (smp && t >= 5) dst = out + O_CS + ((size_t)sq * 3 + (t - 5)) * 512 + c;
                            if (dst) { *(f32x4*)dst = v0; *(f32x4*)(dst + 4) = v1; }
                        }
                    }
                } else {
                    const f32x4 cs0 = csv[m][0], cs1 = csv[m][1];
#pragma unroll
                    for (int bj = 0; bj < 2; ++bj) {
                        const bool isv = (pn == 6 && bj == 1);
                        if (!isv) {
                            const f32x4 z1 = acc[ai][bj][m][0] * rs, z2 = acc[ai][bj][m][1] * rs;
                            f32x4 o1, o2;
                            o1[0] = z1[0] * cs0[0] - z2[0] * cs0[1]; o2[0] = z2[0] * cs0[0] + z1[0] * cs0[1];
                            o1[1] = z1[1] * cs0[2] - z2[1] * cs0[3]; o2[1] = z2[1] * cs0[2] + z1[1] * cs0[3];
                            o1[2] = z1[2] * cs1[0] - z2[2] * cs1[1]; o2[2] = z2[2] * cs1[0] + z1[2] * cs1[1];
                            o1[3] = z1[3] * cs1[2] - z2[3] * cs1[3]; o2[3] = z2[3] * cs1[2] + z1[3] * cs1[3];
                            if (pn < 6) {
                                const int head = (pn - 4) * 4 + bj * 2 + hl; o1 = o1 * C2S; o2 = o2 * C2S;
                                bf16_t* d = prow + 1024 + head * 64 + 4 * ip;
                                u32x2 a; a.x = cvt_pk_bf16(o1[0], o1[1]); a.y = cvt_pk_bf16(o1[2], o1[3]); st8(d, a);
                                u32x2 b; b.x = cvt_pk_bf16(o2[0], o2[1]); b.y = cvt_pk_bf16(o2[2], o2[3]); st8(d + 32, b);
                            } else {
                                const int head = hl;
                                bf16_t* d = prow + 1536 + head * 64 + 4 * ip;
                                u32x2 a; a.x = cvt_pk_bf16(o1[0], o1[1]); a.y = cvt_pk_bf16(o1[2], o1[3]); st8(d, a);
                                u32x2 b; b.x = cvt_pk_bf16(o2[0], o2[1]); b.y = cvt_pk_bf16(o2[2], o2[3]); st8(d + 32, b);
                                float* dst = nullptr;
                                if (!smp && t >= SEQ - 128) dst = out + O_SKP + ((size_t)sq * 128 + (t - (SEQ - 128))) * 128 + head * 64 + 4 * ip;
                                else if (smp) dst = out + O_SKS + ((size_t)sq * 128 + 120 + t) * 128 + head * 64 + 4 * ip;
                                if (dst) { *(f32x4*)dst = o1; *(f32x4*)(dst + 32) = o2; }
                            }
                        } else {
                            const int cv = wc * 32 + 8 * fq;
                            const f32x4 v0 = acc[ai][bj][m][0] * rs, v1 = acc[ai][bj][m][1] * rs;
                            u32x4 w; w.x = cvt_pk_bf16(v0[0], v0[1]); w.y = cvt_pk_bf16(v0[2], v0[3]); w.z = cvt_pk_bf16(v1[0], v1[1]); w.w = cvt_pk_bf16(v1[2], v1[3]);
                            st16(prow + 1664 + cv, w);
                            float* dst = nullptr;
                            if (!smp && t >= SEQ - 128) dst = out + O_SVP + ((size_t)sq * 128 + (t - (SEQ - 128))) * 128 + cv;
                            else if (smp) dst = out + O_SVS + ((size_t)sq * 128 + 120 + t) * 128 + cv;
                            if (dst) { *(f32x4*)dst = v0; *(f32x4*)(dst + 4) = v1; }
                        }
                    }
                }
            }
        }
    }
};

struct Args { const float* in[37]; float* out; unsigned char* ws; double inv_rev[32]; int use_cg; int pad; };
struct Ctx {
    LAS unsigned char* lds; int tid, lane, wave, G, bid;
    const float* const* in; float* out; unsigned char* ws;
    float* SS; float* ROPE; float* SUMA; float* SUMB; bf16_t* WAB; bf16_t* XB; bf16_t* H; float* X; bf16_t* PROJ; bf16_t* MIX; bf16_t* QX; bf16_t* XO;
};
__device__ __forceinline__ float wave_sum(float v) {
#pragma unroll
    for (int o = 1; o < 64; o <<= 1) v += __shfl_xor(v, o);
    return v;
}
__device__ __forceinline__ int dst_row_of(int mode, int row_off, int n) {
    if (mode == 0) return row_off + n;
    if (mode == 1) return (n >> 7) * 256 + row_off + (n & 127);
    if (n < 1024 || n >= 1664) return n;
    const int hb = (n - 1024) >> 6, dd = (n - 1024) & 63, nn = dd >> 5, rem = dd & 31, i = rem >> 2, e = rem & 3;
    return 1024 + hb * 64 + 8 * i + 4 * nn + e;
}
struct P0Item { const float* W; bf16_t* WT; const float* g0; int K, N, mode, row_off, r; };
__device__ __forceinline__ P0Item p0_item(Ctx& F, int it) {
    unsigned char* ws = F.ws;
    constexpr int I_GU = 16 * 88, I_DN = 44 * 32, I_IN = 16 * 56, I_SQ = 16 * 32;
    static_assert(I_GU == I_DN, "");
    int r = it; P0Item d;
    if (r < I_GU) { d = P0Item{F.in[10], (bf16_t*)(ws + WS_W1GU), F.in[9], D, FF, 1, 0, r}; return d; } r -= I_GU;
    if (r < I_GU) { d = P0Item{F.in[11], (bf16_t*)(ws + WS_W1GU), F.in[9], D, FF, 1, 128, r}; return d; } r -= I_GU;
    if (r < I_DN) { d = P0Item{F.in[12], (bf16_t*)(ws + WS_W1D), nullptr, FF, D, 0, 0, r}; return d; } r -= I_DN;
    if (r < I_GU) { d = P0Item{F.in[33], (bf16_t*)(ws + WS_W2GU), F.in[32], D, FF, 1, 0, r}; return d; } r -= I_GU;
    if (r < I_GU) { d = P0Item{F.in[34], (bf16_t*)(ws + WS_W2GU), F.in[32], D, FF, 1, 128, r}; return d; } r -= I_GU;
    if (r < I_DN) { d = P0Item{F.in[35], (bf16_t*)(ws + WS_W2D), nullptr, FF, D, 0, 0, r}; return d; } r -= I_DN;
    if (r < I_IN) { d = P0Item{F.in[14], (bf16_t*)(ws + WS_WIN), F.in[13], D, NIN, 2, 0, r}; return d; } r -= I_IN;
    if (r < I_SQ / 2) { d = P0Item{F.in[25], (bf16_t*)(ws + WS_WOUT), F.in[23], 512, D, 0, 0, r}; return d; } r -= I_SQ / 2;
    if (r < I_SQ / 2) { d = P0Item{F.in[25] + 512 * 1024, (bf16_t*)(ws + WS_WOUT + MiB), F.in[24], 512, D, 0, 0, r}; return d; } r -= I_SQ / 2;
    if (r < I_SQ) { d = P0Item{F.in[28], (bf16_t*)(ws + WS_WCQ), F.in[26], D, D, 0, 0, r}; return d; } r -= I_SQ;
    if (r < I_SQ) { d = P0Item{F.in[29], (bf16_t*)(ws + WS_WCKV), nullptr, D, D, 0, 0, r}; return d; } r -= I_SQ;
    if (r < I_SQ) { d = P0Item{F.in[30], (bf16_t*)(ws + WS_WCKV), nullptr, D, D, 0, 1024, r}; return d; } r -= I_SQ;
    d = P0Item{F.in[31], (bf16_t*)(ws + WS_WCO), nullptr, D, D, 0, 0, r}; return d;
}
__device__ __forceinline__ void p0_load_item(const P0Item& d, float (&v)[32], int lane) {
    const int nblk = d.N / 32, kb = d.r / nblk, nb = d.r % nblk, k0 = 64 * kb, n0 = 32 * nb;
#pragma unroll
    for (int i = 0; i < 32; ++i) { const int k = k0 + 2 * i + (lane >> 5); v[i] = __builtin_nontemporal_load(d.W + (size_t)k * d.N + n0 + (lane & 31)) * (d.g0 ? d.g0[k] : 1.0f); }
}
__device__ __forceinline__ void p0_store_item(const P0Item& d, const float (&v)[32], LAS float* scr, int lane) {
    const int nblk = d.N / 32, kb = d.r / nblk, nb = d.r % nblk, k0 = 64 * kb, n0 = 32 * nb;
#pragma unroll
    for (int i = 0; i < 32; ++i) scr[(2 * i + (lane >> 5)) * 33 + (lane & 31)] = v[i];
    asm volatile("s_waitcnt lgkmcnt(0)" ::: "memory");
    const int c = lane & 7;
#pragma unroll
    for (int j = 0; j < 4; ++j) {
        const int n = (lane >> 3) + 8 * j; const LAS float* s = scr + (8 * c) * 33 + n;
        u32x4 o; o.x = cvt_pk_bf16(s[0 * 33], s[1 * 33]); o.y = cvt_pk_bf16(s[2 * 33], s[3 * 33]); o.z = cvt_pk_bf16(s[4 * 33], s[5 * 33]); o.w = cvt_pk_bf16(s[6 * 33], s[7 * 33]);
        *(u32x4*)(d.WT + (size_t)dst_row_of(d.mode, d.row_off, n0 + n) * d.K + k0 + 8 * c) = o;
    }
    asm volatile("s_waitcnt lgkmcnt(0)" ::: "memory");
}
__device__ __forceinline__ void p0_prologue(Ctx& F, const double* inv_rev) {
    LAS float* scr = (LAS float*)(F.lds + F.wave * 16384);
    const int gw = F.bid * 8 + F.wave, NGW = F.G * 8;
    constexpr int NITEMS = 6 * 1408 + 896 + 5 * 512;
#ifndef DUP_P0A
#define DUP_P0A 0
#endif
#ifndef DUP_P0B
#define DUP_P0B 0
#endif
#ifndef DUP_P0C
#define DUP_P0C 0
#endif
    for (int rp_ = 0; rp_ <= DUP_P0A; ++rp_) {
        float cur[32]; int it = gw;
        if (it < NITEMS) { const P0Item d = p0_item(F, it); p0_load_item(d, cur, F.lane); }
        for (; it < NITEMS; it += NGW) {
            float nxt[32]; const bool more = it + NGW < NITEMS;
            if (more) { const P0Item dn = p0_item(F, it + NGW); p0_load_item(dn, nxt, F.lane); }
            const P0Item d = p0_item(F, it);
            p0_store_item(d, cur, scr, F.lane);
            if (more) {
#pragma unroll
                for (int i = 0; i < 32; ++i) cur[i] = nxt[i];
            }
        }
    }
    for (int rp_ = 0; rp_ <= DUP_P0B; ++rp_)
    for (int mb = gw; mb < M + MEMR; mb += 4 * NGW) {
        f32x4 v[4][4]; float s[4];
#pragma unroll
        for (int r = 0; r < 4; ++r) {
            const int m = mb + r * NGW; s[r] = 0.f;
            if (m < M + MEMR) {
                const float* src = m < MP ? F.in[0] + (size_t)m * D : (m < M ? F.in[1] + (size_t)(m - MP) * D : F.in[2] + (size_t)(m - M) * D);
                const f32x4* xr = (const f32x4*)src + F.lane;
#pragma unroll
                for (int j = 0; j < 4; ++j) v[r][j] = __builtin_nontemporal_load(xr + 64 * j);
            }
        }
#pragma unroll
        for (int r = 0; r < 4; ++r) {
            const int m = mb + r * NGW;
            if (m < M + MEMR) {
#pragma unroll
                for (int j = 0; j < 4; ++j) s[r] += (v[r][j][0] * v[r][j][0] + v[r][j][1] * v[r][j][1]) + (v[r][j][2] * v[r][j][2] + v[r][j][3] * v[r][j][3]);
                s[r] = wave_sum(s[r]);
                if (m < M) { if (F.lane == 0) F.SS[m] = s[r]; }
                else { const float rs = rstd_of(s[r]); const f32x4* gr = (const f32x4*)F.in[27] + F.lane;
#pragma unroll
                    for (int j = 0; j < 4; ++j) v[r][j] = v[r][j] * rs * gr[64 * j]; }
                u32x2* o8 = (u32x2*)(F.XB + (size_t)m * D) + F.lane;
#pragma unroll
                for (int j = 0; j < 4; ++j) { u32x2 w; w.x = pk2(v[r][j][0], v[r][j][1]); w.y = pk2(v[r][j][2], v[r][j][3]); o8[64 * j] = w; }
            }
        }
    }
    const int gt = F.bid * 512 + F.tid, NGT = F.G * 512;
    for (int rp_ = 0; rp_ <= DUP_P0C; ++rp_) {
    for (int i = gt; i < 6 * M; i += NGT) F.SS[M + i] = 0.f;
    for (int i = gt; i < ROPE_POS * 32; i += NGT) {
        const int pos = i >> 5, fi = i & 31; const double rev = (double)pos * inv_rev[fi]; const float fr = (float)(rev - floor(rev));
        F.ROPE[2 * i] = __builtin_amdgcn_cosf(fr); F.ROPE[2 * i + 1] = __builtin_amdgcn_sinf(fr);
    }
    {
        f32x4 ck[4], cv[4];
#pragma unroll
        for (int u = 0; u < 4; ++u) { const int i = gt + u * NGT; if (i < 128 * 3840) { const int n = i / 3840, r = i % 3840;
            ck[u] = __builtin_nontemporal_load((const f32x4*)(F.in[5] + (size_t)n * 16384 + 1024) + r); cv[u] = __builtin_nontemporal_load((const f32x4*)(F.in[6] + (size_t)n * 16384 + 1024) + r); } }
#pragma unroll
        for (int u = 0; u < 4; ++u) { const int i = gt + u * NGT; if (i < 128 * 3840) { const int n = i / 3840, r = i % 3840;
            __builtin_nontemporal_store(ck[u], (f32x4*)(F.out + O_SKS + (size_t)n * 16384) + r); __builtin_nontemporal_store(cv[u], (f32x4*)(F.out + O_SVS + (size_t)n * 16384) + r); } }
    }
    for (int i = gt; i < 2 * 8 * 64 * 64; i += NGT) {
        const int k = i & 63, n = (i >> 6) & 63, g = (i >> 12) & 7, mat = i >> 15;
        F.WAB[i] = f2bf((mat ? F.in[19] : F.in[17])[((size_t)g * 64 + k) * 64 + n]);
    }
    }
}
#define XB_TMO      128
#define XB_XCNT(j)  (256  + 64 * (j))
#define XB_XSUB(j)  (1280 + 64 * (j))
#define XB_XGEN(j)  (2304 + 64 * (j))
#define XB_TOP      3328
#define XB_TOPGEN   3392
#define XCD_BAR_WORDS 3456
#define XB_SPIN_CAP (1u << 18)

__device__ __forceinline__ unsigned xb_ld(unsigned* p)              { return __hip_atomic_load(p, __ATOMIC_RELAXED, __HIP_MEMORY_SCOPE_AGENT); }
__device__ __forceinline__ unsigned xb_add(unsigned* p, unsigned v) { return __hip_atomic_fetch_add(p, v, __ATOMIC_RELAXED, __HIP_MEMORY_SCOPE_AGENT); }
__device__ __forceinline__ unsigned xb_xcc_id() { return (unsigned)__builtin_amdgcn_s_getreg((3 << 11) | 20) & 0xFu; }
#define XB_SPIN(cond, bar) do { unsigned _sp = 0; while (cond) { __builtin_amdgcn_s_sleep(1); \
    if ((++_sp & 255u) == 0u) { if (xb_ld(&(bar)[XB_TMO])) break; if (_sp > XB_SPIN_CAP) { atomicAdd(&(bar)[XB_TMO], 1u); break; } } } } while (0)

struct XcdBarrier {
    unsigned* bar; unsigned x;
    volatile LAS unsigned* st;
};

__device__ __forceinline__ XcdBarrier xcd_barrier_post(unsigned* bar, volatile LAS unsigned* st) {
    XcdBarrier b; b.bar = bar; b.x = xb_xcc_id(); b.st = st;
    if (threadIdx.x == 0) (void)xb_add(&bar[XB_XCNT(b.x)], 1u);
    return b;
}
__device__ __forceinline__ void xcd_barrier_complete(unsigned* bar, unsigned x, unsigned& nloc, unsigned& nx) {
    const unsigned G = gridDim.x * gridDim.y * gridDim.z;
    unsigned sum, cnt, mine, sp = 0u;
    for (;;) {
        sum = 0u; cnt = 0u; mine = 0u;
#pragma unroll
        for (unsigned j = 0; j < 16; ++j) { const unsigned c = xb_ld(&bar[XB_XCNT(j)]); sum += c; cnt += (c > 0u) ? 1u : 0u; mine = (j == x) ? c : mine; }
        if (sum == G) break;
        __builtin_amdgcn_s_sleep(1);
        if ((++sp & 255u) == 0u) { if (xb_ld(&bar[XB_TMO])) break; if (sp > XB_SPIN_CAP) { atomicAdd(&bar[XB_TMO], 1u); break; } }
    }
    nloc = mine > 0u ? mine : 1u; nx = cnt > 0u ? cnt : 1u;
}

__device__ __forceinline__ void xcd_barrier(const XcdBarrier& b) {
    asm volatile("s_waitcnt vmcnt(0)" ::: "memory");
    __syncthreads();
    if (threadIdx.x == 0) {
        unsigned* bar = b.bar;
        __builtin_amdgcn_s_waitcnt(0);
        unsigned nloc = b.st[0], nx = b.st[1];
        if (nloc == 0u) { xcd_barrier_complete(bar, b.x, nloc, nx); b.st[0] = nloc; b.st[1] = nx; }
        const unsigned old = xb_add(&bar[XB_XSUB(b.x)], 1u);
        const unsigned gen = old / nloc;
        if (old + 1u == (gen + 1u) * nloc) {
            __builtin_amdgcn_fence(__ATOMIC_RELEASE, "agent");
            asm volatile("s_waitcnt vmcnt(0)" ::: "memory");
            const unsigned og = xb_add(&bar[XB_TOP], 1u);
            const unsigned tg = og / nx;
            if (og + 1u == (tg + 1u) * nx) xb_add(&bar[XB_TOPGEN], 1u);
            else XB_SPIN(xb_ld(&bar[XB_TOPGEN]) == tg, bar);
            __builtin_amdgcn_fence(__ATOMIC_ACQUIRE, "agent");
            xb_add(&bar[XB_XGEN(b.x)], 1u);
            asm volatile("s_waitcnt vmcnt(0)" ::: "memory");
        } else {
            XB_SPIN(xb_ld(&bar[XB_XGEN(b.x)]) == gen, bar);
            __builtin_amdgcn_fence(__ATOMIC_ACQUIRE, "agent");
            asm volatile("s_waitcnt vmcnt(0)" ::: "memory");
        }
    }
    __syncthreads();
}

template <bool SAMPLE, int PASS, int NH>
__device__ __forceinline__ void lru_tile(Ctx& F, int m0, int bn  , int k  , float* ssl) {
    const int g = F.wave, lane = F.lane, c = g * 64 + lane;
    LAS unsigned char* ldsw = F.lds + g * 16384;
    const float* conv_w = F.in[15]; const float cw0 = conv_w[c], cw1 = conv_w[512 + c], cw2 = conv_w[1024 + c], cw3 = conv_w[1536 + c], cb = F.in[16][c];
    const float ba = F.in[18][c], bi = F.in[20][c], lamv = F.in[21][c];
    const float sp8 = 8.0f * (fmaxf(-lamv, 0.f) + log1pf(__expf(-fabsf(lamv))));
    const bf16_t* Pu = F.PROJ + (size_t)m0 * NIN + c;
    const float* scv = F.in[7] + (size_t)bn * 1536 + c;
    float x0 = 0.f, x1 = 0.f, x2 = 0.f;
    if (!SAMPLE && k > 0) { x0 = bf2f(Pu[-3 * NIN]); x1 = bf2f(Pu[-2 * NIN]); x2 = bf2f(Pu[-NIN]); }
    float h = 0.f, Ap = 1.f;
    if (!SAMPLE && PASS == 2 && k > 0) {
        const float* sa = F.SUMA + (size_t)bn * 128 * 512 + c; const float* sb = F.SUMB + (size_t)bn * 128 * 512 + c;
        const int kq = (k + 3) >> 2;
        float qa[4] = {1.f, 1.f, 1.f, 1.f}, qb[4] = {0.f, 0.f, 0.f, 0.f};
#pragma unroll 4
        for (int j = 0; j < kq; ++j) {
#pragma unroll
            for (int q = 0; q < 4; ++q) { const int jj = q * kq + j; if (jj < k) { const float a = sa[(size_t)jj * 512], b = sb[(size_t)jj * 512]; qa[q] *= a; qb[q] = a * qb[q] + b; } }
        }
#pragma unroll
        for (int q = 0; q < 4; ++q) h = qa[q] * h + qb[q];
    }
    LAS float* pre_r = (LAS float*)ldsw; LAS float* pre_i = pre_r + 2048;
#pragma unroll 1
    for (int half = 0; half < NH; ++half) {
        unsigned short uu[32], gg[32]; float st[4][3], hs[4];
        {
            const bf16_t* rp = F.PROJ + ((size_t)(m0 + 32 * half) * NIN + g * 64) + (size_t)(lane >> 3) * NIN + (lane & 7) * 8;
            u32x4 wu[4], wg[4];
#pragma unroll
            for (int i = 0; i < 4; ++i) { wu[i] = (PASS == 2) ? __builtin_nontemporal_load((const u32x4*)(rp + (size_t)(8 * i) * NIN)) : *(const u32x4*)(rp + (size_t)(8 * i) * NIN); if (PASS == 2) wg[i] = __builtin_nontemporal_load((const u32x4*)(rp + (size_t)(8 * i) * NIN + 512)); }
            LAS bf16_t* ut = (LAS bf16_t*)ldsw; LAS bf16_t* gt = ut + 2048;
#pragma unroll
            for (int i = 0; i < 4; ++i) { *(LAS u32x4*)(ut + ((lane >> 3) + 8 * i) * 64 + (lane & 7) * 8) = wu[i]; if (PASS == 2) *(LAS u32x4*)(gt + ((lane >> 3) + 8 * i) * 64 + (lane & 7) * 8) = wg[i]; }
            asm volatile("s_waitcnt lgkmcnt(0)" ::: "memory");
#pragma unroll
            for (int j = 0; j < 32; ++j) { uu[j] = ut[j * 64 + lane]; gg[j] = (PASS == 2) ? gt[j * 64 + lane] : (unsigned short)0; }
            asm volatile("s_waitcnt lgkmcnt(0)" ::: "memory");
        }
        if (SAMPLE) {
#pragma unroll
            for (int sq = 0; sq < 4; ++sq) { const float* sc = scv + (size_t)(4 * half + sq) * 1536; st[sq][0] = sc[0]; st[sq][1] = sc[512]; st[sq][2] = sc[1024]; hs[sq] = F.in[8][(size_t)(bn + 4 * half + sq) * 512 + c]; }
        }
        {
            LAS bf16_t* convb = (LAS bf16_t*)(ldsw + 8192); float xa = x0, xb = x1, xc = x2;
#pragma unroll
            for (int j = 0; j < 32; ++j) {
                if (SAMPLE && (j & 7) == 0) { xa = st[j >> 3][0]; xb = st[j >> 3][1]; xc = st[j >> 3][2]; }
                const float xi = bf2f(uu[j]);
                const float cv = (((cb + cw0 * xa) + cw1 * xb) + cw2 * xc) + cw3 * xi; xa = xb; xb = xc; xc = xi;
                convb[j * 72 + lane] = (unsigned short)cvt_pk_bf16(cv, cv);
            }
        }
        asm volatile("s_waitcnt lgkmcnt(0)" ::: "memory");
        bf16x8 Af[2][2];
        {
            const LAS bf16_t* convb = (const LAS bf16_t*)(ldsw + 8192);
#pragma unroll
            for (int tt = 0; tt < 2; ++tt)
#pragma unroll
                for (int ks = 0; ks < 2; ++ks) Af[tt][ks] = *(const LAS bf16x8*)(convb + (16 * tt + (lane & 15)) * 72 + 32 * ks + 8 * (lane >> 4));
        }
        asm volatile("s_waitcnt lgkmcnt(0)" ::: "memory");
#pragma unroll
        for (int nt = 0; nt < 4; ++nt) {
            const bf16_t* wa = F.WAB + ((size_t)g * 64 + 16 * nt + (lane & 15)) * 64 + 8 * (lane >> 4); const bf16_t* wi = wa + 8 * 64 * 64;
            const bf16x8 Ba0 = *(const bf16x8*)wa, Ba1 = *(const bf16x8*)(wa + 32), Bi0 = *(const bf16x8*)wi, Bi1 = *(const bf16x8*)(wi + 32);
#pragma unroll
            for (int tt2 = 0; tt2 < 2; ++tt2) {
                f32x4 ar = (f32x4){0.f, 0.f, 0.f, 0.f}, ai = ar;
                ar = __builtin_amdgcn_mfma_f32_16x16x32_bf16(Af[tt2][0], Ba0, ar, 0, 0, 0); ar = __builtin_amdgcn_mfma_f32_16x16x32_bf16(Af[tt2][1], Ba1, ar, 0, 0, 0);
                ai = __builtin_amdgcn_mfma_f32_16x16x32_bf16(Af[tt2][0], Bi0, ai, 0, 0, 0); ai = __builtin_amdgcn_mfma_f32_16x16x32_bf16(Af[tt2][1], Bi1, ai, 0, 0, 0);
                const int nn = (16 * nt + (lane & 15)) ^ (((lane >> 4) & 1) << 4);
#pragma unroll
                for (int j = 0; j < 4; ++j) { const int il = 16 * tt2 + 4 * (lane >> 4) + j; pre_r[il * 64 + nn] = ar[j]; pre_i[il * 64 + nn] = ai[j]; }
            }
        }
        asm volatile("s_waitcnt lgkmcnt(0)" ::: "memory");
#pragma unroll
        for (int il = 0; il < 32; il += 2) {
            typedef float v2f __attribute__((ext_vector_type(2)));
            const int i = 32 * half + il; const int nn = lane ^ (((il >> 2) & 1) << 4);
            if (SAMPLE && (il & 7) == 0) { x0 = st[il >> 3][0]; x1 = st[il >> 3][1]; x2 = st[il >> 3][2]; h = hs[il >> 3]; }
            const float xa = bf2f(uu[il]), xb = bf2f(uu[il + 1]);
            v2f cv = (v2f){cb, cb} + (v2f){x0, x1} * cw0; cv = cv + (v2f){x1, x2} * cw1; cv = cv + (v2f){x2, xa} * cw2; cv = cv + (v2f){xa, xb} * cw3;
            x0 = x2; x1 = xa; x2 = xb;
            const v2f tr = ((v2f){pre_r[il * 64 + nn], pre_r[(il + 1) * 64 + nn]} + ba) * (-LOG2E), ti = ((v2f){pre_i[il * 64 + nn], pre_i[(il + 1) * 64 + nn]} + bi) * (-LOG2E);
            const v2f r = (v2f){__builtin_amdgcn_rcpf(1.0f + fexp2(tr.x)), __builtin_amdgcn_rcpf(1.0f + fexp2(tr.y))};
            const v2f gi = (v2f){__builtin_amdgcn_rcpf(1.0f + fexp2(ti.x)), __builtin_amdgcn_rcpf(1.0f + fexp2(ti.y))};
            const v2f la = r * (-sp8), al = la * LOG2E, xx = la * 2.0f;
            const v2f a = (v2f){fexp2(al.x), fexp2(al.y)};
            const v2f ser = -xx * (1.0f + xx * 0.5f * (1.0f + xx * (1.0f / 3.0f) * (1.0f + xx * 0.25f * (1.0f + xx * 0.2f * (1.0f + xx * (1.0f / 6.0f))))));
            const v2f alt = 1.0f - a * a;
            const float om0 = xx.x > -0.25f ? ser.x : alt.x, om1 = xx.y > -0.25f ? ser.y : alt.y;
            const v2f sq = (v2f){__builtin_amdgcn_sqrtf(fmaxf(om0, 0.f)), __builtin_amdgcn_sqrtf(fmaxf(om1, 0.f))};
            const v2f bb = sq * (gi * cv);
            const float h0 = a.x * h + bb.x, h1 = a.y * h0 + bb.y; h = h1;
            if (PASS == 1) Ap *= a.x * a.y;
            if (PASS == 2) {
                const v2f g2 = (v2f){bf2f(gg[il]), bf2f(gg[il + 1])};
                const v2f z = (g2 + g2 * g2 * g2 * 0.044715f) * (-2.0f * 0.7978845608028654f * LOG2E);
                const v2f sg = (v2f){__builtin_amdgcn_rcpf(1.0f + fexp2(z.x)), __builtin_amdgcn_rcpf(1.0f + fexp2(z.y))};
                const v2f yv = (v2f){h0, h1} * g2 * sg;
                const unsigned yp = cvt_pk_bf16(yv.x, yv.y);
                ((LAS unsigned*)pre_i)[il * 64 + nn] = yp & 0xffffu; ((LAS unsigned*)pre_i)[(il + 1) * 64 + nn] = yp >> 16;
                const float y0 = __uint_as_float(yp << 16), y1 = __uint_as_float(yp & 0xffff0000u);
                pre_r[il * 64 + nn] = y0 * y0; pre_r[(il + 1) * 64 + nn] = y1 * y1;
                if (SAMPLE && (il & 7) == 6) F.out[O_HS + (size_t)(bn + (i >> 3)) * 512 + c] = h1;
            }
            if ((il & 7) == 6) __builtin_amdgcn_sched_barrier(0);
        }
        asm volatile("s_waitcnt lgkmcnt(0)" ::: "memory");
        if (PASS == 2) {
            if (lane < 32) {
                float s = 0.f;
#pragma unroll 8
                for (int j = 0; j < 64; ++j) s += pre_r[lane * 64 + ((j + lane) & 63)];
                unsafeAtomicAdd(ssl + m0 + 32 * half + lane, s);
            }
            {
                const LAS unsigned* yw = (const LAS unsigned*)pre_i;
#pragma unroll
                for (int i = 0; i < 4; ++i) {
                    const int row = (lane >> 3) + 8 * i, ch8 = ((lane & 7) * 8) ^ (((row >> 2) & 1) << 4);
                    const u32x4 lo = *(const LAS u32x4*)(yw + row * 64 + ch8), hi4 = *(const LAS u32x4*)(yw + row * 64 + ch8 + 4);
                    u32x4 w; w.x = (lo.x & 0xffffu) | (lo.y << 16); w.y = (lo.z & 0xffffu) | (lo.w << 16); w.z = (hi4.x & 0xffffu) | (hi4.y << 16); w.w = (hi4.z & 0xffffu) | (hi4.w << 16);
                    st16(F.MIX + (size_t)(m0 + 32 * half + row) * 512 + g * 64 + (lane & 7) * 8, w);
                }
            }
            asm volatile("s_waitcnt lgkmcnt(0)" ::: "memory");
        }
    }
    if (PASS == 1) {
        __hip_atomic_store((unsigned*)(F.SUMA + ((size_t)bn * 128 + k) * 512 + c), __float_as_uint(Ap), __ATOMIC_RELAXED, __HIP_MEMORY_SCOPE_AGENT);
        __hip_atomic_store((unsigned*)(F.SUMB + ((size_t)bn * 128 + k) * 512 + c), __float_as_uint(h), __ATOMIC_RELAXED, __HIP_MEMORY_SCOPE_AGENT);
    }
    if (PASS == 2) { if (!SAMPLE && k == 127) F.out[O_HP + (size_t)bn * 512 + c] = h; }
}

constexpr int SWA_KS = 136, SWA_VS = 204, SWA_VOFF = 192 * SWA_KS * 2;
__device__ __forceinline__ int crow(int r, int hi) { return (r & 3) + 8 * (r >> 2) + 4 * hi; }
__device__ __forceinline__ unsigned short bf_at(const u32x4& v, int e) { return (unsigned short)(v[e >> 1] >> ((e & 1) * 16)); }
template <bool SAMPLE>
__device__ __forceinline__ void swa_qtile(Ctx& F, const bf16_t* qrow  , int kb, int tb  , int h, float sk, bf16_t* orow, float* ssrow) {
    const int lane = F.lane, q = lane & 31, hi = lane >> 5, kvh = h >> 2;
    const LAS bf16_t* Kl = (const LAS bf16_t*)F.lds; const LAS bf16_t* Vt = (const LAS bf16_t*)(F.lds + SWA_VOFF);
    bf16x8 qf[4];
#pragma unroll
    for (int ks = 0; ks < 4; ++ks) qf[ks] = *(const bf16x8*)(qrow + 16 * ks + 8 * hi);
    f32x16 s[5];
#pragma unroll
    for (int kt = 0; kt < 5; ++kt) {
        s[kt] = (f32x16){0.f, 0.f, 0.f, 0.f, 0.f, 0.f, 0.f, 0.f, 0.f, 0.f, 0.f, 0.f, 0.f, 0.f, 0.f, 0.f};
#pragma unroll
        for (int ks = 0; ks < 4; ++ks) {
            const bf16x8 a = *(const LAS bf16x8*)(Kl + (kb + 32 * kt + q) * SWA_KS + kvh * 64 + 16 * ks + 8 * hi);
            s[kt] = __builtin_amdgcn_mfma_f32_32x32x16_bf16(a, qf[ks], s[kt], 0, 0, 0);
        }
    }
    float mx = sk;
#pragma unroll
    for (int kt = 0; kt < 5; ++kt)
#pragma unroll
        for (int r = 0; r < 16; ++r) {
            const int kk = 32 * kt + crow(r, hi); bool valid;
            if (SAMPLE) valid = (kk < 128) ? (kk >= q + 1) : (kk - 128 <= q && kk < 136);
            else valid = (kk >= q + 1) && (kk <= q + 128) && (tb + kk >= 0);
            const float sv = valid ? s[kt][r] : -INFINITY; s[kt][r] = sv; mx = fmaxf(mx, sv);
        }
    mx = fmaxf(mx, __shfl_xor(mx, 32));
    float l = 0.f; bf16x8 pb[10];
#pragma unroll
    for (int kt = 0; kt < 5; ++kt) {
        float p[16];
#pragma unroll
        for (int r = 0; r < 16; ++r) { p[r] = fexp2(s[kt][r] - mx); l += p[r]; }
#pragma unroll
        for (int hf = 0; hf < 2; ++hf) {
            u32x4 w; w.x = cvt_pk_bf16(p[8 * hf + 0], p[8 * hf + 1]); w.y = cvt_pk_bf16(p[8 * hf + 2], p[8 * hf + 3]); w.z = cvt_pk_bf16(p[8 * hf + 4], p[8 * hf + 5]); w.w = cvt_pk_bf16(p[8 * hf + 6], p[8 * hf + 7]);
            pb[2 * kt + hf] = __builtin_bit_cast(bf16x8, w);
        }
    }
    l += __shfl_xor(l, 32); l += fexp2(sk - mx);
    const float inv = 1.0f / l; float sq = 0.f;
    const bool wr_ok = !SAMPLE || q < 8;
#pragma unroll
    for (int dt = 0; dt < 2; ++dt) {
        f32x16 o = (f32x16){0.f, 0.f, 0.f, 0.f, 0.f, 0.f, 0.f, 0.f, 0.f, 0.f, 0.f, 0.f, 0.f, 0.f, 0.f, 0.f};
#pragma unroll
        for (int u = 0; u < 10; ++u) {
            const LAS bf16_t* vp = Vt + (kvh * 64 + 32 * dt + q) * SWA_VS + kb + 16 * u + 4 * hi;
            const u32x2 lo = *(const LAS u32x2*)vp, hi4 = *(const LAS u32x2*)(vp + 8);
            u32x4 w; w.x = lo.x; w.y = lo.y; w.z = hi4.x; w.w = hi4.y;
            o = __builtin_amdgcn_mfma_f32_32x32x16_bf16(__builtin_bit_cast(bf16x8, w), pb[u], o, 0, 0, 0);
        }
#pragma unroll
        for (int r = 0; r < 16; ++r) { o[r] *= inv; sq += o[r] * o[r]; }
        if (wr_ok) {
#pragma unroll
            for (int rg = 0; rg < 4; ++rg) {
                u32x2 w; w.x = cvt_pk_bf16(o[4 * rg], o[4 * rg + 1]); w.y = cvt_pk_bf16(o[4 * rg + 2], o[4 * rg + 3]);
                st8(orow + 32 * dt + 8 * rg + 4 * hi, w);
            }
        }
    }
    sq += __shfl_xor(sq, 32);
    if (wr_ok && hi == 0) unsafeAtomicAdd(ssrow, sq);
}
__device__ __forceinline__ void swa_prompt_item(Ctx& F, int b, int qb, float* ssa) {
    const int tid = F.tid, lane = F.lane, h = F.wave, q = lane & 31;
    LAS bf16_t* Kl = (LAS bf16_t*)F.lds; LAS bf16_t* Vt = (LAS bf16_t*)(F.lds + SWA_VOFF);
    const int tb = 64 * qb - 128; const size_t rowbase = (size_t)b * SEQ;
    const u32x4 z4 = (u32x4){0u, 0u, 0u, 0u};
#pragma unroll
    for (int i = 0; i < 6; ++i) { const int p = tid + 512 * i, key = p >> 4, ch = p & 15, tok = tb + key;
        const u32x4 v = tok >= 0 ? *(const u32x4*)(F.PROJ + (rowbase + tok) * NIN + 1536 + ch * 8) : z4;
        *(LAS u32x4*)(Kl + key * SWA_KS + ch * 8) = v; }
#pragma unroll
    for (int i = 0; i < 3; ++i) { const int p = tid + 512 * i, ch = (p & 3) + 4 * (p / 384), kp = (p % 384) >> 2, tok = tb + 2 * kp;
        const u32x4 v0 = tok >= 0 ? *(const u32x4*)(F.PROJ + (rowbase + tok) * NIN + 1664 + ch * 8) : z4;
        const u32x4 v1 = tok + 1 >= 0 ? *(const u32x4*)(F.PROJ + (rowbase + tok + 1) * NIN + 1664 + ch * 8) : z4;
#pragma unroll
        for (int e = 0; e < 8; ++e) *(LAS unsigned*)(Vt + (ch * 8 + e) * SWA_VS + 2 * kp) = (unsigned)bf_at(v0, e) | ((unsigned)bf_at(v1, e) << 16); }
    __syncthreads();
    const float sk = F.in[22][h] * LOG2E;
    const size_t m0 = rowbase + 64 * qb;
    swa_qtile<false>(F, F.PROJ + (m0 + q) * NIN + 1024 + h * 64, 0, tb, h, sk, (F.MIX + (size_t)M * 512) + (m0 + q) * 512 + h * 64, ssa + m0 + q);
    swa_qtile<false>(F, F.PROJ + (m0 + 32 + q) * NIN + 1024 + h * 64, 32, tb + 32, h, sk, (F.MIX + (size_t)M * 512) + (m0 + 32 + q) * 512 + h * 64, ssa + m0 + 32 + q);
    __syncthreads();
}
__device__ __forceinline__ void swa_sample_item(Ctx& F, int n, float* ssa) {
    const int tid = F.tid, lane = F.lane, h = F.wave, q = lane & 31;
    LAS bf16_t* Kl = (LAS bf16_t*)F.lds; LAS bf16_t* Vt = (LAS bf16_t*)(F.lds + SWA_VOFF);
    const size_t m0 = (size_t)MP + 8 * n;
    const float* ck = F.in[5] + (size_t)n * 16384; const float* cv = F.in[6] + (size_t)n * 16384;
    const u32x4 z4 = (u32x4){0u, 0u, 0u, 0u};
#pragma unroll
    for (int i = 0; i < 5; ++i) { const int p = tid + 512 * i, key = p >> 4, ch = p & 15;
        u32x4 v = z4;
        if (key < 128) { const f32x4 a = __builtin_nontemporal_load((const f32x4*)(ck + key * 128 + ch * 8)), bq = __builtin_nontemporal_load((const f32x4*)(ck + key * 128 + ch * 8 + 4));
            v.x = cvt_pk_bf16(a[0], a[1]); v.y = cvt_pk_bf16(a[2], a[3]); v.z = cvt_pk_bf16(bq[0], bq[1]); v.w = cvt_pk_bf16(bq[2], bq[3]); }
        else if (key < 136) v = *(const u32x4*)(F.PROJ + (m0 + key - 128) * NIN + 1536 + ch * 8);
        *(LAS u32x4*)(Kl + key * SWA_KS + ch * 8) = v; }
#pragma unroll
    for (int i = 0; i < 3; ++i) { const int p = tid + 512 * i;
        if (p < 1280) { const int ch = (p & 3) + 4 * (p / 320), kp = (p % 320) >> 2, key = 2 * kp;
            u32x4 v0 = z4, v1 = z4;
            if (key < 128) {
                const f32x4 a0 = __builtin_nontemporal_load((const f32x4*)(cv + key * 128 + ch * 8)), b0 = __builtin_nontemporal_load((const f32x4*)(cv + key * 128 + ch * 8 + 4)), a1 = __builtin_nontemporal_load((const f32x4*)(cv + (key + 1) * 128 + ch * 8)), b1 = __builtin_nontemporal_load((const f32x4*)(cv + (key + 1) * 128 + ch * 8 + 4));
                v0.x = cvt_pk_bf16(a0[0], a0[1]); v0.y = cvt_pk_bf16(a0[2], a0[3]); v0.z = cvt_pk_bf16(b0[0], b0[1]); v0.w = cvt_pk_bf16(b0[2], b0[3]);
                v1.x = cvt_pk_bf16(a1[0], a1[1]); v1.y = cvt_pk_bf16(a1[2], a1[3]); v1.z = cvt_pk_bf16(b1[0], b1[1]); v1.w = cvt_pk_bf16(b1[2], b1[3]);
            } else if (key < 136) { v0 = *(const u32x4*)(F.PROJ + (m0 + key - 128) * NIN + 1664 + ch * 8); v1 = *(const u32x4*)(F.PROJ + (m0 + key + 1 - 128) * NIN + 1664 + ch * 8); }
#pragma unroll
            for (int e = 0; e < 8; ++e) *(LAS unsigned*)(Vt + (ch * 8 + e) * SWA_VS + 2 * kp) = (unsigned)bf_at(v0, e) | ((unsigned)bf_at(v1, e) << 16); } }
    __syncthreads();
    const float sk = F.in[22][h] * LOG2E;
    const int qc = q < 8 ? q : 7;
    swa_qtile<true>(F, F.PROJ + (m0 + qc) * NIN + 1024 + h * 64, 0, 0, h, sk, (F.MIX + (size_t)M * 512) + (m0 + qc) * 512 + h * 64, ssa + m0 + qc);
    __syncthreads();
}

constexpr int XK_S = 72, XV_S = 260, XV_OFF = 256 * XK_S * 2;
template <bool SAMPLE>
__device__ __forceinline__ void xattn_item(Ctx& F, const float* Ksrc, const float* Vsrc, int h, size_t m0) {
    const int tid = F.tid, lane = F.lane, q = lane & 31, hi = lane >> 5;
    LAS bf16_t* Kc = (LAS bf16_t*)F.lds; LAS bf16_t* Vtc = (LAS bf16_t*)(F.lds + XV_OFF);
    const bool active = SAMPLE ? (F.wave == 0) : true;
    const size_t qr = SAMPLE ? m0 + (q < 8 ? q : 7) : m0 + 32 * F.wave + q;
    const bf16_t* qrow = F.QX + qr * D + h * 256;
    f32x16 S[8];
#pragma unroll
    for (int kt = 0; kt < 8; ++kt) S[kt] = (f32x16){0.f, 0.f, 0.f, 0.f, 0.f, 0.f, 0.f, 0.f, 0.f, 0.f, 0.f, 0.f, 0.f, 0.f, 0.f, 0.f};
#define XLD(ptr) (SAMPLE ? __builtin_nontemporal_load((const f32x4*)(ptr)) : *(const f32x4*)(ptr))
    f32x4 pre[8];
    const float* kbase = Ksrc + (size_t)(tid >> 4) * 1024 + h * 256 + 4 * (tid & 15);
    const float* vbase = Vsrc + (size_t)(2 * (tid >> 2)) * 1024 + h * 256 + 4 * (tid & 3);
#pragma unroll
    for (int i = 0; i < 8; ++i) pre[i] = XLD(kbase + (size_t)i * 32 * 1024);
    for (int ch = 0; ch < 4; ++ch) {
        __syncthreads();
#pragma unroll
        for (int i = 0; i < 8; ++i) { u32x2 w; w.x = cvt_pk_bf16(pre[i][0], pre[i][1]); w.y = cvt_pk_bf16(pre[i][2], pre[i][3]); *(LAS u32x2*)(Kc + ((tid >> 4) + 32 * i) * XK_S + 4 * (tid & 15)) = w; }
        __syncthreads();
        if (ch < 3) {
#pragma unroll
            for (int i = 0; i < 8; ++i) pre[i] = XLD(kbase + (size_t)i * 32 * 1024 + 64 * (ch + 1));
        } else {
#pragma unroll
            for (int i = 0; i < 4; ++i) { pre[2 * i] = XLD(vbase + 16 * i); pre[2 * i + 1] = XLD(vbase + 1024 + 16 * i); }
        }
        if (active) {
#pragma unroll 1
            for (int ks = 0; ks < 4; ++ks) {
                const bf16x8 qf = *(const bf16x8*)(qrow + 64 * ch + 16 * ks + 8 * hi);
#pragma unroll
                for (int kt = 0; kt < 8; ++kt) {
                    const bf16x8 a = *(const LAS bf16x8*)(Kc + (32 * kt + q) * XK_S + 16 * ks + 8 * hi);
                    S[kt] = __builtin_amdgcn_mfma_f32_32x32x16_bf16(a, qf, S[kt], 0, 0, 0);
                }
            }
        }
    }
    float mx = -INFINITY;
#pragma unroll
    for (int kt = 0; kt < 8; ++kt)
#pragma unroll
        for (int r = 0; r < 16; ++r) mx = fmaxf(mx, S[kt][r]);
    mx = fmaxf(mx, __shfl_xor(mx, 32));
    float l = 0.f; bf16x8 pb[16];
#pragma unroll
    for (int kt = 0; kt < 8; ++kt) {
        float p[16];
#pragma unroll
        for (int r = 0; r < 16; ++r) { p[r] = fexp2(S[kt][r] - mx); l += p[r]; }
#pragma unroll
        for (int hf = 0; hf < 2; ++hf) {
            u32x4 w; w.x = cvt_pk_bf16(p[8 * hf + 0], p[8 * hf + 1]); w.y = cvt_pk_bf16(p[8 * hf + 2], p[8 * hf + 3]); w.z = cvt_pk_bf16(p[8 * hf + 4], p[8 * hf + 5]); w.w = cvt_pk_bf16(p[8 * hf + 6], p[8 * hf + 7]);
            pb[2 * kt + hf] = __builtin_bit_cast(bf16x8, w);
        }
    }
    l += __shfl_xor(l, 32);
    const float inv = 1.0f / l;
    bf16_t* orow = F.XO + qr * D + h * 256;
    for (int ch = 0; ch < 4; ++ch) {
        __syncthreads();
#pragma unroll
        for (int i = 0; i < 4; ++i) {
#pragma unroll
            for (int e = 0; e < 4; ++e) *(LAS unsigned*)(Vtc + (4 * ((tid & 3) + 4 * i) + e) * XV_S + 2 * (tid >> 2)) = cvt_pk_bf16(pre[2 * i][e], pre[2 * i + 1][e]); }
        __syncthreads();
        if (ch < 3) {
#pragma unroll
            for (int i = 0; i < 4; ++i) { pre[2 * i] = XLD(vbase + 64 * (ch + 1) + 16 * i); pre[2 * i + 1] = XLD(vbase + 1024 + 64 * (ch + 1) + 16 * i); }
        }
        if (active) {
#pragma unroll
            for (int dt = 0; dt < 2; ++dt) {
                f32x16 o = (f32x16){0.f, 0.f, 0.f, 0.f, 0.f, 0.f, 0.f, 0.f, 0.f, 0.f, 0.f, 0.f, 0.f, 0.f, 0.f, 0.f};
#pragma unroll
                for (int u = 0; u < 16; ++u) {
                    const LAS bf16_t* vp = Vtc + (32 * dt + q) * XV_S + 16 * u + 4 * hi;
                    const u32x2 lo = *(const LAS u32x2*)vp, hi4 = *(const LAS u32x2*)(vp + 8);
                    u32x4 w; w.x = lo.x; w.y = lo.y; w.z = hi4.x; w.w = hi4.y;
                    o = __builtin_amdgcn_mfma_f32_32x32x16_bf16(__builtin_bit_cast(bf16x8, w), pb[u], o, 0, 0, 0);
                }
                if (!SAMPLE || q < 8) {
#pragma unroll
                    for (int rg = 0; rg < 4; ++rg) {
                        u32x2 w; w.x = cvt_pk_bf16(o[4 * rg] * inv, o[4 * rg + 1] * inv); w.y = cvt_pk_bf16(o[4 * rg + 2] * inv, o[4 * rg + 3] * inv);
                        st8(orow + 64 * ch + 32 * dt + 8 * rg + 4 * hi, w);
                    }
                }
            }
        }
    }
    __syncthreads();
}

struct MiniSeg { const bf16_t* A; const bf16_t* Bt; int K; const float* rowss; };
template <int MODE  , int NSEG>
__device__ __forceinline__ void mini_gemm(Ctx& F, const MiniSeg& sg0, const MiniSeg& sg1, float cscale, const float* base_s  , bf16_t* XB, float* ss_out, bf16_t* O, const float* ssin, float cst,
                                          unsigned* cnt_s = nullptr, const float* gfin = nullptr, float* Y = nullptr  ) {
    const int t = F.bid; if (t >= 256) return;
    const int lane = F.lane, w = F.wave, fr = lane & 15, fq = lane >> 4;
    const int R0 = (t >> 4) * 64, C0 = (t & 15) * 64;
    f32x4 acc[4][4];
#pragma unroll
    for (int mt = 0; mt < 4; ++mt)
#pragma unroll
        for (int nt = 0; nt < 4; ++nt) acc[mt][nt] = (f32x4){0.f, 0.f, 0.f, 0.f};
#pragma unroll
    for (int s_ = 0; s_ < NSEG; ++s_) {
        const MiniSeg& sg = s_ ? sg1 : sg0;
        const int K = sg.K, nsteps = K >> 8;
        const bf16_t* pa = sg.A + (size_t)(R0 + fr) * K + (size_t)w * (K >> 3) + 8 * fq; const bf16_t* pb = sg.Bt + (size_t)(C0 + fr) * K + (size_t)w * (K >> 3) + 8 * fq;
        f32x4 sacc[4][4];
        if (NSEG > 1) {
#pragma unroll
            for (int mt = 0; mt < 4; ++mt)
#pragma unroll
                for (int nt = 0; nt < 4; ++nt) sacc[mt][nt] = (f32x4){0.f, 0.f, 0.f, 0.f};
        }
        constexpr int NB = (NSEG > 1) ? 2 : 4;
#pragma unroll 1
        for (int s0 = 0; s0 < nsteps; s0 += NB) {
            bf16x8 a[NB][4], b[NB][4];
#pragma unroll
            for (int s = 0; s < NB; ++s)
                if (s0 + s < nsteps) {
#pragma unroll
                    for (int i = 0; i < 4; ++i) { a[s][i] = *(const bf16x8*)(pa + (size_t)(16 * i) * K + 32 * (s0 + s)); b[s][i] = *(const bf16x8*)(pb + (size_t)(16 * i) * K + 32 * (s0 + s)); }
                }
#pragma unroll
            for (int s = 0; s < NB; ++s)
                if (s0 + s < nsteps) {
#pragma unroll
                    for (int mt = 0; mt < 4; ++mt)
#pragma unroll
                        for (int nt = 0; nt < 4; ++nt) {
                            if (NSEG > 1) sacc[mt][nt] = __builtin_amdgcn_mfma_f32_16x16x32_bf16(b[s][nt], a[s][mt], sacc[mt][nt], 0, 0, 0);
                            else acc[mt][nt] = __builtin_amdgcn_mfma_f32_16x16x32_bf16(b[s][nt], a[s][mt], acc[mt][nt], 0, 0, 0);
                        }
                }
        }
        if (NSEG > 1) {
#pragma unroll
            for (int mt = 0; mt < 4; ++mt) {
                const float sc = rsqrtf(sg.rowss[MP + R0 + 16 * mt + fr] * (1.0f / 512.0f) + EPS);
#pragma unroll
                for (int nt = 0; nt < 4; ++nt) acc[mt][nt] = acc[mt][nt] + sacc[mt][nt] * sc;
            }
        }
    }
    LAS float* part = (LAS float*)(F.lds + w * 16384);
#pragma unroll
    for (int mt = 0; mt < 4; ++mt)
#pragma unroll
        for (int nt = 0; nt < 4; ++nt) { const int row = 16 * mt + fr, chn = (4 * nt + fq) ^ fr; *(LAS f32x4*)(part + row * 64 + 4 * chn) = acc[mt][nt]; }
    __syncthreads();
    const int r = 8 * w + (lane >> 3), j = lane & 7;
    f32x4 t0 = (f32x4){0.f, 0.f, 0.f, 0.f}, t1 = t0;
#pragma unroll
    for (int pw = 0; pw < 8; ++pw) {
        const LAS float* pp = (const LAS float*)(F.lds + pw * 16384) + r * 64;
        t0 = t0 + *(const LAS f32x4*)(pp + 4 * ((2 * j) ^ (r & 15))); t1 = t1 + *(const LAS f32x4*)(pp + 4 * ((2 * j + 1) ^ (r & 15)));
    }
    const int R = MP + R0 + r, C = C0 + 8 * j;
    if (MODE == 0 || MODE == 2) {
        if (NSEG == 1) { t0 = t0 * cscale; t1 = t1 * cscale; }
        f32x4 b0, b1;
        if (base_s) { b0 = *(const f32x4*)(base_s + (size_t)(R - MP) * D + C); b1 = *(const f32x4*)(base_s + (size_t)(R - MP) * D + C + 4); }
        else { const u32x4 wv = *(const u32x4*)(XB + (size_t)R * D + C);
            b0 = (f32x4){__uint_as_float(wv.x << 16), __uint_as_float(wv.x & 0xffff0000u), __uint_as_float(wv.y << 16), __uint_as_float(wv.y & 0xffff0000u)};
            b1 = (f32x4){__uint_as_float(wv.z << 16), __uint_as_float(wv.z & 0xffff0000u), __uint_as_float(wv.w << 16), __uint_as_float(wv.w & 0xffff0000u)}; }
        const f32x4 v0 = b0 + t0, v1 = b1 + t1;
        if (MODE == 0) { u32x4 wo; wo.x = cvt_pk_bf16(v0[0], v0[1]); wo.y = cvt_pk_bf16(v0[2], v0[3]); wo.z = cvt_pk_bf16(v1[0], v1[1]); wo.w = cvt_pk_bf16(v1[2], v1[3]);
            *(u32x4*)(XB + (size_t)R * D + C) = wo; }
        float sq = (v0[0] * v0[0] + v0[1] * v0[1]) + (v0[2] * v0[2] + v0[3] * v0[3]) + (v1[0] * v1[0] + v1[1] * v1[1]) + (v1[2] * v1[2] + v1[3] * v1[3]);
        sq += __shfl_xor(sq, 1); sq += __shfl_xor(sq, 2); sq += __shfl_xor(sq, 4);
        if (j == 0) unsafeAtomicAdd(ss_out + R, sq);
        if (MODE == 2) {
            asm volatile("s_waitcnt vmcnt(0)" ::: "memory");
            __syncthreads();
            if (threadIdx.x == 0) {
                unsigned* c = cnt_s + 64 * (t >> 4);
                __hip_atomic_fetch_add(c, 1u, __ATOMIC_RELAXED, __HIP_MEMORY_SCOPE_AGENT);
                unsigned sp = 0u;
                while (__hip_atomic_load(c, __ATOMIC_RELAXED, __HIP_MEMORY_SCOPE_AGENT) < 16u) { __builtin_amdgcn_s_sleep(2); if (++sp > (1u << 20)) break; }
            }
            __syncthreads();
            float s = 0.f; if (j == 0) s = unsafeAtomicAdd(ss_out + R, 0.0f);
            s = __shfl(s, lane & ~7);
            const float rs = rstd_of(s);
            const f32x4 g0 = *(const f32x4*)(gfin + C), g1 = *(const f32x4*)(gfin + C + 4);
            __builtin_nontemporal_store(v0 * rs * g0, (f32x4*)(Y + (size_t)R * D + C)); __builtin_nontemporal_store(v1 * rs * g1, (f32x4*)(Y + (size_t)R * D + C + 4));
        }
    } else {
        const float rs = rstd_of(ssin[R]) * cst;
        const f32x4 v0 = t0 * rs, v1 = t1 * rs;
        u32x4 wo; wo.x = cvt_pk_bf16(v0[0], v0[1]); wo.y = cvt_pk_bf16(v0[2], v0[3]); wo.z = cvt_pk_bf16(v1[0], v1[1]); wo.w = cvt_pk_bf16(v1[2], v1[3]);
        st16(O + (size_t)R * D + C, wo);
    }
    __syncthreads();
}

__global__ void __launch_bounds__(512, 2) hymba_fwd(Args args) {
    extern __shared__ __attribute__((aligned(16))) unsigned char lds_raw[];
    cg::grid_group grid = cg::this_grid();
    Ctx F;
    F.lds = (LAS unsigned char*)lds_raw; F.tid = threadIdx.x; F.lane = F.tid & 63; F.wave = __builtin_amdgcn_readfirstlane(F.tid >> 6); F.G = gridDim.x; F.bid = blockIdx.x;
    F.in = args.in; F.out = args.out; F.ws = args.ws;
    unsigned char* ws = args.ws;
    F.SS = (float*)(ws + WS_SS); F.ROPE = (float*)(ws + WS_ROPE); F.SUMA = (float*)(ws + WS_SUM); F.SUMB = F.SUMA + 256 * 512; F.WAB = (bf16_t*)(ws + WS_WAB);
    F.XB = (bf16_t*)(ws + WS_XB); F.H = (bf16_t*)(ws + WS_H); F.X = (float*)(ws + WS_X); F.PROJ = (bf16_t*)(ws + WS_PROJ); F.MIX = (bf16_t*)(ws + WS_MIX);
    F.QX = (bf16_t*)(ws + WS_QX); F.XO = (bf16_t*)(ws + WS_XO);
    float* ss0 = F.SS; float* ss1 = F.SS + M; float* ss2 = F.SS + 2 * M; float* ss3 = F.SS + 3 * M; float* ss4 = F.SS + 4 * M;
    constexpr size_t WS_BAR = WS_WAB + 2 * MiB;
    unsigned* const barw = (unsigned*)(ws + WS_BAR);
    volatile LAS unsigned* const barst = (volatile LAS unsigned*)(F.lds + MISC_OFF + 8192);
    if (threadIdx.x < 2) barst[threadIdx.x] = 0u;
    __syncthreads();
    XcdBarrier xbar = xcd_barrier_post(barw, barst);
#define GRID_SYNC() xcd_barrier(xbar)
#define RETID() do { int t_ = threadIdx.x; asm volatile("" : "+v"(t_)); F.tid = t_; F.lane = t_ & 63; F.wave = __builtin_amdgcn_readfirstlane(t_ >> 6); } while (0)
#ifndef PHASE_MASK
#define PHASE_MASK 0xFFFF
#endif
#define PH(k) if constexpr (((PHASE_MASK) >> (k)) & 1)
#ifndef DUP_MASK
#define DUP_MASK 0
#endif
#ifndef EXTRA_SYNCS
#define EXTRA_SYNCS 0
#endif
#define REP(k) for (int rep = 0; rep < 1 + (((DUP_MASK) >> (k)) & 1); ++rep)
    float* const ssdummy = (float*)(ws + WS_WAB + MiB);

    PH(0) REP(0) { RETID(); p0_prologue(F, args.inv_rev); }
    if (args.use_cg) grid.sync();
    GRID_SYNC();
    for (int e = 0; e < EXTRA_SYNCS; ++e) GRID_SYNC();
    PH(1) REP(1) {
        Gemm g{F.XB, (const bf16_t*)(ws + WS_W1GU), M, 2 * FF, D}; StaticOrder S; S.init(M, 2 * FF, F.G, F.bid);
        EpiGU E{F.H, ss0};
        gemm_phase<EpiGU, StaticOrder, true, true>(F.lds, g, S, E);
        Gemm g2{F.XB + (size_t)M * D, (const bf16_t*)(ws + WS_WCKV), MEMR, 2 * D, D}; StaticOrder S2; S2.init(MEMR, 2 * D, F.G, F.G - 1 - F.bid);
        EpiMemKV E2{F.out};
        gemm_phase<EpiMemKV, StaticOrder, true, true>(F.lds, g2, S2, E2);
    }
    GRID_SYNC();
    PH(2) {
        Gemm g{F.H, (const bf16_t*)(ws + WS_W1D), MP, D, FF}; StaticOrder S; S.init(MP, D, F.G, F.bid);
        EpiRes<false, false> E{nullptr, nullptr, F.XB, ss1, 0.5f, nullptr};
        gemm_phase<EpiRes<false, false>, StaticOrder, true, true>(F.lds, g, S, E);
        RETID(); const MiniSeg s0{F.H + (size_t)MP * FF, (const bf16_t*)(ws + WS_W1D), FF, nullptr};
        mini_gemm<0, 1>(F, s0, s0, 0.5f, nullptr, F.XB, ss1, nullptr, nullptr, 0.f);
    }
    GRID_SYNC();
    PH(3) REP(3) {
        Gemm g{F.XB, (const bf16_t*)(ws + WS_WIN), M, NIN, D}; StaticOrder S; S.init(M, NIN, F.G, F.bid);
        EpiIn E{F.PROJ, ss1, F.ROPE, F.out};
        gemm_phase<EpiIn, StaticOrder, true, true>(F.lds, g, S, E);
    }
    GRID_SYNC();
    unsigned* const cntl = barw + 9216;
    const int pmx = 8 * (F.bid & 7) + ((F.bid >> 3) >> 2), itm = (pmx >> 5) * 128 + (pmx & 31) * 4 + ((F.bid >> 3) & 3);
    PH(4) { RETID(); if (F.bid < 256) lru_tile<false, 1, 2>(F, (itm >> 7) * SEQ + (itm & 127) * 64, itm >> 7, itm & 127, nullptr); }
    asm volatile("s_waitcnt vmcnt(0)" ::: "memory");
    __syncthreads();
    if (threadIdx.x == 0 && F.bid < 256) __hip_atomic_fetch_add(cntl + 64 * (itm >> 7), 1u, __ATOMIC_RELAXED, __HIP_MEMORY_SCOPE_AGENT);
    PH(13) REP(13) { RETID(); float* ssa = rep ? ssdummy : F.SS + 6 * M; if (F.bid < 256) { swa_prompt_item(F, itm >> 7, itm & 127, ssa); if (F.bid < 128) swa_sample_item(F, F.bid, ssa); }
        if (rep == 0 && F.bid >= 128 && F.bid < 160) { const int st = F.bid - 128; lru_tile<true, 2, 1>(F, MP + st * 32, st * 4, 0, F.SS + 5 * M); } }
    if (threadIdx.x == 0 && F.bid < 256) {
        unsigned sp = 0u;
        while (__hip_atomic_load(cntl + 64 * (itm >> 7), __ATOMIC_RELAXED, __HIP_MEMORY_SCOPE_AGENT) < 128u) { __builtin_amdgcn_s_sleep(2); if (++sp > (1u << 20)) break; }
        __builtin_amdgcn_fence(__ATOMIC_ACQUIRE, "agent");
        asm volatile("s_waitcnt vmcnt(0)" ::: "memory");
    }
    __syncthreads();
    PH(5) REP(5) { RETID(); float* ssl = rep ? ssdummy : F.SS + 5 * M;
        if (F.bid < 256) lru_tile<false, 2, 2>(F, (itm >> 7) * SEQ + (itm & 127) * 64, itm >> 7, itm & 127, ssl);
    }
    GRID_SYNC();
    PH(6) {
        StaticOrder2 S; S.init(MP, D, F.G, F.bid);
        Gemm g{F.MIX, (const bf16_t*)(ws + WS_WOUT), MP, D, 512, F.MIX + (size_t)M * 512, (const bf16_t*)(ws + WS_WOUT + MiB)};
        EpiMix E{F.XB, ss2, F.SS + 5 * M, F.SS + 6 * M};
        gemm_phase<EpiMix, StaticOrder2, true, true>(F.lds, g, S, E);
        RETID(); const MiniSeg s0{F.MIX + (size_t)MP * 512, (const bf16_t*)(ws + WS_WOUT), 512, F.SS + 5 * M}, s1{F.MIX + (size_t)(M + MP) * 512, (const bf16_t*)(ws + WS_WOUT + MiB), 512, F.SS + 6 * M};
        mini_gemm<0, 2>(F, s0, s1, 1.0f, nullptr, F.XB, ss2, nullptr, nullptr, 0.f);
    }
    GRID_SYNC();
    PH(7) REP(7) {
        Gemm g{F.XB, (const bf16_t*)(ws + WS_WCQ), MP, D, D}; StaticOrder S; S.init(MP, D, F.G, F.bid);
        EpiRowBf16 E{F.QX, D, ss2, C2X};
        gemm_phase<EpiRowBf16, StaticOrder, true, true>(F.lds, g, S, E);
        RETID(); const MiniSeg s0{F.XB + (size_t)MP * D, (const bf16_t*)(ws + WS_WCQ), D, nullptr};
        mini_gemm<1, 1>(F, s0, s0, 1.0f, nullptr, nullptr, nullptr, F.QX, ss2, C2X);
    }
    GRID_SYNC();
    PH(8) REP(8) { RETID();
        if (F.bid < 256) {
            const int upm = 8 * (F.bid & 7) + ((F.bid >> 3) & 7), b = upm >> 5, qb = upm & 31, hp = F.bid >> 6;
            if (!(F.bid & 1)) xattn_item<false>(F, F.out + O_MK + (size_t)b * 262144, F.out + O_MV + (size_t)b * 262144, hp, (size_t)b * SEQ + 256 * qb);
#pragma unroll 1
            for (int sl = 0; sl < 2; ++sl) { const int j = F.bid + 256 * sl, n = j >> 2, h = j & 3;
                xattn_item<true>(F, F.in[3] + (size_t)n * 262144, F.in[4] + (size_t)n * 262144, h, (size_t)MP + 8 * n); }
            if (F.bid & 1) xattn_item<false>(F, F.out + O_MK + (size_t)b * 262144, F.out + O_MV + (size_t)b * 262144, hp, (size_t)b * SEQ + 256 * qb);
        }
    }
    GRID_SYNC();
    PH(9) {
        Gemm g{F.XO, (const bf16_t*)(ws + WS_WCO), MP, D, D}; StaticOrder S; S.init(MP, D, F.G, F.bid);
        EpiRes<false, false> E{nullptr, nullptr, F.XB, ss3, 1.0f, nullptr};
        gemm_phase<EpiRes<false, false>, StaticOrder, true, true>(F.lds, g, S, E);
        RETID(); const MiniSeg s0{F.XO + (size_t)MP * D, (const bf16_t*)(ws + WS_WCO), D, nullptr};
        mini_gemm<0, 1>(F, s0, s0, 1.0f, nullptr, F.XB, ss3, nullptr, nullptr, 0.f);
    }
    GRID_SYNC();
    PH(10) REP(10) {
        Gemm g{F.XB, (const bf16_t*)(ws + WS_W2GU), M, 2 * FF, D}; StaticOrder S; S.init(M, 2 * FF, F.G, F.bid);
        EpiGU E{F.H, ss3};
        gemm_phase<EpiGU, StaticOrder, true, true>(F.lds, g, S, E);
    }
    GRID_SYNC();
    PH(11) {
        unsigned* cntp = barw + 4096; unsigned* cnts = barw + 8192;
        Gemm g{F.H, (const bf16_t*)(ws + WS_W2D), MP, D, FF}; StaticOrder S; S.init(MP, D, F.G, F.bid);
        EpiFinal E{F.XB, ss4, cntp, F.in[36], F.out + O_Y, 0.5f};
        gemm_phase<EpiFinal, StaticOrder, false, true>(F.lds, g, S, E);
        RETID(); const MiniSeg s0{F.H + (size_t)MP * FF, (const bf16_t*)(ws + WS_W2D), FF, nullptr};
        mini_gemm<2, 1>(F, s0, s0, 0.5f, nullptr, F.XB, ss4, nullptr, nullptr, 0.f, cnts, F.in[36], F.out + O_Y);
    }
}

extern "C" void kernel_launch(void* const* d_in, const int* in_sizes, int n_in, void* d_out, int out_size, void* d_ws, size_t ws_size, hipStream_t stream) {
    static int grid = 0;
    if (grid == 0) {
        if (n_in != 37 || (size_t)out_size != O_END || ws_size < WS_END) { fprintf(stderr, "kernel_launch: unexpected shapes: n_in %d out %d (want %zu) ws %zu (want >= %zu)\n", n_in, out_size, (size_t)O_END, ws_size, (size_t)WS_END); grid = -1; return; }
        int dev = 0, cus = 0, per_cu = 0;
        hipGetDevice(&dev); hipDeviceGetAttribute(&cus, hipDeviceAttributeMultiprocessorCount, dev);
        if (hipFuncSetAttribute((const void*)hymba_fwd, hipFuncAttributeMaxDynamicSharedMemorySize, LDS_BYTES) != hipSuccess) { fprintf(stderr, "kernel_launch: hipFuncSetAttribute failed\n"); grid = -1; return; }
        if (hipOccupancyMaxActiveBlocksPerMultiprocessor(&per_cu, (const void*)hymba_fwd, 512, LDS_BYTES) != hipSuccess || per_cu < 1) { fprintf(stderr, "kernel_launch: occupancy query says %d blocks/CU\n", per_cu); (void)hipGetLastError(); per_cu = 1; }
        grid = cus;
        if (grid != 256) fprintf(stderr, "kernel_launch: note: %d CUs\n", grid);
    }
    if (grid < 0) return;
    Args a; memset(&a, 0, sizeof(a));
    for (int i = 0; i < 37; ++i) a.in[i] = (const float*)d_in[i];
    a.out = (float*)d_out; a.ws = (unsigned char*)d_ws;
    for (int i = 0; i < 32; ++i) a.inv_rev[i] = std::pow(10000.0, -(double)i / 32.0) / 6.283185307179586476925;
    a.use_cg = 0;
    if (hipMemsetAsync((char*)d_ws + WS_WAB + 2 * MiB, 0, 40960, stream) != hipSuccess) { fprintf(stderr, "kernel_launch: memset of barrier words failed\n"); return; }
    void* kargs[] = {&a};
    hipError_t e = hipLaunchCooperativeKernel((const void*)hymba_fwd, dim3(grid), dim3(512), kargs, LDS_BYTES, stream);
    if (e != hipSuccess) fprintf(stderr, "kernel_launch: cooperative launch failed: %s (grid %d)\n", hipGetErrorString(e), grid);
}
```
